# Optimizing an MI355X kernel written in HIP

```python
import math
import jax, jax.numpy as jnp
from jax import lax
import numpy as np

D_MODEL = 1024
BATCH = 8
SEQ = 2048
DEPTH = 4
DEC_BATCH = 128
DEC_SEQ = 4
PAST_LEN = 16384
PAGE_SIZE = 128

N_META = 16
CHUNK = 64
EPS = 1e-6
SSM_EXPAND = 2
D_INNER = SSM_EXPAND * D_MODEL
SSM_HEAD_DIM = 64
SSM_HEADS = D_INNER // SSM_HEAD_DIM
SSM_GROUPS = 4
SSM_STATE = 128
SSM_CONV = 4
SSM_XBC = D_INNER + 2 * SSM_GROUPS * SSM_STATE
GDN_HEADS = 8
GDN_DK = 128
GDN_DV = 128
GDN_CONV = 4
GDN_QKV = GDN_HEADS * (2 * GDN_DK + GDN_DV)
D_FF = 2816
FFN_CONV = 3
IN_SIZES = (D_INNER, SSM_XBC, SSM_HEADS, GDN_QKV, GDN_HEADS, GDN_HEADS, GDN_HEADS * GDN_DV, D_MODEL, D_MODEL)
IN_DIM = sum(IN_SIZES)

kernel_name = "hybrid_ssd_gdn_convffn_meta_step"


def split_cols(t, sizes):
    out = []
    off = 0
    for s in sizes:
        out.append(t[..., off:off + s])
        off += s
    return out


def rmsnorm(x, w):
    xf = x.astype(jnp.float32)
    y = xf * lax.rsqrt(jnp.mean(xf * xf, axis=-1, keepdims=True) + EPS)
    return (y * w.astype(jnp.float32)).astype(x.dtype)


def l2norm(x):
    return x * lax.rsqrt(jnp.sum(x * x, axis=-1, keepdims=True) + EPS)


def causal_dwconv(x, buf, w):
    width = w.shape[0]
    L = x.shape[1]
    xp = jnp.concatenate([buf.astype(x.dtype), x], axis=1)
    y = xp[:, 0:L] * w[0]
    for j in range(1, width):
        y = y + xp[:, j:j + L] * w[j]
    return y, xp[:, L:]


def ssd_segment(x, Bm, Cm, dt, A, h0):
    b, L = x.shape[:2]
    c = math.gcd(L, CHUNK)
    nc = L // c
    hg = SSM_HEADS // SSM_GROUPS

    def to_chunks(t):
        return jnp.moveaxis(t.reshape((b, nc, c) + t.shape[2:]), 1, 0)

    xs = to_chunks(x.reshape(b, L, SSM_GROUPS, hg, SSM_HEAD_DIM))
    dts = to_chunks(dt.reshape(b, L, SSM_GROUPS, hg))
    Bs = to_chunks(Bm)
    Cs = to_chunks(Cm)
    Ag = A.reshape(SSM_GROUPS, hg)
    causal = jnp.tril(jnp.ones((c, c), dtype=bool))

    def step(h, inp):
        xc, Bc, Cc, dtc = inp
        acum = jnp.cumsum(dtc * Ag, axis=1)
        seg = acum[:, :, None] - acum[:, None, :]
        decay = jnp.exp(jnp.where(causal[None, :, :, None, None], seg, -jnp.inf))
        cb = jnp.einsum('bign,bjgn->bijg', Cc, Bc)
        wgt = decay * cb[..., None] * dtc[:, None]
        y = jnp.einsum('bijgh,bjghp->bighp', wgt, xc)
        y = y + jnp.einsum('bign,bghpn->bighp', Cc, h) * jnp.exp(acum)[..., None]
        last = acum[:, -1]
        wj = jnp.exp(last[:, None] - acum) * dtc
        h = h * jnp.exp(last)[..., None, None] + jnp.einsum('bjgh,bjghp,bjgn->bghpn', wj, xc, Bc)
        return h, y

    hG = h0.reshape(b, SSM_GROUPS, hg, SSM_HEAD_DIM, SSM_STATE)
    hG, ys = lax.scan(step, hG, (xs, Bs, Cs, dts))
    y = jnp.moveaxis(ys, 0, 1).reshape(b, L, SSM_HEADS, SSM_HEAD_DIM)
    return y, hG.reshape(b, SSM_HEADS, SSM_HEAD_DIM, SSM_STATE)


def gdn_segment(q, k, v, g, beta, S0):
    b, L = q.shape[:2]
    c = math.gcd(L, CHUNK)
    nc = L // c

    def to_chunks(t):
        t = jnp.moveaxis(t.reshape((b, nc, c) + t.shape[2:]), 1, 0)
        return jnp.moveaxis(t, 3, 2)

    qs, ks, vs, gs, bs = (to_chunks(t) for t in (q, k, v, g, beta))
    incl = jnp.tril(jnp.ones((c, c), dtype=bool))
    strict = jnp.tril(jnp.ones((c, c), dtype=bool), -1)
    eye = jnp.eye(c, dtype=jnp.float32)

    def step(S, inp):
        qc, kc, vc, gc, bc = inp
        gcum = jnp.cumsum(gc, axis=-1)
        seg = gcum[..., :, None] - gcum[..., None, :]
        decay = jnp.exp(jnp.where(incl, seg, -jnp.inf))
        kb = kc * bc[..., None]
        amat = jnp.where(strict, jnp.einsum('bhik,bhjk->bhij', kb, kc) * decay, 0.0)
        rhs = jnp.concatenate([vc * bc[..., None], kb * jnp.exp(gcum)[..., None]], axis=-1)
        sol = lax.linalg.triangular_solve(eye + amat, rhs, left_side=True, lower=True, unit_diagonal=True)
        u, w = sol[..., :GDN_DV], sol[..., GDN_DV:]
        v_new = u - jnp.einsum('bhik,bhkv->bhiv', w, S)
        attn = jnp.einsum('bhik,bhjk->bhij', qc, kc) * decay
        o = jnp.einsum('bhik,bhkv->bhiv', qc * jnp.exp(gcum)[..., None], S) + jnp.einsum('bhij,bhjv->bhiv', attn, v_new)
        last = gcum[..., -1]
        S = S * jnp.exp(last)[..., None, None] + jnp.einsum(
            'bhjk,bhjv->bhkv', kc * jnp.exp(last[..., None] - gcum)[..., None], v_new)
        return S, o

    S, os_ = lax.scan(step, S0, (qs, ks, vs, gs, bs))
    o = jnp.moveaxis(jnp.moveaxis(os_, 3, 2), 0, 1).reshape(b, L, GDN_HEADS, GDN_DV)
    return o, S


def mixer_block(x, s_ssm, s_ssm_conv, s_gdn, s_gdn_conv, segments,
                norm_w, w_in, ssm_conv_w, ssm_conv_b, ssm_dt_bias, ssm_a_log, ssm_d, ssm_norm_w,
                gdn_conv_w, gdn_dt_bias, gdn_a_log, gdn_norm_w, w_ssm_out, w_gdn_out, w_o):
    f32 = jnp.float32
    bsz, L, _ = x.shape
    h = rmsnorm(x, norm_w)
    z, xbc, dt_raw, qkv, a_raw, b_raw, gate, mg_ssm, mg_gdn = split_cols(h @ w_in, IN_SIZES)
    xbc, new_ssm_conv = causal_dwconv(xbc, s_ssm_conv, ssm_conv_w)
    xbc = jax.nn.silu(xbc + ssm_conv_b)
    xs, Bm, Cm = split_cols(xbc, (D_INNER, SSM_GROUPS * SSM_STATE, SSM_GROUPS * SSM_STATE))
    xs = xs.reshape(bsz, L, SSM_HEADS, SSM_HEAD_DIM).astype(f32)
    Bm = Bm.reshape(bsz, L, SSM_GROUPS, SSM_STATE).astype(f32)
    Cm = Cm.reshape(bsz, L, SSM_GROUPS, SSM_STATE).astype(f32)
    dt = jax.nn.softplus((dt_raw + ssm_dt_bias).astype(f32))
    A = -jnp.exp(ssm_a_log.astype(f32))
    qkv, new_gdn_conv = causal_dwconv(qkv, s_gdn_conv, gdn_conv_w)
    qkv = jax.nn.silu(qkv)
    q, k, v = split_cols(qkv, (GDN_HEADS * GDN_DK, GDN_HEADS * GDN_DK, GDN_HEADS * GDN_DV))
    q = l2norm(q.reshape(bsz, L, GDN_HEADS, GDN_DK).astype(f32)) * (GDN_DK ** -0.5)
    k = l2norm(k.reshape(bsz, L, GDN_HEADS, GDN_DK).astype(f32))
    v = v.reshape(bsz, L, GDN_HEADS, GDN_DV).astype(f32)
    g = -jnp.exp(gdn_a_log.astype(f32)) * jax.nn.softplus((a_raw + gdn_dt_bias).astype(f32))
    beta = jax.nn.sigmoid(b_raw.astype(f32))
    hs = s_ssm.astype(f32)
    S = s_gdn.astype(f32)
    y_ssm_parts, y_gdn_parts = [], []
    start = 0
    for n in segments:
        sl = slice(start, start + n)
        y1, hs = ssd_segment(xs[:, sl], Bm[:, sl], Cm[:, sl], dt[:, sl], A, hs)
        y2, S = gdn_segment(q[:, sl], k[:, sl], v[:, sl], g[:, sl], beta[:, sl], S)
        y_ssm_parts.append(y1)
        y_gdn_parts.append(y2)
        start += n
    y_ssm = jnp.concatenate(y_ssm_parts, axis=1) + ssm_d.astype(f32)[:, None] * xs
    y_gdn = jnp.concatenate(y_gdn_parts, axis=1)
    y_ssm = y_ssm.reshape(bsz, L, D_INNER) * jax.nn.silu(z.astype(f32))
    y_ssm = rmsnorm(y_ssm.reshape(bsz, L, SSM_GROUPS, D_INNER // SSM_GROUPS),
                    ssm_norm_w.reshape(SSM_GROUPS, D_INNER // SSM_GROUPS))
    y_ssm = y_ssm.reshape(bsz, L, D_INNER).astype(x.dtype) @ w_ssm_out
    y_gdn = rmsnorm(y_gdn, gdn_norm_w) * jax.nn.silu(gate.reshape(bsz, L, GDN_HEADS, GDN_DV).astype(f32))
    y_gdn = y_gdn.reshape(bsz, L, GDN_HEADS * GDN_DV).astype(x.dtype) @ w_gdn_out
    merged = jax.nn.sigmoid(mg_ssm) * y_ssm + jax.nn.sigmoid(mg_gdn) * y_gdn
    x = x + merged @ w_o
    return x, hs.astype(x.dtype), new_ssm_conv, S.astype(x.dtype), new_gdn_conv


def conv_ffn(x, s_conv, norm_w, w_up, conv_w, conv_b, w_down):
    h = rmsnorm(x, norm_w)
    gt, up = split_cols(h @ w_up, (D_FF, D_FF))
    gt, new_conv = causal_dwconv(gt, s_conv, conv_w)
    return x + (jax.nn.silu(gt + conv_b) * up) @ w_down, new_conv


def run_trunk(x, s_ssm, s_ssm_conv, s_gdn, s_gdn_conv, s_ffn_conv, segments,
              norm_mix_w, w_in, ssm_conv_w, ssm_conv_b, ssm_dt_bias, ssm_a_log, ssm_d, ssm_norm_w,
              gdn_conv_w, gdn_dt_bias, gdn_a_log, gdn_norm_w, w_ssm_out, w_gdn_out, w_o,
              norm_ffn_w, w_up, ffn_conv_w, ffn_conv_b, w_down, norm_f_w):
    o_ssm, o_ssm_conv, o_gdn, o_gdn_conv, o_ffn_conv = [], [], [], [], []
    for l in range(DEPTH):
        x, a1, a2, a3, a4 = mixer_block(
            x, s_ssm[l], s_ssm_conv[l], s_gdn[l], s_gdn_conv[l], segments,
            norm_mix_w[l], w_in[l], ssm_conv_w[l], ssm_conv_b[l], ssm_dt_bias[l], ssm_a_log[l], ssm_d[l],
            ssm_norm_w[l], gdn_conv_w[l], gdn_dt_bias[l], gdn_a_log[l], gdn_norm_w[l],
            w_ssm_out[l], w_gdn_out[l], w_o[l])
        x, a5 = conv_ffn(x, s_ffn_conv[l], norm_ffn_w[l], w_up[l], ffn_conv_w[l], ffn_conv_b[l], w_down[l])
        o_ssm.append(a1); o_ssm_conv.append(a2); o_gdn.append(a3); o_gdn_conv.append(a4); o_ffn_conv.append(a5)
    y = rmsnorm(x, norm_f_w)
    return (y, jnp.stack(o_ssm), jnp.stack(o_ssm_conv), jnp.stack(o_gdn),
            jnp.stack(o_gdn_conv), jnp.stack(o_ffn_conv))


def setup_inputs(seed: int = 0) -> dict:
    key = jax.random.key(seed)
    ks = iter(jax.random.split(key, 48))
    f32 = jnp.float32

    def nrm(shape, scale):
        return scale * jax.random.normal(next(ks), shape, f32)

    def dt_bias(n):
        dt = jnp.exp(jax.random.uniform(next(ks), (DEPTH, n), f32, math.log(1e-3), math.log(1e-1)))
        return dt + jnp.log(-jnp.expm1(-dt))

    def a_log(n):
        return jnp.log(jax.random.uniform(next(ks), (DEPTH, n), f32, 1.0, 16.0))

    return {
        "x_prompt": nrm((BATCH, SEQ, D_MODEL), 1.0),
        "x_sample": nrm((DEC_BATCH, DEC_SEQ, D_MODEL), 1.0),
        "state_ssm": nrm((DEPTH, DEC_BATCH, SSM_HEADS, SSM_HEAD_DIM, SSM_STATE), 0.1),
        "state_ssm_conv": nrm((DEPTH, DEC_BATCH, SSM_CONV - 1, SSM_XBC), 1.0),
        "state_gdn": nrm((DEPTH, DEC_BATCH, GDN_HEADS, GDN_DK, GDN_DV), 0.1),
        "state_gdn_conv": nrm((DEPTH, DEC_BATCH, GDN_CONV - 1, GDN_QKV), 1.0),
        "state_ffn_conv": nrm((DEPTH, DEC_BATCH, FFN_CONV - 1, D_FF), 1.0),
        "meta_tokens": nrm((N_META, D_MODEL), 1.0),
        "norm_mix_w": 1.0 + nrm((DEPTH, D_MODEL), 0.02),
        "w_in": nrm((DEPTH, D_MODEL, IN_DIM), D_MODEL ** -0.5),
        "ssm_conv_w": nrm((DEPTH, SSM_CONV, SSM_XBC), SSM_CONV ** -0.5),
        "ssm_conv_b": nrm((DEPTH, SSM_XBC), 0.01),
        "ssm_dt_bias": dt_bias(SSM_HEADS),
        "ssm_a_log": a_log(SSM_HEADS),
        "ssm_d": 1.0 + nrm((DEPTH, SSM_HEADS), 0.1),
        "ssm_norm_w": 1.0 + nrm((DEPTH, D_INNER), 0.02),
        "gdn_conv_w": nrm((DEPTH, GDN_CONV, GDN_QKV), GDN_CONV ** -0.5),
        "gdn_dt_bias": dt_bias(GDN_HEADS),
        "gdn_a_log": a_log(GDN_HEADS),
        "gdn_norm_w": 1.0 + nrm((DEPTH, GDN_DV), 0.02),
        "w_ssm_out": nrm((DEPTH, D_INNER, D_MODEL), D_INNER ** -0.5),
        "w_gdn_out": nrm((DEPTH, GDN_HEADS * GDN_DV, D_MODEL), (GDN_HEADS * GDN_DV) ** -0.5),
        "w_o": nrm((DEPTH, D_MODEL, D_MODEL), D_MODEL ** -0.5),
        "norm_ffn_w": 1.0 + nrm((DEPTH, D_MODEL), 0.02),
        "w_up": nrm((DEPTH, D_MODEL, 2 * D_FF), D_MODEL ** -0.5),
        "ffn_conv_w": nrm((DEPTH, FFN_CONV, D_FF), FFN_CONV ** -0.5),
        "ffn_conv_b": nrm((DEPTH, D_FF), 0.01),
        "w_down": nrm((DEPTH, D_FF, D_MODEL), D_FF ** -0.5),
        "norm_f_w": 1.0 + nrm((D_MODEL,), 0.02),
    }


def reference(x_prompt, x_sample, state_ssm, state_ssm_conv, state_gdn, state_gdn_conv, state_ffn_conv,
              meta_tokens, norm_mix_w, w_in, ssm_conv_w, ssm_conv_b, ssm_dt_bias, ssm_a_log, ssm_d, ssm_norm_w,
              gdn_conv_w, gdn_dt_bias, gdn_a_log, gdn_norm_w, w_ssm_out, w_gdn_out, w_o,
              norm_ffn_w, w_up, ffn_conv_w, ffn_conv_b, w_down, norm_f_w):
    weights = (norm_mix_w, w_in, ssm_conv_w, ssm_conv_b, ssm_dt_bias, ssm_a_log, ssm_d, ssm_norm_w,
               gdn_conv_w, gdn_dt_bias, gdn_a_log, gdn_norm_w, w_ssm_out, w_gdn_out, w_o,
               norm_ffn_w, w_up, ffn_conv_w, ffn_conv_b, w_down, norm_f_w)
    bp, sp, _ = x_prompt.shape
    dtp = x_prompt.dtype
    xp = jnp.concatenate([jnp.broadcast_to(meta_tokens.astype(dtp), (bp, N_META, D_MODEL)), x_prompt], axis=1)
    z_ssm = jnp.zeros((DEPTH, bp, SSM_HEADS, SSM_HEAD_DIM, SSM_STATE), dtp)
    z_ssm_conv = jnp.zeros((DEPTH, bp, SSM_CONV - 1, SSM_XBC), dtp)
    z_gdn = jnp.zeros((DEPTH, bp, GDN_HEADS, GDN_DK, GDN_DV), dtp)
    z_gdn_conv = jnp.zeros((DEPTH, bp, GDN_CONV - 1, GDN_QKV), dtp)
    z_ffn_conv = jnp.zeros((DEPTH, bp, FFN_CONV - 1, D_FF), dtp)
    yp, p_ssm, p_ssm_conv, p_gdn, p_gdn_conv, p_ffn_conv = run_trunk(
        xp, z_ssm, z_ssm_conv, z_gdn, z_gdn_conv, z_ffn_conv, (N_META, sp), *weights)
    y_prompt = yp[:, N_META:]
    y_sample, s_ssm, s_ssm_conv, s_gdn, s_gdn_conv, s_ffn_conv = run_trunk(
        x_sample, state_ssm, state_ssm_conv, state_gdn, state_gdn_conv, state_ffn_conv,
        (x_sample.shape[1],), *weights)
    return (y_prompt, y_sample, p_ssm, p_ssm_conv, p_gdn, p_gdn_conv, p_ffn_conv,
            s_ssm, s_ssm_conv, s_gdn, s_gdn_conv, s_ffn_conv)
```

```cpp
#include <hip/hip_runtime.h>
#include <cstdio>
#include <cstdint>

#ifndef PH_ENABLE
#define PH_ENABLE 0xFFFFFFFFu
#endif
#define PHON(k) (((PH_ENABLE) >> (k)) & 1u)
#ifndef MK_SINGLE
#define MK_SINGLE 0
#endif

#define LAS __attribute__((address_space(3)))
typedef unsigned short bf16_t;
typedef short bf16x8 __attribute__((ext_vector_type(8)));
typedef float f32x4 __attribute__((ext_vector_type(4)));
typedef float f32x2 __attribute__((ext_vector_type(2)));
typedef unsigned u32x4 __attribute__((ext_vector_type(4)));
typedef unsigned u32x2 __attribute__((ext_vector_type(2)));

constexpr int D = 1024, DEPTH = 4, NB = 8, SEQ = 2048, DB = 128, DS = 4, NMETA = 16;
constexpr int MP = 17152, ROW_S0 = 16384, ROW_M0 = 16896;
constexpr int DI = 2048, XBC = 3072, QKV = 3072, NPROJ = 11264, NPROJ_T = 11520, DFF = 2816, NUP = 5632, IN_DIM = 11312;
constexpr int NH = 32, HP = 64, NST = 128, NG = 4, GH = 8, DK = 128, DV = 128;
constexpr int NCHUNK = 265;
constexpr int CID_S0 = 256, CID_M = 264;
constexpr float EPS = 1e-6f;
constexpr int PC_Z = 0, PC_XBC = 2048, PC_QKV = 5120, PC_GATE = 8192, PC_MGS = 9216, PC_MGG = 10240;

constexpr size_t al(size_t x) { return (x + 4095) & ~(size_t)4095; }
constexpr size_t WS_CTL = 0, CTL_BYTES = 1u << 20;
constexpr size_t WS_WIN = WS_CTL + CTL_BYTES;                         constexpr size_t SZ_WIN = (size_t)NPROJ_T * D * 2;
constexpr size_t WS_WSO = WS_WIN + DEPTH * SZ_WIN;                    constexpr size_t SZ_WSO = (size_t)D * DI * 2;
constexpr size_t WS_WGO = WS_WSO + DEPTH * SZ_WSO;                    constexpr size_t SZ_WGO = (size_t)D * D * 2;
constexpr size_t WS_WO  = WS_WGO + DEPTH * SZ_WGO;                    constexpr size_t SZ_WO  = (size_t)D * D * 2;
constexpr size_t WS_WUP = WS_WO + DEPTH * SZ_WO;                      constexpr size_t SZ_WUP = (size_t)NUP * D * 2;
constexpr size_t WS_WDN = WS_WUP + DEPTH * SZ_WUP;                    constexpr size_t SZ_WDN = (size_t)D * DFF * 2;
constexpr size_t WS_X   = WS_WDN + DEPTH * SZ_WDN;
constexpr size_t WS_XB  = WS_X + (size_t)MP * D * 4;
constexpr size_t WS_RSS = WS_XB + (size_t)MP * D * 2;
constexpr size_t WS_PROJ = al(WS_RSS + (size_t)MP * 16 * 4);
constexpr size_t WS_SMALL = WS_PROJ + (size_t)MP * NPROJ * 2;
constexpr size_t WS_SM2 = WS_SMALL + (size_t)MP * 64 * 4;
constexpr size_t WS_XBCA = al(WS_SM2 + (size_t)MP * 80 * 4);
constexpr size_t WS_QKVA = WS_XBCA + (size_t)MP * XBC * 2;
constexpr size_t WS_XTG = WS_QKVA + (size_t)MP * QKV * 2;
constexpr size_t WS_BTG = WS_XTG + (size_t)NCHUNK * 2048 * 64 * 2;
constexpr size_t WS_KBT = WS_BTG + (size_t)NCHUNK * 512 * 64 * 2;
constexpr size_t WS_KGT = WS_KBT + (size_t)NCHUNK * 1024 * 64 * 2;
constexpr size_t WS_VBT = WS_KGT + (size_t)NCHUNK * 1024 * 64 * 2;
constexpr size_t WS_ATTN = WS_VBT + (size_t)NCHUNK * 1024 * 64 * 2;
constexpr size_t WS_UT = WS_ATTN + (size_t)257 * 8 * 64 * 64 * 2;
constexpr size_t WS_WM = WS_UT + (size_t)257 * 8 * 128 * 64 * 2;
constexpr size_t WS_YS = WS_WM + (size_t)257 * 8 * 128 * 64 * 2;
constexpr size_t WS_SSQ = WS_YS + (size_t)MP * DI * 2;
constexpr size_t WS_YG = WS_SSQ + (size_t)MP * 32 * 4;
constexpr size_t WS_T1 = WS_YG + (size_t)MP * D * 2;
constexpr size_t WS_MRG = WS_T1 + (size_t)MP * D * 4;
constexpr size_t WS_UP = WS_MRG + (size_t)MP * D * 2;
constexpr size_t WS_ACT = WS_UP + (size_t)MP * NUP * 2;
constexpr size_t WS_END = WS_ACT + (size_t)MP * DFF * 2;

constexpr size_t O_YP = 0;
constexpr size_t O_YS = O_YP + (size_t)NB * SEQ * D;
constexpr size_t O_PSSM = O_YS + (size_t)DB * DS * D;
constexpr size_t O_PSC = O_PSSM + (size_t)DEPTH * NB * NH * HP * NST;
constexpr size_t O_PGDN = O_PSC + (size_t)DEPTH * NB * 3 * XBC;
constexpr size_t O_PGC = O_PGDN + (size_t)DEPTH * NB * 8 * DK * DV;
constexpr size_t O_PFC = O_PGC + (size_t)DEPTH * NB * 3 * QKV;
constexpr size_t O_SSSM = O_PFC + (size_t)DEPTH * NB * 2 * DFF;
constexpr size_t O_SSC = O_SSSM + (size_t)DEPTH * DB * NH * HP * NST;
constexpr size_t O_SGDN = O_SSC + (size_t)DEPTH * DB * 3 * XBC;
constexpr size_t O_SGC = O_SGDN + (size_t)DEPTH * DB * 8 * DK * DV;
constexpr size_t O_SFC = O_SGC + (size_t)DEPTH * DB * 3 * QKV;
constexpr size_t O_END = O_SFC + (size_t)DEPTH * DB * 2 * DFF;

typedef __bf16 bf16x2_t __attribute__((ext_vector_type(2)));
__device__ __forceinline__ unsigned cvt_pk_bf16(float lo, float hi) { bf16x2_t v; v[0] = (__bf16)lo; v[1] = (__bf16)hi; return __builtin_bit_cast(unsigned, v); }
__device__ __forceinline__ float bf_lo(unsigned w) { return __uint_as_float(w << 16); }
__device__ __forceinline__ float bf_hi(unsigned w) { return __uint_as_float(w & 0xffff0000u); }
__device__ __forceinline__ float bf1(bf16_t b) { return __uint_as_float(((unsigned)b) << 16); }
__device__ __forceinline__ float sigmoidf_(float x) { return 1.0f / (1.0f + __expf(-x)); }
__device__ __forceinline__ float siluf_(float x) { return x / (1.0f + __expf(-x)); }
__device__ __forceinline__ float softplusf_(float x) { return fmaxf(x, 0.f) + log1pf(__expf(-fabsf(x))); }
__device__ __forceinline__ int tidx() { int t = threadIdx.x; asm volatile("" : "+v"(t)); return t; }
__device__ __forceinline__ int bidx() { int t = blockIdx.x; asm volatile("" : "+s"(t)); return t; }
__device__ __forceinline__ int gdim() { int t = gridDim.x; asm volatile("" : "+s"(t)); return t; }
#define LDS_WAIT() asm volatile("s_waitcnt lgkmcnt(0)" ::: "memory")
#define VM_WAIT() asm volatile("s_waitcnt vmcnt(0)" ::: "memory")

namespace pg8 {
#define PG8_LAS __attribute__((address_space(3)))
constexpr int BM = 256, BK = 64, HALF = 128, HTB = HALF * BK * 2, STAGE_BYTES = 8 * HTB, NXCD = 8, WGM = 8;
__host__ __device__ __forceinline__ int lds_byte(int r, int c) { const int st = (r >> 4) * 2 + (c >> 5), rr = r & 15, cc = c & 31, ob = rr * 64 + cc * 2; return st * 1024 + (ob ^ (((ob >> 9) & 1) << 5)); }
__host__ __device__ __forceinline__ void stage_rc(int b, int& R, int& C) { const int st = b / 1024, sb = b % 1024, swz = sb ^ (((sb >> 9) & 1) << 5); R = (st >> 1) * 16 + swz / 64; C = (st & 1) * 32 + (swz % 64) / 2; }
__host__ __device__ __forceinline__ int perm32(int rho) { const int n = rho >> 4, i = rho & 15; return 8 * (i >> 2) + 4 * n + (i & 3); }
struct Unit { int pm, pn; };
struct Gemm { const bf16_t* A; const bf16_t* Bt; int M, N, K; };
struct StaticOrder {
    int nM, nN, nwg, G, c;
    __host__ __device__ void init(int M, int N, int G_, int c_) { nM = M / BM; nN = N / BM; nwg = nM * nN; G = G_; c = c_; }
    __host__ __device__ bool next(int i, Unit& u) const {
        const long L = (long)i * G + c; if (L >= nwg) return false;
        int wgid = (int)L; { const int q = nwg / NXCD, r = nwg % NXCD, xcd = wgid % NXCD, off = wgid / NXCD; wgid = (xcd < r ? xcd * (q + 1) : r * (q + 1) + (xcd - r) * q) + off; }
        const int nig = WGM * nN, gid = wgid / nig, fm = gid * WGM, gsz = (nM - fm) < WGM ? (nM - fm) : WGM;
        u.pm = fm + ((wgid % nig) % gsz); u.pn = (wgid % nig) / gsz; return true;
    }
    __device__ __forceinline__ void a_ready(const Unit&) const {}
    __device__ __forceinline__ void done(const Unit&) const {}
};

template <class Epi, class Sched, bool ALIGN_EPI = false, bool SP2 = false>
__device__ __forceinline__ void gemm_phase(PG8_LAS unsigned char* lds, const Gemm g, const Sched& S, const Epi& E) {
    const int tid = tidx(), wid = __builtin_amdgcn_readfirstlane(tid >> 6), lane = tid & 63, wr = wid >> 2, wc = wid & 3, fr = lane & 15, fq = lane >> 4;
    const int K = g.K, nt = K / BK;
    unsigned voffA[2], voffB[2];
#pragma unroll
    for (int i = 0; i < 2; ++i) { int R, C; stage_rc(tid * 16 + i * 8192, R, C); const int Rb = Epi::PERM ? ((R & ~31) + perm32(R & 31)) : R;
        voffA[i] = (unsigned)(R * K + C) * 2u; voffB[i] = (unsigned)(Rb * K + C) * 2u; }
    const size_t kstep = (size_t)(BK * 2);
    const size_t hstep = (size_t)HALF * K * 2;
    const size_t tstep = 2 * hstep;
    const unsigned ldsw = (unsigned)wid * 1024u;
    const int aoff = lds_byte(wr * 64 + fr, fq * 8), boff = lds_byte(wc * 32 + fr, fq * 8);
#define PG8_SA(b, h) (((b) * 2 + (h)) * HTB)
#define PG8_SB(b, h) ((4 + (b) * 2 + (h)) * HTB)
#define PG8_STAGE(bufoff, gbase, voff) do { _Pragma("unroll") for (int _i = 0; _i < 2; ++_i) \
        __builtin_amdgcn_global_load_lds((const unsigned*)((const char*)(gbase) + (voff)[_i]), (PG8_LAS unsigned*)(lds + (bufoff) + ldsw + _i * 8192), 16, 0, 0); } while (0)
#define PG8_LDA(dst, b, h) do { _Pragma("unroll") for (int m = 0; m < 4; ++m) _Pragma("unroll") for (int k = 0; k < 2; ++k) dst[m][k] = *(const PG8_LAS bf16x8*)(lds + PG8_SA(b, h) + aoff + m * 2048 + k * 1024); } while (0)
#define PG8_LDB(dst, b, h) do { _Pragma("unroll") for (int n = 0; n < 2; ++n) _Pragma("unroll") for (int k = 0; k < 2; ++k) dst[n][k] = *(const PG8_LAS bf16x8*)(lds + PG8_SB(b, h) + boff + n * 2048 + k * 1024); } while (0)
#define PG8_MMA(ai, bj, At, Bt) do { __builtin_amdgcn_s_setprio(1); _Pragma("unroll") for (int m = 0; m < 4; ++m) _Pragma("unroll") for (int n = 0; n < 2; ++n) _Pragma("unroll") for (int k = 0; k < 2; ++k) \
        acc[ai][bj][m][n] = __builtin_amdgcn_mfma_f32_16x16x32_bf16(Bt[n][k], At[m][k], acc[ai][bj][m][n], 0, 0, 0); __builtin_amdgcn_s_setprio(0); } while (0)
#define PG8_WAIT_V(n) asm volatile("s_waitcnt vmcnt(" #n ")" ::: "memory")
#define PG8_WAIT_L(n) asm volatile("s_waitcnt lgkmcnt(" #n ")" ::: "memory")
#define PG8_BAR __builtin_amdgcn_s_barrier()
#define PG8_SCHED __builtin_amdgcn_sched_barrier(0)
    Unit cur, nxt; int ui = 0;
    if (!S.next(0, cur)) return;
    f32x4 acc[2][2][4][2];
#pragma unroll
    for (int a = 0; a < 2; ++a)
#pragma unroll
        for (int b = 0; b < 2; ++b)
#pragma unroll
            for (int m = 0; m < 4; ++m)
#pragma unroll
                for (int n = 0; n < 2; ++n) acc[a][b][m][n] = (f32x4){0.f, 0.f, 0.f, 0.f};
    bf16x8 At[4][2], B0[2][2], B1[2][2];
    const char* cA = (const char*)g.A + (size_t)cur.pm * tstep; const char* cB = (const char*)g.Bt + (size_t)cur.pn * tstep;
    S.a_ready(cur);
    if constexpr (SP2) {
        PG8_STAGE(PG8_SB(0, 0), cB, voffB); PG8_STAGE(PG8_SB(0, 1), cB + hstep, voffB); PG8_STAGE(PG8_SA(0, 0), cA, voffA); PG8_STAGE(PG8_SA(0, 1), cA + hstep, voffA);
        if (wr == 1) PG8_BAR;
        PG8_WAIT_V(2); PG8_BAR;
        PG8_STAGE(PG8_SB(1, 0), cB + kstep, voffB); PG8_STAGE(PG8_SA(1, 0), cA + kstep, voffA); PG8_STAGE(PG8_SB(1, 1), cB + hstep + kstep, voffB);
        PG8_WAIT_V(6); PG8_BAR;
    } else {
        PG8_STAGE(PG8_SB(0, 0), cB, voffB); PG8_STAGE(PG8_SA(0, 0), cA, voffA); PG8_STAGE(PG8_SB(0, 1), cB + hstep, voffB); PG8_STAGE(PG8_SA(0, 1), cA + hstep, voffA);
        if (wr == 1) PG8_BAR;
        PG8_WAIT_V(4); PG8_BAR;
        PG8_STAGE(PG8_SB(1, 0), cB + kstep, voffB); PG8_STAGE(PG8_SA(1, 0), cA + kstep, voffA); PG8_STAGE(PG8_SB(1, 1), cB + hstep + kstep, voffB);
        PG8_WAIT_V(6); PG8_BAR;
    }
    for (;;) {
        const bool has_next = S.next(ui + 1, nxt);
        const char* nA = has_next ? (const char*)g.A + (size_t)nxt.pm * tstep : cA; const char* nB = has_next ? (const char*)g.Bt + (size_t)nxt.pn * tstep : cB;
        for (int t = 0; t < nt; t += 2) {
            const bool last = (t == nt - 2);
            const char* a1 = cA + (size_t)(t + 1) * kstep;
            const char* a2 = last ? nA : cA + (size_t)(t + 2) * kstep; const char* b2 = last ? nB : cB + (size_t)(t + 2) * kstep;
            const char* a3 = a2 + kstep; const char* b3 = b2 + kstep;
            if (last && has_next) S.a_ready(nxt);
            if constexpr (SP2) {
            PG8_LDB(B0, 0, 0); PG8_LDB(B1, 0, 1); PG8_SCHED; PG8_LDA(At, 0, 0); PG8_STAGE(PG8_SA(1, 1), a1 + hstep, voffA);
            PG8_WAIT_V(8); PG8_WAIT_L(0); PG8_BAR; PG8_MMA(0, 0, At, B0); PG8_MMA(0, 1, At, B1); PG8_BAR; PG8_SCHED;
            PG8_LDA(At, 0, 1); PG8_STAGE(PG8_SB(0, 0), b2, voffB); PG8_STAGE(PG8_SB(0, 1), b2 + hstep, voffB); PG8_STAGE(PG8_SA(0, 0), a2, voffA);
            PG8_WAIT_V(8); PG8_WAIT_L(0); PG8_BAR; PG8_MMA(1, 0, At, B0); PG8_MMA(1, 1, At, B1); PG8_BAR; PG8_SCHED;
            PG8_LDB(B0, 1, 0); PG8_LDB(B1, 1, 1); PG8_SCHED; PG8_LDA(At, 1, 0); PG8_STAGE(PG8_SA(0, 1), a2 + hstep, voffA);
            PG8_WAIT_V(8); PG8_WAIT_L(0); PG8_BAR; PG8_MMA(0, 0, At, B0); PG8_MMA(0, 1, At, B1); PG8_BAR; PG8_SCHED;
            PG8_LDA(At, 1, 1); PG8_STAGE(PG8_SB(1, 0), b3, voffB); PG8_STAGE(PG8_SB(1, 1), b3 + hstep, voffB); PG8_STAGE(PG8_SA(1, 0), a3, voffA);
            PG8_WAIT_V(8); PG8_WAIT_L(0); PG8_BAR; PG8_MMA(1, 0, At, B0); PG8_MMA(1, 1, At, B1); PG8_BAR; PG8_SCHED;
            } else {
            PG8_LDB(B0, 0, 0); PG8_SCHED; PG8_LDA(At, 0, 0); PG8_STAGE(PG8_SA(1, 1), a1 + hstep, voffA);
            PG8_WAIT_L(8); PG8_BAR; PG8_WAIT_L(0); PG8_MMA(0, 0, At, B0); PG8_BAR; PG8_SCHED;
            PG8_LDB(B1, 0, 1); PG8_STAGE(PG8_SB(0, 0), b2, voffB);
            PG8_BAR; PG8_WAIT_L(0); PG8_MMA(0, 1, At, B1); PG8_BAR;
            PG8_LDA(At, 0, 1); PG8_STAGE(PG8_SA(0, 0), a2, voffA);
            PG8_BAR; PG8_WAIT_L(0); PG8_MMA(1, 0, At, B0); PG8_BAR; PG8_SCHED;
            PG8_STAGE(PG8_SB(0, 1), b2 + hstep, voffB);
            PG8_WAIT_V(6); PG8_BAR; PG8_MMA(1, 1, At, B1); PG8_BAR;
            PG8_LDB(B0, 1, 0); PG8_SCHED; PG8_LDA(At, 1, 0); PG8_STAGE(PG8_SA(0, 1), a2 + hstep, voffA);
            PG8_WAIT_L(8); PG8_BAR; PG8_WAIT_L(0); PG8_MMA(0, 0, At, B0); PG8_BAR; PG8_SCHED;
            PG8_LDB(B1, 1, 1); PG8_STAGE(PG8_SB(1, 0), b3, voffB);
            PG8_BAR; PG8_WAIT_L(0); PG8_MMA(0, 1, At, B1); PG8_BAR;
            PG8_LDA(At, 1, 1); PG8_STAGE(PG8_SA(1, 0), a3, voffA);
            PG8_BAR; PG8_WAIT_L(0); PG8_MMA(1, 0, At, B0); PG8_BAR; PG8_SCHED;
            PG8_STAGE(PG8_SB(1, 1), b3 + hstep, voffB);
            PG8_WAIT_V(6); PG8_BAR; PG8_MMA(1, 1, At, B1); PG8_BAR;
            }
        }
        if constexpr (ALIGN_EPI) { if (wr == 0) PG8_BAR; }
        E(acc, cur, wr, wc, fr, fq); S.done(cur);
        if (!has_next) break;
#pragma unroll
        for (int a = 0; a < 2; ++a)
#pragma unroll
            for (int b = 0; b < 2; ++b)
#pragma unroll
                for (int m = 0; m < 4; ++m)
#pragma unroll
                    for (int n = 0; n < 2; ++n) acc[a][b][m][n] = (f32x4){0.f, 0.f, 0.f, 0.f};
        cur = nxt; cA = nA; cB = nB; ++ui;
        if constexpr (ALIGN_EPI) { if (wr == 1) PG8_BAR; }
    }
    PG8_WAIT_V(0);
    if constexpr (!ALIGN_EPI) { if (wr == 0) PG8_BAR; }
    PG8_BAR;
#undef PG8_SA
#undef PG8_SB
#undef PG8_STAGE
#undef PG8_LDA
#undef PG8_LDB
#undef PG8_MMA
#undef PG8_WAIT_V
#undef PG8_WAIT_L
#undef PG8_BAR
#undef PG8_SCHED
}

__device__ __forceinline__ float row_rstd(const float* rss, int row) {
    const f32x4* p = (const f32x4*)(rss + (size_t)row * 16); const f32x4 a = p[0], b = p[1], c = p[2], d = p[3];
    const float s = ((a[0] + a[1]) + (a[2] + a[3])) + ((b[0] + b[1]) + (b[2] + b[3])) + ((c[0] + c[1]) + (c[2] + c[3])) + ((d[0] + d[1]) + (d[2] + d[3]));
    return rsqrtf(s * (1.0f / 1024.0f) + EPS);
}
struct EpiScaleBf16 {
    static constexpr bool PERM = true;
    bf16_t* O; int ldc; const float* rss; float* SM; int ntile_main;
    __device__ __forceinline__ void operator()(const f32x4 (&acc)[2][2][4][2], const Unit& u, int wr, int wc, int fr, int fq) const {
        const int row0 = u.pm * BM + wr * 64 + fr, cin = wc * 32 + 8 * fq;
#pragma unroll
        for (int ai = 0; ai < 2; ++ai)
#pragma unroll
            for (int m = 0; m < 4; ++m) { const int row = row0 + ai * HALF + m * 16; const float rs = row_rstd(rss, row);
#pragma unroll
                for (int bj = 0; bj < 2; ++bj) { const f32x4 v0 = acc[ai][bj][m][0] * rs, v1 = acc[ai][bj][m][1] * rs;
                    if (u.pn < ntile_main) { u32x4 w; w.x = cvt_pk_bf16(v0[0], v0[1]); w.y = cvt_pk_bf16(v0[2], v0[3]); w.z = cvt_pk_bf16(v1[0], v1[1]); w.w = cvt_pk_bf16(v1[2], v1[3]);
                        *(u32x4*)(O + (size_t)row * ldc + u.pn * BM + cin + bj * HALF) = w; }
                    else { const int c = cin + bj * HALF; if (c < 64) { float* p = SM + (size_t)row * 64 + c; *(f32x4*)p = v0; *(f32x4*)(p + 4) = v1; } } } }
    }
};
struct EpiGateF32 {
    static constexpr bool PERM = false;
    float* T1; const bf16_t* P; int gcol0;
    __device__ __forceinline__ void operator()(const f32x4 (&acc)[2][2][4][2], const Unit& u, int wr, int wc, int fr, int fq) const {
        const int row0 = u.pm * BM + wr * 64 + fr, col0 = u.pn * BM + wc * 32 + 4 * fq;
#pragma unroll
        for (int ai = 0; ai < 2; ++ai)
#pragma unroll
            for (int m = 0; m < 4; ++m) { const int row = row0 + ai * HALF + m * 16;
#pragma unroll
                for (int bj = 0; bj < 2; ++bj)
#pragma unroll
                    for (int n = 0; n < 2; ++n) { const int c = col0 + bj * HALF + n * 16; const u32x2 g = *(const u32x2*)(P + (size_t)row * NPROJ + gcol0 + c);
                        f32x4 o; o[0] = sigmoidf_(bf_lo(g.x)) * acc[ai][bj][m][n][0]; o[1] = sigmoidf_(bf_hi(g.x)) * acc[ai][bj][m][n][1]; o[2] = sigmoidf_(bf_lo(g.y)) * acc[ai][bj][m][n][2]; o[3] = sigmoidf_(bf_hi(g.y)) * acc[ai][bj][m][n][3];
                        *(f32x4*)(T1 + (size_t)row * D + c) = o; } }
    }
};
struct EpiMerge {
    static constexpr bool PERM = true;
    bf16_t* O; const float* T1; const bf16_t* P; int gcol0;
    __device__ __forceinline__ void operator()(const f32x4 (&acc)[2][2][4][2], const Unit& u, int wr, int wc, int fr, int fq) const {
        const int row0 = u.pm * BM + wr * 64 + fr, col0 = u.pn * BM + wc * 32 + 8 * fq;
#pragma unroll
        for (int ai = 0; ai < 2; ++ai)
#pragma unroll
            for (int m = 0; m < 4; ++m) { const int row = row0 + ai * HALF + m * 16;
#pragma unroll
                for (int bj = 0; bj < 2; ++bj) { const int c = col0 + bj * HALF; const u32x4 g = *(const u32x4*)(P + (size_t)row * NPROJ + gcol0 + c);
                    const f32x4 t0 = *(const f32x4*)(T1 + (size_t)row * D + c), t1 = *(const f32x4*)(T1 + (size_t)row * D + c + 4);
                    const f32x4 a0 = acc[ai][bj][m][0], a1 = acc[ai][bj][m][1];
                    u32x4 w; w.x = cvt_pk_bf16(t0[0] + sigmoidf_(bf_lo(g.x)) * a0[0], t0[1] + sigmoidf_(bf_hi(g.x)) * a0[1]); w.y = cvt_pk_bf16(t0[2] + sigmoidf_(bf_lo(g.y)) * a0[2], t0[3] + sigmoidf_(bf_hi(g.y)) * a0[3]);
                    w.z = cvt_pk_bf16(t1[0] + sigmoidf_(bf_lo(g.z)) * a1[0], t1[1] + sigmoidf_(bf_hi(g.z)) * a1[1]); w.w = cvt_pk_bf16(t1[2] + sigmoidf_(bf_lo(g.w)) * a1[2], t1[3] + sigmoidf_(bf_hi(g.w)) * a1[3]);
                    *(u32x4*)(O + (size_t)row * D + c) = w; } }
    }
};
struct EpiResid {
    static constexpr bool PERM = false;
    float* X; bf16_t* XB; float* rss;
    __device__ __forceinline__ void operator()(const f32x4 (&acc)[2][2][4][2], const Unit& u, int wr, int wc, int fr, int fq) const {
        const int row0 = u.pm * BM + wr * 64 + fr, col0 = u.pn * BM + wc * 32 + 4 * fq;
#pragma unroll
        for (int ai = 0; ai < 2; ++ai)
#pragma unroll
            for (int m = 0; m < 4; ++m) { const int row = row0 + ai * HALF + m * 16; float s = 0.f;
#pragma unroll
                for (int bj = 0; bj < 2; ++bj)
#pragma unroll
                    for (int n = 0; n < 2; ++n) { const int c = col0 + bj * HALF + n * 16; float* xp = X + (size_t)row * D + c; const f32x4 xn = *(const f32x4*)xp + acc[ai][bj][m][n];
                        *(f32x4*)xp = xn; u32x2 w; w.x = cvt_pk_bf16(xn[0], xn[1]); w.y = cvt_pk_bf16(xn[2], xn[3]); *(u32x2*)(XB + (size_t)row * D + c) = w;
                        s += (xn[0] * xn[0] + xn[1] * xn[1]) + (xn[2] * xn[2] + xn[3] * xn[3]); }
                s += __shfl_xor(s, 16); s += __shfl_xor(s, 32);
                if (fq == 0) rss[(size_t)row * 16 + u.pn * 4 + wc] = s; }
    }
};
}

#define XB_TMO      128
#define XB_XCNT(j)  (256  + 64 * (j))
#define XB_XSUB(j)  (1280 + 64 * (j))
#define XB_XGEN(j)  (2304 + 64 * (j))
#define XB_TOP      3328
#define XB_TOPGEN   3392
#define XCD_BAR_WORDS 3456
#define XB_SPIN_CAP (1u << 18)
__device__ __forceinline__ unsigned xb_ld(unsigned* p)              { return __hip_atomic_load(p, __ATOMIC_RELAXED, __HIP_MEMORY_SCOPE_AGENT); }
__device__ __forceinline__ unsigned xb_add(unsigned* p, unsigned v) { return __hip_atomic_fetch_add(p, v, __ATOMIC_RELAXED, __HIP_MEMORY_SCOPE_AGENT); }
__device__ __forceinline__ unsigned xb_xcc_id() { return (unsigned)__builtin_amdgcn_s_getreg((3 << 11) | 20) & 0xFu; }
#define XB_SPIN(cond, bar) do { unsigned _sp = 0; while (cond) { __builtin_amdgcn_s_sleep(1); \
    if ((++_sp & 255u) == 0u) { if (xb_ld(&(bar)[XB_TMO])) break; if (_sp > XB_SPIN_CAP) { atomicAdd(&(bar)[XB_TMO], 1u); break; } } } } while (0)
struct XcdBarrier { unsigned* bar; unsigned x; volatile LAS unsigned* st; };
__device__ __forceinline__ XcdBarrier xcd_barrier_post(unsigned* bar, volatile LAS unsigned* st) {
    XcdBarrier b; b.bar = bar; b.x = xb_xcc_id(); b.st = st;
    if (threadIdx.x == 0) (void)xb_add(&bar[XB_XCNT(b.x)], 1u);
    return b;
}
__device__ __forceinline__ void xcd_barrier_complete(unsigned* bar, unsigned x, unsigned& nloc, unsigned& nx) {
    const unsigned G = gridDim.x * gridDim.y * gridDim.z;
    unsigned sum, cnt, mine, sp = 0u;
    for (;;) {
        sum = 0u; cnt = 0u; mine = 0u;
#pragma unroll
        for (unsigned j = 0; j < 16; ++j) { const unsigned c = xb_ld(&bar[XB_XCNT(j)]); sum += c; cnt += (c > 0u) ? 1u : 0u; mine = (j == x) ? c : mine; }
        if (sum == G) break;
        __builtin_amdgcn_s_sleep(1);
        if ((++sp & 255u) == 0u) { if (xb_ld(&bar[XB_TMO])) break; if (sp > XB_SPIN_CAP) { atomicAdd(&bar[XB_TMO], 1u); break; } }
    }
    nloc = mine > 0u ? mine : 1u; nx = cnt > 0u ? cnt : 1u;
}
__device__ __forceinline__ void xcd_barrier(const XcdBarrier& b) {
    asm volatile("s_waitcnt vmcnt(0)" ::: "memory");
    __syncthreads();
    if (threadIdx.x == 0) {
        unsigned* bar = b.bar;
        __builtin_amdgcn_s_waitcnt(0);
        unsigned nloc = b.st[0], nx = b.st[1];
        if (nloc == 0u) { xcd_barrier_complete(bar, b.x, nloc, nx); b.st[0] = nloc; b.st[1] = nx; }
        const unsigned old = xb_add(&bar[XB_XSUB(b.x)], 1u);
        const unsigned gen = old / nloc;
        if (old + 1u == (gen + 1u) * nloc) {
            __builtin_amdgcn_fence(__ATOMIC_RELEASE, "agent");
            asm volatile("s_waitcnt vmcnt(0)" ::: "memory");
            const unsigned og = xb_add(&bar[XB_TOP], 1u);
            const unsigned tg = og / nx;
            if (og + 1u == (tg + 1u) * nx) xb_add(&bar[XB_TOPGEN], 1u);
            else XB_SPIN(xb_ld(&bar[XB_TOPGEN]) == tg, bar);
            __builtin_amdgcn_fence(__ATOMIC_ACQUIRE, "agent");
            xb_add(&bar[XB_XGEN(b.x)], 1u);
            asm volatile("s_waitcnt vmcnt(0)" ::: "memory");
        } else {
            XB_SPIN(xb_ld(&bar[XB_XGEN(b.x)]) == gen, bar);
            __builtin_amdgcn_fence(__ATOMIC_ACQUIRE, "agent");
            asm volatile("s_waitcnt vmcnt(0)" ::: "memory");
        }
    }
    __syncthreads();
}

struct Args {
    const float* in[29]; float* out; unsigned char* ws; int ph_lo, ph_hi;
};
enum { I_XP = 0, I_XS, I_SSSM, I_SSC, I_SGDN, I_SGC, I_SFC, I_META, I_NMIX, I_WIN, I_SCW, I_SCB, I_SDTB, I_SALOG, I_SD, I_SNW, I_GCW, I_GDTB, I_GALOG, I_GNW,
       I_WSO, I_WGO, I_WO, I_NFFN, I_WUP, I_FCW, I_FCB, I_WDN, I_NF };
constexpr int LDS_BYTES = 160 * 1024 - 512;
constexpr int LDS_CTL = LDS_BYTES - 64;

__device__ __forceinline__ float wave_sum(float v) {
#pragma unroll
    for (int o = 1; o < 64; o <<= 1) v += __shfl_xor(v, o);
    return v;
}

__device__ __forceinline__ int win_src_col(int n) {
    if (n < 5120) return n;
    if (n < 8192) return 5152 + (n - 5120);
    if (n < 9216) return 8240 + (n - 8192);
    if (n < 10240) return 9264 + (n - 9216);
    if (n < 11264) return 10288 + (n - 10240);
    if (n < 11296) return 5120 + (n - 11264);
    if (n < 11304) return 8224 + (n - 11296);
    if (n < 11312) return 8232 + (n - 11304);
    return -1;
}
template <int MODE>
__device__ __forceinline__ void transpose_item(const float* W, int K, int Nsrc, bf16_t* WT, const float* scale, int scale_mask, LAS float* scr, int item, int nblk, int lane) {
    const int kb = item / nblk, nb = item % nblk, k0 = 64 * kb, n0 = 32 * nb;
    const int n = n0 + (lane & 31); const int sc = MODE == 1 ? win_src_col(n) : n;
#pragma unroll 8
    for (int i = 0; i < 32; ++i) { const int kk = 2 * i + (lane >> 5); const int k = k0 + kk;
        float v = sc >= 0 ? W[(size_t)k * Nsrc + sc] : 0.f; if (scale) v *= scale[k & scale_mask];
        scr[kk * 33 + (lane & 31)] = v; }
    LDS_WAIT(); asm volatile("" ::: "memory");
    const int c = lane & 7;
#pragma unroll
    for (int j = 0; j < 4; ++j) { const int nn = (lane >> 3) + 8 * j; const LAS float* s = scr + (8 * c) * 33 + nn;
        u32x4 o; o.x = cvt_pk_bf16(s[0 * 33], s[1 * 33]); o.y = cvt_pk_bf16(s[2 * 33], s[3 * 33]); o.z = cvt_pk_bf16(s[4 * 33], s[5 * 33]); o.w = cvt_pk_bf16(s[6 * 33], s[7 * 33]);
        *(u32x4*)(WT + (size_t)(n0 + nn) * K + k0 + 8 * c) = o; }
    LDS_WAIT(); asm volatile("" ::: "memory");
}
__device__ __forceinline__ void phase_weights(const Args& a, LAS unsigned char* lds) {
    const int lane = tidx() & 63, wave = tidx() >> 6;
    LAS float* scr = (LAS float*)(lds + wave * 16384);
    const int gw = bidx() * 8 + wave, NGW = gdim() * 8;
    constexpr int I_A = 16 * (NPROJ_T / 32), I_B = 32 * 32, I_C = 16 * 32, I_D = 16 * 32, I_E = 16 * (NUP / 32), I_F = 44 * 32, I_L = I_A + I_B + I_C + I_D + I_E + I_F;
    for (int it = gw; it < DEPTH * I_L; it += NGW) {
        const int l = it / I_L; int r = it % I_L;
        if (r < I_A) { transpose_item<1>(a.in[I_WIN] + (size_t)l * D * IN_DIM, D, IN_DIM, (bf16_t*)(a.ws + WS_WIN + l * SZ_WIN), a.in[I_NMIX] + l * D, 0xffff, scr, r, NPROJ_T / 32, lane); continue; } r -= I_A;
        if (r < I_B) { transpose_item<0>(a.in[I_WSO] + (size_t)l * DI * D, DI, D, (bf16_t*)(a.ws + WS_WSO + l * SZ_WSO), a.in[I_SNW] + l * DI, 0xffff, scr, r, 32, lane); continue; } r -= I_B;
        if (r < I_C) { transpose_item<0>(a.in[I_WGO] + (size_t)l * D * D, D, D, (bf16_t*)(a.ws + WS_WGO + l * SZ_WGO), a.in[I_GNW] + l * DV, 127, scr, r, 32, lane); continue; } r -= I_C;
        if (r < I_D) { transpose_item<0>(a.in[I_WO] + (size_t)l * D * D, D, D, (bf16_t*)(a.ws + WS_WO + l * SZ_WO), nullptr, 0, scr, r, 32, lane); continue; } r -= I_D;
        if (r < I_E) { transpose_item<0>(a.in[I_WUP] + (size_t)l * D * NUP, D, NUP, (bf16_t*)(a.ws + WS_WUP + l * SZ_WUP), a.in[I_NFFN] + l * D, 0xffff, scr, r, NUP / 32, lane); continue; } r -= I_E;
        transpose_item<0>(a.in[I_WDN] + (size_t)l * DFF * D, DFF, D, (bf16_t*)(a.ws + WS_WDN + l * SZ_WDN), nullptr, 0, scr, r, 32, lane);
    }
}

__device__ __forceinline__ const float* src_row(const Args& a, int row) {
    if (row < ROW_S0) return a.in[I_XP] + (size_t)row * D;
    if (row < ROW_M0) return a.in[I_XS] + (size_t)(row - ROW_S0) * D;
    if (row < ROW_M0 + NMETA) return a.in[I_META] + (size_t)(row - ROW_M0) * D;
    return nullptr;
}
__device__ __forceinline__ void phase_inputs(const Args& a) {
    const int lane = tidx() & 63, wave = tidx() >> 6;
    const int gw = bidx() * 8 + wave, NGW = gdim() * 8;
    float* X = (float*)(a.ws + WS_X); bf16_t* XB = (bf16_t*)(a.ws + WS_XB); float* RSS = (float*)(a.ws + WS_RSS);
    for (int row = gw; row < MP; row += NGW) {
        const float* s = src_row(a, row); float ss = 0.f;
#pragma unroll
        for (int j = 0; j < 4; ++j) { f32x4 v = s ? *(const f32x4*)(s + 256 * j + 4 * lane) : (f32x4){0.f, 0.f, 0.f, 0.f};
            *(f32x4*)(X + (size_t)row * D + 256 * j + 4 * lane) = v; u32x2 w; w.x = cvt_pk_bf16(v[0], v[1]); w.y = cvt_pk_bf16(v[2], v[3]);
            *(u32x2*)(XB + (size_t)row * D + 256 * j + 4 * lane) = w; ss += (v[0] * v[0] + v[1] * v[1]) + (v[2] * v[2] + v[3] * v[3]); }
        ss = wave_sum(ss);
        if (lane < 16) RSS[(size_t)row * 16 + lane] = lane == 0 ? ss : 0.f;
    }
}

struct Chunk { int row0, seg, nvalid, kind, b, c; };
__device__ __forceinline__ Chunk chunk_of(int cid) {
    Chunk k;
    if (cid < CID_S0) { k.kind = 0; k.b = cid >> 5; k.c = cid & 31; k.row0 = k.b * SEQ + 64 * k.c; k.seg = 64; k.nvalid = 64; }
    else if (cid < CID_M) { k.kind = 1; k.b = cid - CID_S0; k.c = 0; k.row0 = ROW_S0 + 64 * k.b; k.seg = 4; k.nvalid = 64; }
    else { k.kind = 2; k.b = 0; k.c = 0; k.row0 = ROW_M0; k.seg = 16; k.nvalid = 16; }
    return k;
}

__device__ __forceinline__ void phase_prep(const Args& a, int l, LAS unsigned char* lds) {
    const int tid = tidx();
    LAS float* tDT = (LAS float*)lds;
    LAS float* tAC = tDT + 64 * 32;
    LAS float* tG = tAC + 64 * 32;
    LAS float* tB = tG + 64 * 8;
    const bf16_t* PROJ = (const bf16_t*)(a.ws + WS_PROJ); const float* SMALL = (const float*)(a.ws + WS_SMALL); float* SM2 = (float*)(a.ws + WS_SM2);
    bf16_t* XBCA = (bf16_t*)(a.ws + WS_XBCA); bf16_t* QKVA = (bf16_t*)(a.ws + WS_QKVA);
    bf16_t* XTG = (bf16_t*)(a.ws + WS_XTG); bf16_t* BTG = (bf16_t*)(a.ws + WS_BTG); bf16_t* KBT = (bf16_t*)(a.ws + WS_KBT); bf16_t* KGT = (bf16_t*)(a.ws + WS_KGT); bf16_t* VBT = (bf16_t*)(a.ws + WS_VBT);
    for (int unit = bidx(); unit < NCHUNK * 3; unit += gdim()) {
        const int cid = unit / 3, third = unit % 3; const Chunk ck = chunk_of(cid);
        __syncthreads();
        for (int idx = tid; idx < 64 * 48; idx += 512) { const int tok = idx / 48, col = idx % 48; const float raw = SMALL[(size_t)(ck.row0 + tok) * 64 + col]; const bool valid = tok < ck.nvalid;
            if (col < 32) { const float dt = valid ? softplusf_(raw + a.in[I_SDTB][l * NH + col]) : 0.f; tDT[tok * 32 + col] = dt; tAC[tok * 32 + col] = -__expf(a.in[I_SALOG][l * NH + col]) * dt; }
            else if (col < 40) { const int h = col - 32; tG[tok * 8 + h] = valid ? -__expf(a.in[I_GALOG][l * 8 + h]) * softplusf_(raw + a.in[I_GDTB][l * 8 + h]) : 0.f; }
            else { const int h = col - 40; tB[tok * 8 + h] = valid ? sigmoidf_(raw) : 0.f; } }
        __syncthreads();
        if (tid < 40) { LAS float* t = tid < 32 ? tAC + tid : tG + (tid - 32); const int st = tid < 32 ? 32 : 8; float run = 0.f;
            for (int tok = 0; tok < 64; ++tok) { if ((tok & (ck.seg - 1)) == 0) run = 0.f; run += t[tok * st]; t[tok * st] = run; } }
        __syncthreads();
        if (third == 0) for (int idx = tid; idx < 64 * 80; idx += 512) { const int tok = idx / 80, col = idx % 80;
            const float v = col < 32 ? tDT[tok * 32 + col] : col < 64 ? tAC[tok * 32 + col - 32] : col < 72 ? tG[tok * 8 + col - 64] : tB[tok * 8 + col - 72];
            SM2[(size_t)(ck.row0 + tok) * 80 + col] = v; }
        const int gc = third * 2048 + tid * 4; const bool isx = gc < XBC; const int ch = isx ? gc : gc - XBC;
        const int pcol = isx ? PC_XBC + ch : PC_QKV + ch;
        const float* cw = isx ? a.in[I_SCW] + (size_t)l * 4 * XBC : a.in[I_GCW] + (size_t)l * 4 * QKV;
        float w[4][4], bias[4];
#pragma unroll
        for (int j = 0; j < 4; ++j) { const f32x4 t = *(const f32x4*)(cw + j * 3072 + ch); w[j][0] = t[0]; w[j][1] = t[1]; w[j][2] = t[2]; w[j][3] = t[3]; }
        { const f32x4 t = isx ? *(const f32x4*)(a.in[I_SCB] + l * XBC + ch) : (f32x4){0.f, 0.f, 0.f, 0.f}; bias[0] = t[0]; bias[1] = t[1]; bias[2] = t[2]; bias[3] = t[3]; }
        const float* st_in = (isx ? a.in[I_SSC] : a.in[I_SGC]) + (size_t)l * DB * 3 * 3072;
        float* cs_out_p = a.out + (isx ? O_PSC : O_PGC) + (size_t)l * NB * 3 * 3072;
        float* cs_out_s = a.out + (isx ? O_SSC : O_SGC) + (size_t)l * DB * 3 * 3072;
        const int kind = isx ? (ch < DI ? 0 : ch < DI + 512 ? 1 : 2) : (ch < 1024 ? 3 : ch < 2048 ? 4 : 5);
        const int hh = kind >= 3 ? ((ch & 1023) >> 7) : 0;
        float xw[3][4];
#pragma unroll
        for (int j = 0; j < 3; ++j)
#pragma unroll
            for (int e = 0; e < 4; ++e) xw[j][e] = 0.f;
        for (int i8 = 0; i8 < 8; ++i8) {
            float cur[8][4];
#pragma unroll
            for (int ii = 0; ii < 8; ++ii) { const u32x2 t = *(const u32x2*)(PROJ + (size_t)(ck.row0 + i8 * 8 + ii) * NPROJ + pcol); cur[ii][0] = bf_lo(t.x); cur[ii][1] = bf_hi(t.x); cur[ii][2] = bf_lo(t.y); cur[ii][3] = bf_hi(t.y); }
            float av[8][4];
#pragma unroll
            for (int ii = 0; ii < 8; ++ii) { const int i = i8 * 8 + ii; const int row = ck.row0 + i;
                if ((i & (ck.seg - 1)) == 0) {
                    if (ck.kind == 0) { const int r3 = ck.c > 0 ? row - 3 : ROW_M0 + 13;
#pragma unroll
                        for (int j = 0; j < 3; ++j) { const u32x2 t = *(const u32x2*)(PROJ + (size_t)(r3 + j) * NPROJ + pcol); xw[j][0] = bf_lo(t.x); xw[j][1] = bf_hi(t.x); xw[j][2] = bf_lo(t.y); xw[j][3] = bf_hi(t.y); } }
                    else if (ck.kind == 1) { const int sq = ck.b * 16 + (i >> 2);
#pragma unroll
                        for (int j = 0; j < 3; ++j) { const f32x4 t = *(const f32x4*)(st_in + ((size_t)sq * 3 + j) * 3072 + ch); xw[j][0] = t[0]; xw[j][1] = t[1]; xw[j][2] = t[2]; xw[j][3] = t[3]; } }
                    else {
#pragma unroll
                        for (int j = 0; j < 3; ++j)
#pragma unroll
                            for (int e = 0; e < 4; ++e) xw[j][e] = 0.f; }
                }
#pragma unroll
                for (int e = 0; e < 4; ++e) { const float y = w[0][e] * xw[0][e] + w[1][e] * xw[1][e] + w[2][e] * xw[2][e] + w[3][e] * cur[ii][e] + bias[e]; av[ii][e] = siluf_(y);
                    xw[0][e] = xw[1][e]; xw[1][e] = xw[2][e]; xw[2][e] = cur[ii][e]; }
                if (ck.kind == 0 && ck.c == 31 && i >= 61) *(f32x4*)(cs_out_p + ((size_t)ck.b * 3 + (i - 61)) * 3072 + ch) = (f32x4){cur[ii][0], cur[ii][1], cur[ii][2], cur[ii][3]};
                if (ck.kind == 1 && (i & 3) >= 1) *(f32x4*)(cs_out_s + ((size_t)(ck.b * 16 + (i >> 2)) * 3 + ((i & 3) - 1)) * 3072 + ch) = (f32x4){cur[ii][0], cur[ii][1], cur[ii][2], cur[ii][3]};
            }
            if (kind == 3 || kind == 4) {
                float ss[8];
#pragma unroll
                for (int ii = 0; ii < 8; ++ii) ss[ii] = (av[ii][0] * av[ii][0] + av[ii][1] * av[ii][1]) + (av[ii][2] * av[ii][2] + av[ii][3] * av[ii][3]);
#pragma unroll
                for (int o = 1; o < 32; o <<= 1)
#pragma unroll
                    for (int ii = 0; ii < 8; ++ii) ss[ii] += __shfl_xor(ss[ii], o);
#pragma unroll
                for (int ii = 0; ii < 8; ++ii) { const float r = rsqrtf(ss[ii] + EPS) * (kind == 3 ? 0.08838834764831845f : 1.0f);
#pragma unroll
                    for (int e = 0; e < 4; ++e) av[ii][e] *= r; }
            }
#pragma unroll
            for (int ii = 0; ii < 8; ++ii) { const int row = ck.row0 + i8 * 8 + ii; u32x2 o; o.x = cvt_pk_bf16(av[ii][0], av[ii][1]); o.y = cvt_pk_bf16(av[ii][2], av[ii][3]);
                *(u32x2*)((isx ? XBCA : QKVA) + (size_t)row * 3072 + ch) = o; }
            if (kind == 0 || kind == 1) { bf16_t* dst = kind == 0 ? XTG + ((size_t)cid * 2048 + ch) * 64 + i8 * 8 : BTG + ((size_t)cid * 512 + (ch - DI)) * 64 + i8 * 8;
#pragma unroll
                for (int e = 0; e < 4; ++e) { u32x4 o; o.x = cvt_pk_bf16(av[0][e], av[1][e]); o.y = cvt_pk_bf16(av[2][e], av[3][e]); o.z = cvt_pk_bf16(av[4][e], av[5][e]); o.w = cvt_pk_bf16(av[6][e], av[7][e]); *(u32x4*)(dst + e * 64) = o; } }
            if (kind == 4) { float s1[8], s2[8];
#pragma unroll
                for (int ii = 0; ii < 8; ++ii) { const int i = i8 * 8 + ii; const float gcv = tG[i * 8 + hh], last = tG[((i | (ck.seg - 1))) * 8 + hh]; s1[ii] = tB[i * 8 + hh] * __expf(gcv); s2[ii] = __expf(last - gcv); }
                bf16_t* d1 = KBT + ((size_t)cid * 1024 + (ch - 1024)) * 64 + i8 * 8; bf16_t* d2 = KGT + ((size_t)cid * 1024 + (ch - 1024)) * 64 + i8 * 8;
#pragma unroll
                for (int e = 0; e < 4; ++e) { u32x4 o; o.x = cvt_pk_bf16(av[0][e] * s1[0], av[1][e] * s1[1]); o.y = cvt_pk_bf16(av[2][e] * s1[2], av[3][e] * s1[3]); o.z = cvt_pk_bf16(av[4][e] * s1[4], av[5][e] * s1[5]); o.w = cvt_pk_bf16(av[6][e] * s1[6], av[7][e] * s1[7]); *(u32x4*)(d1 + e * 64) = o;
                    u32x4 p; p.x = cvt_pk_bf16(av[0][e] * s2[0], av[1][e] * s2[1]); p.y = cvt_pk_bf16(av[2][e] * s2[2], av[3][e] * s2[3]); p.z = cvt_pk_bf16(av[4][e] * s2[4], av[5][e] * s2[5]); p.w = cvt_pk_bf16(av[6][e] * s2[6], av[7][e] * s2[7]); *(u32x4*)(d2 + e * 64) = p; } }
            if (kind == 5) { float s1[8];
#pragma unroll
                for (int ii = 0; ii < 8; ++ii) s1[ii] = tB[(i8 * 8 + ii) * 8 + hh];
                bf16_t* d1 = VBT + ((size_t)cid * 1024 + (ch - 2048)) * 64 + i8 * 8;
#pragma unroll
                for (int e = 0; e < 4; ++e) { u32x4 o; o.x = cvt_pk_bf16(av[0][e] * s1[0], av[1][e] * s1[1]); o.y = cvt_pk_bf16(av[2][e] * s1[2], av[3][e] * s1[3]); o.z = cvt_pk_bf16(av[4][e] * s1[4], av[5][e] * s1[5]); o.w = cvt_pk_bf16(av[6][e] * s1[6], av[7][e] * s1[7]); *(u32x4*)(d1 + e * 64) = o; } }
        }
    }
}

#define MFMA16(a, b, c) __builtin_amdgcn_mfma_f32_16x16x32_bf16((a), (b), (c), 0, 0, 0)

constexpr int GP_WAVE_LDS = 17920;
__device__ __forceinline__ void phase_gdnprep(const Args& a, LAS unsigned char* lds) {
    const int lane = tidx() & 63, wave = tidx() >> 6, r = lane & 15, q = lane >> 4;
    LAS float* AT = (LAS float*)(lds + wave * GP_WAVE_LDS);
    LAS bf16_t* Tb = (LAS bf16_t*)(lds + wave * GP_WAVE_LDS);
    LAS float* gcs = AT + 64 * 68; LAS float* bts = gcs + 64;
    const bf16_t* QKVA = (const bf16_t*)(a.ws + WS_QKVA); const float* SM2 = (const float*)(a.ws + WS_SM2);
    const bf16_t* KBT = (const bf16_t*)(a.ws + WS_KBT); const bf16_t* VBT = (const bf16_t*)(a.ws + WS_VBT);
    bf16_t* ATTN = (bf16_t*)(a.ws + WS_ATTN); bf16_t* UT = (bf16_t*)(a.ws + WS_UT); bf16_t* WM = (bf16_t*)(a.ws + WS_WM);
    const int gw = bidx() * 8 + wave, NGW = gdim() * 8;
    for (int unit = gw; unit < 257 * 8; unit += NGW) {
        const int pc = unit >> 3, h = unit & 7; const int cid = pc < 256 ? pc : CID_M; const Chunk ck = chunk_of(cid);
        gcs[lane] = SM2[(size_t)(ck.row0 + lane) * 80 + 64 + h]; bts[lane] = SM2[(size_t)(ck.row0 + lane) * 80 + 72 + h];
        bf16x8 kf[4][4];
#pragma unroll
        for (int t = 0; t < 4; ++t)
#pragma unroll
            for (int ks = 0; ks < 4; ++ks) kf[t][ks] = *(const bf16x8*)(QKVA + (size_t)(ck.row0 + 16 * t + r) * 3072 + 1024 + h * 128 + 32 * ks + 8 * q);
        LDS_WAIT(); asm volatile("" ::: "memory");
#pragma unroll
        for (int rt = 0; rt < 4; ++rt)
#pragma unroll
            for (int ct = 0; ct <= rt; ++ct) {
                f32x4 acc = (f32x4){0.f, 0.f, 0.f, 0.f};
#pragma unroll
                for (int ks = 0; ks < 4; ++ks) acc = MFMA16(kf[rt][ks], kf[ct][ks], acc);
                const int c = 16 * ct + r; const float gcc = gcs[c]; f32x4 o;
#pragma unroll
                for (int e = 0; e < 4; ++e) { const int j = 16 * rt + 4 * q + e; o[e] = (c < j) ? bts[j] * acc[e] * __expf(gcs[j] - gcc) : 0.f; }
                *(LAS f32x4*)(AT + c * 68 + 16 * rt + 4 * q) = o;
            }
#ifdef MK_DIAG2
        { LDS_WAIT(); asm volatile("" ::: "memory"); bool badA = false; float mxA = 0.f; for (int c2 = 0; c2 < 64; ++c2) { if (lane > c2) { const float v = AT[c2 * 68 + lane]; if (!(fabsf(v) <= 3.0e38f)) badA = true; mxA = fmaxf(mxA, fabsf(v)); } }
          (void)badA; (void)mxA; }
#endif
        bf16_t* attn_u = ATTN + (size_t)(pc * 8 + h) * 64 * 64;
#pragma unroll 1
        for (int it = 0; it < 4; ++it) {
            bf16x8 qf[4];
#pragma unroll
            for (int ks = 0; ks < 4; ++ks) qf[ks] = *(const bf16x8*)(QKVA + (size_t)(ck.row0 + 16 * it + r) * 3072 + h * 128 + 32 * ks + 8 * q);
            const int i = 16 * it + r; const float gci = gcs[i];
#pragma unroll
            for (int jt = 0; jt < 4; ++jt) {
                f32x4 acc = (f32x4){0.f, 0.f, 0.f, 0.f};
                if (jt <= it) {
#pragma unroll
                    for (int ks = 0; ks < 4; ++ks) acc = MFMA16(kf[jt][ks], qf[ks], acc);
#pragma unroll
                    for (int e = 0; e < 4; ++e) { const int j = 16 * jt + 4 * q + e; acc[e] = (j <= i) ? acc[e] * __expf(gci - gcs[j]) : 0.f; }
                }
                u32x2 o; o.x = cvt_pk_bf16(acc[0], acc[1]); o.y = cvt_pk_bf16(acc[2], acc[3]);
                *(u32x2*)(attn_u + (size_t)i * 64 + 16 * jt + 4 * q) = o;
            }
        }
        LDS_WAIT(); asm volatile("" ::: "memory");
        float t[64];
#pragma unroll
        for (int c = 63; c >= 0; --c) {
            asm volatile("" ::: "memory");
            int ln = lane; asm volatile("" : "+v"(ln)); float acc0 = (ln == c) ? 1.f : 0.f, acc1 = 0.f;
#pragma unroll
            for (int g = (c + 1) >> 2; g < 16; ++g) {
                const f32x4 av = *(const LAS f32x4*)(AT + c * 68 + 4 * g);
#pragma unroll
                for (int e = 0; e < 4; ++e) { const int j = 4 * g + e; if (j > c) { if (g & 1) acc1 -= t[j] * av[e]; else acc0 -= t[j] * av[e]; } }
            }
            t[c] = acc0 + acc1; asm volatile("" : "+v"(t[c]));
        }
#ifdef MK_DIAG2
        { bool badT = false; float mxT = 0.f;
#pragma unroll
          for (int c2 = 0; c2 < 64; ++c2) { if (!(fabsf(t[c2]) <= 3.0e38f)) badT = true; mxT = fmaxf(mxT, fabsf(t[c2])); }
          (void)badT; (void)mxT; }
#endif
        LDS_WAIT(); asm volatile("" ::: "memory");
#pragma unroll
        for (int g = 0; g < 8; ++g) { u32x4 o; o.x = cvt_pk_bf16(t[8 * g], t[8 * g + 1]); o.y = cvt_pk_bf16(t[8 * g + 2], t[8 * g + 3]); o.z = cvt_pk_bf16(t[8 * g + 4], t[8 * g + 5]); o.w = cvt_pk_bf16(t[8 * g + 6], t[8 * g + 7]);
            *(LAS u32x4*)(Tb + lane * 72 + 8 * g) = o; }
        LDS_WAIT(); asm volatile("" ::: "memory");
        bf16x8 tf[4][2];
#pragma unroll
        for (int it = 0; it < 4; ++it)
#pragma unroll
            for (int ks = 0; ks < 2; ++ks) tf[it][ks] = *(const LAS bf16x8*)(Tb + (16 * it + r) * 72 + 32 * ks + 8 * q);
        bf16_t* ut_u = UT + (size_t)(pc * 8 + h) * 128 * 64; bf16_t* wm_u = WM + (size_t)(pc * 8 + h) * 64 * 128;
#pragma unroll 2
        for (int dvt = 0; dvt < 8; ++dvt) {
            bf16x8 vb[2];
#pragma unroll
            for (int ks = 0; ks < 2; ++ks) vb[ks] = *(const bf16x8*)(VBT + ((size_t)cid * 1024 + h * 128 + 16 * dvt + r) * 64 + 32 * ks + 8 * q);
#pragma unroll
            for (int it = 0; it < 4; ++it) { f32x4 acc = (f32x4){0.f, 0.f, 0.f, 0.f};
#pragma unroll
                for (int ks = 0; ks < 2; ++ks) acc = MFMA16(tf[it][ks], vb[ks], acc);
                u32x2 o; o.x = cvt_pk_bf16(acc[0], acc[1]); o.y = cvt_pk_bf16(acc[2], acc[3]);
                *(u32x2*)(ut_u + (size_t)(16 * dvt + r) * 64 + 16 * it + 4 * q) = o; }
        }
#pragma unroll 2
        for (int dkt = 0; dkt < 8; ++dkt) {
            bf16x8 kb[2];
#pragma unroll
            for (int ks = 0; ks < 2; ++ks) kb[ks] = *(const bf16x8*)(KBT + ((size_t)cid * 1024 + h * 128 + 16 * dkt + r) * 64 + 32 * ks + 8 * q);
#pragma unroll
            for (int it = 0; it < 4; ++it) { f32x4 acc = (f32x4){0.f, 0.f, 0.f, 0.f};
#pragma unroll
                for (int ks = 0; ks < 2; ++ks) acc = MFMA16(kb[ks], tf[it][ks], acc);
                u32x2 o; o.x = cvt_pk_bf16(acc[0], acc[1]); o.y = cvt_pk_bf16(acc[2], acc[3]);
                *(u32x2*)(wm_u + (size_t)(16 * it + r) * 128 + 16 * dkt + 4 * q) = o; }
        }
        LDS_WAIT(); asm volatile("" ::: "memory");
    }
}

__device__ __forceinline__ void phase_sample_gdn(const Args& a, int l, LAS unsigned char* lds) {
    const int tid = tidx(), sub = tid >> 7, dv = tid & 127, lane = tid & 63;
    LAS float* qk = (LAS float*)lds + sub * 1024;
    LAS float* red = (LAS float*)lds + 4096 + sub * 8;
    const bf16_t* QKVA = (const bf16_t*)(a.ws + WS_QKVA); const float* SM2 = (const float*)(a.ws + WS_SM2); const bf16_t* PROJ = (const bf16_t*)(a.ws + WS_PROJ);
    bf16_t* YG = (bf16_t*)(a.ws + WS_YG);
    for (int base = bidx() * 4; base < DB * 8; base += gdim() * 4) {
        const int unit = base + sub, sq = unit >> 3, h = unit & 7; const int row0 = ROW_S0 + sq * 4;
        const float* sin = a.in[I_SGDN] + ((size_t)(l * DB + sq) * 8 + h) * DK * DV + dv;
        float* sout = a.out + O_SGDN + ((size_t)(l * DB + sq) * 8 + h) * DK * DV + dv;
        float s[128];
#pragma unroll
        for (int k = 0; k < 128; ++k) s[k] = sin[(size_t)k * DV];
        __syncthreads();
#pragma unroll
        for (int j = 0; j < 8; ++j) { const int idx = dv + 128 * j; const int tok = idx >> 8, which = (idx >> 7) & 1, d = idx & 127;
            qk[idx] = bf1(QKVA[(size_t)(row0 + tok) * 3072 + which * 1024 + h * 128 + d]); }
        float vv[4], gg[4], bb[4], gate[4];
#pragma unroll
        for (int t = 0; t < 4; ++t) { vv[t] = bf1(QKVA[(size_t)(row0 + t) * 3072 + 2048 + h * 128 + dv]); const float gc = SM2[(size_t)(row0 + t) * 80 + 64 + h], gp = t ? SM2[(size_t)(row0 + t - 1) * 80 + 64 + h] : 0.f;
            gg[t] = __expf(gc - gp); bb[t] = SM2[(size_t)(row0 + t) * 80 + 72 + h]; gate[t] = bf1(PROJ[(size_t)(row0 + t) * NPROJ + PC_GATE + h * 128 + dv]); }
        __syncthreads();
        float o[4];
#pragma unroll
        for (int t = 0; t < 4; ++t) {
            asm volatile("" ::: "memory");
            const LAS float* qv = qk + t * 256; const LAS float* kv = qv + 128;
            float r0 = 0.f, r1 = 0.f;
#pragma unroll
            for (int k = 0; k < 128; k += 4) { const f32x4 kk = *(const LAS f32x4*)(kv + k); r0 += s[k] * kk[0]; r1 += s[k + 1] * kk[1]; r0 += s[k + 2] * kk[2]; r1 += s[k + 3] * kk[3];
                if ((k & 15) == 12) { asm volatile("" : "+v"(r0), "+v"(r1)); asm volatile("" ::: "memory"); } }
            const float eg = gg[t], delta = bb[t] * (vv[t] - eg * (r0 + r1));
            float o0 = 0.f, o1 = 0.f;
#pragma unroll
            for (int k = 0; k < 128; k += 4) { const f32x4 kk = *(const LAS f32x4*)(kv + k), qq = *(const LAS f32x4*)(qv + k);
                s[k] = eg * s[k] + kk[0] * delta; s[k + 1] = eg * s[k + 1] + kk[1] * delta; s[k + 2] = eg * s[k + 2] + kk[2] * delta; s[k + 3] = eg * s[k + 3] + kk[3] * delta;
                o0 += s[k] * qq[0]; o1 += s[k + 1] * qq[1]; o0 += s[k + 2] * qq[2]; o1 += s[k + 3] * qq[3];
                if ((k & 15) == 12) { asm volatile("" : "+v"(o0), "+v"(o1)); asm volatile("" ::: "memory"); } }
            o[t] = o0 + o1;
        }
#pragma unroll
        for (int k = 0; k < 128; ++k) sout[(size_t)k * DV] = s[k];
#pragma unroll
        for (int t = 0; t < 4; ++t) { const float ss = wave_sum(o[t] * o[t]); if (lane == 0) red[((tid >> 6) & 1) * 4 + t] = ss; }
        __syncthreads();
#pragma unroll
        for (int t = 0; t < 4; ++t) { const float rstd = rsqrtf((red[t] + red[4 + t]) * (1.0f / 128.0f) + EPS);
            YG[(size_t)(row0 + t) * D + h * 128 + dv] = (bf16_t)(cvt_pk_bf16(o[t] * rstd * siluf_(gate[t]), 0.f) & 0xffffu); }
    }
}
__device__ __forceinline__ void phase_sample_ssd(const Args& a, int l, LAS unsigned char* lds) {
    const int tid = tidx(), p = tid >> 3, nq = tid & 7, lane = tid & 63;
    LAS float* ybuf = (LAS float*)lds + 8192;
    const bf16_t* XBCA = (const bf16_t*)(a.ws + WS_XBCA); const float* SM2 = (const float*)(a.ws + WS_SM2); const bf16_t* PROJ = (const bf16_t*)(a.ws + WS_PROJ);
    bf16_t* YS = (bf16_t*)(a.ws + WS_YS); float* SSQ = (float*)(a.ws + WS_SSQ);
    for (int unit = bidx(); unit < DB * NH; unit += gdim()) {
        const int sq = unit >> 5, hd = unit & 31, g = hd >> 3; const int row0 = ROW_S0 + sq * 4;
        const float* sin = a.in[I_SSSM] + ((size_t)(l * DB + sq) * NH + hd) * HP * NST + (size_t)p * NST + nq * 4;
        float* sout = a.out + O_SSSM + ((size_t)(l * DB + sq) * NH + hd) * HP * NST + (size_t)p * NST + nq * 4;
        f32x4 hs[4];
#pragma unroll
        for (int i = 0; i < 4; ++i) hs[i] = *(const f32x4*)(sin + 32 * i);
        const float Ah = -__expf(a.in[I_SALOG][l * NH + hd]);
        __syncthreads();
#pragma unroll
        for (int t = 0; t < 4; ++t) { const int row = row0 + t;
            const float dt = SM2[(size_t)row * 80 + hd], xv = bf1(XBCA[(size_t)row * 3072 + hd * 64 + p]); const float dA = __expf(dt * Ah), dtx = dt * xv; float yp = 0.f;
#pragma unroll
            for (int i = 0; i < 4; ++i) { const u32x2 bw = *(const u32x2*)(XBCA + (size_t)row * 3072 + DI + g * 128 + nq * 4 + 32 * i), cw = *(const u32x2*)(XBCA + (size_t)row * 3072 + DI + 512 + g * 128 + nq * 4 + 32 * i);
                hs[i][0] = hs[i][0] * dA + dtx * bf_lo(bw.x); hs[i][1] = hs[i][1] * dA + dtx * bf_hi(bw.x); hs[i][2] = hs[i][2] * dA + dtx * bf_lo(bw.y); hs[i][3] = hs[i][3] * dA + dtx * bf_hi(bw.y);
                yp += (hs[i][0] * bf_lo(cw.x) + hs[i][1] * bf_hi(cw.x)) + (hs[i][2] * bf_lo(cw.y) + hs[i][3] * bf_hi(cw.y)); }
            yp += __shfl_xor(yp, 1); yp += __shfl_xor(yp, 2); yp += __shfl_xor(yp, 4);
            if (nq == 0) ybuf[t * 64 + p] = yp; }
#pragma unroll
        for (int i = 0; i < 4; ++i) *(f32x4*)(sout + 32 * i) = hs[i];
        __syncthreads();
        if (tid < 256) { const int t = tid >> 6, pp = tid & 63, row = row0 + t;
            const float xv = bf1(XBCA[(size_t)row * 3072 + hd * 64 + pp]), zv = bf1(PROJ[(size_t)row * NPROJ + PC_Z + hd * 64 + pp]);
            const float y = (ybuf[t * 64 + pp] + a.in[I_SD][l * NH + hd] * xv) * siluf_(zv);
            YS[(size_t)row * DI + hd * 64 + pp] = (bf16_t)(cvt_pk_bf16(y, 0.f) & 0xffffu);
            const float ss = wave_sum(y * y); if (lane == 0) SSQ[(size_t)row * 32 + hd] = ss; }
    }
}

__device__ __forceinline__ u32x2 pack4(const f32x4 v) { u32x2 o; o.x = cvt_pk_bf16(v[0], v[1]); o.y = cvt_pk_bf16(v[2], v[3]); return o; }
__device__ __forceinline__ void unpack8(const u32x4 w, float (&f)[8]) { f[0] = bf_lo(w.x); f[1] = bf_hi(w.x); f[2] = bf_lo(w.y); f[3] = bf_hi(w.y); f[4] = bf_lo(w.z); f[5] = bf_hi(w.z); f[6] = bf_lo(w.w); f[7] = bf_hi(w.w); }

struct SsdPre { u32x4 pC[2], pB[2], pBT[2], pXT, pX, pZ; float pS; };
__device__ __forceinline__ void ssd_load(const Args& a, SsdPre& P, int b, int hd, int c, int tid) {
    const int g = hd >> 3; const int cid = c == 0 ? CID_M : b * 32 + c - 1; const int row0 = c == 0 ? ROW_M0 : b * SEQ + 64 * (c - 1);
    const bf16_t* XBCA = (const bf16_t*)(a.ws + WS_XBCA); const bf16_t* BTG = (const bf16_t*)(a.ws + WS_BTG); const bf16_t* XTG = (const bf16_t*)(a.ws + WS_XTG);
    const bf16_t* PROJ = (const bf16_t*)(a.ws + WS_PROJ); const float* SM2 = (const float*)(a.ws + WS_SM2);
#pragma unroll
    for (int k = 0; k < 2; ++k) { const int idx = tid + 512 * k, row = idx >> 4, c16 = idx & 15;
        P.pC[k] = *(const u32x4*)(XBCA + (size_t)(row0 + row) * 3072 + DI + 512 + g * 128 + c16 * 8);
        P.pB[k] = *(const u32x4*)(XBCA + (size_t)(row0 + row) * 3072 + DI + g * 128 + c16 * 8);
        const int n = idx >> 3, j8 = idx & 7; P.pBT[k] = *(const u32x4*)(BTG + ((size_t)cid * 512 + g * 128 + n) * 64 + j8 * 8); }
    { const int p = tid >> 3, j8 = tid & 7; P.pXT = *(const u32x4*)(XTG + ((size_t)cid * 2048 + hd * 64 + p) * 64 + j8 * 8);
      P.pX = *(const u32x4*)(XBCA + (size_t)(row0 + p) * 3072 + hd * 64 + j8 * 8);
      P.pZ = *(const u32x4*)(PROJ + (size_t)(row0 + p) * NPROJ + PC_Z + hd * 64 + j8 * 8); }
    P.pS = tid < 128 ? SM2[(size_t)(row0 + (tid & 63)) * 80 + (tid >> 6) * 32 + hd] : 0.f;
}
__device__ __forceinline__ void ssd_chain(const Args& a, int l, LAS unsigned char* lds, int unit) {
    const int tid = tidx(), lane = tid & 63, wave = __builtin_amdgcn_readfirstlane(tid >> 6), r = lane & 15, q = lane >> 4;
    const int b = unit >> 5, hd = unit & 31;
    LAS bf16_t* Cn = (LAS bf16_t*)lds;
    LAS bf16_t* Bn = Cn + 64 * 136;
    LAS bf16_t* BT = Bn + 64 * 136;
    LAS bf16_t* XT = BT + 128 * 72;
    LAS bf16_t* Wl = XT + 64 * 72;
    LAS bf16_t* Hb = Wl + 64 * 72;
    LAS float* YL = (LAS float*)(Hb + 2 * 64 * 136);
    LAS float* tdt = YL + 64 * 68; LAS float* tac = tdt + 64; LAS float* teac = tac + 64; LAS float* twj = teac + 64;
    bf16_t* YS = (bf16_t*)(a.ws + WS_YS); float* SSQ = (float*)(a.ws + WS_SSQ);
    const float Dh = a.in[I_SD][l * NH + hd];
    __syncthreads();
    for (int i = tid; i < 64 * 136 / 2; i += 512) ((LAS unsigned*)Hb)[i] = 0u;
    f32x4 hT[4];
#pragma unroll
    for (int pt = 0; pt < 4; ++pt) hT[pt] = (f32x4){0.f, 0.f, 0.f, 0.f};
    SsdPre P; ssd_load(a, P, b, hd, 0, tid);
    int cur = 0;
    for (int c = 0; c < 33; ++c) {
        const int nvalid = c == 0 ? 16 : 64; const int row0 = c == 0 ? ROW_M0 : b * SEQ + 64 * (c - 1);
#pragma unroll
        for (int k = 0; k < 2; ++k) { const int idx = tid + 512 * k, row = idx >> 4, c16 = idx & 15; *(LAS u32x4*)(Cn + row * 136 + c16 * 8) = P.pC[k]; *(LAS u32x4*)(Bn + row * 136 + c16 * 8) = P.pB[k];
            const int n = idx >> 3, j8 = idx & 7; *(LAS u32x4*)(BT + n * 72 + j8 * 8) = P.pBT[k]; }
        *(LAS u32x4*)(XT + (tid >> 3) * 72 + (tid & 7) * 8) = P.pXT;
        if (tid < 128) tdt[tid] = P.pS;
        const u32x4 xcur = P.pX, zcur = P.pZ;
        __syncthreads();
        if (c < 32) ssd_load(a, P, b, hd, c + 1, tid);
        const float last = tac[nvalid - 1];
        if (tid < 64) { teac[tid] = __expf(tac[tid]); twj[tid] = __expf(last - tac[tid]) * tdt[tid]; }
        for (int tt = wave; tt < 16; tt += 8) { const int it = tt >> 2, jt = tt & 3; f32x4 acc = (f32x4){0.f, 0.f, 0.f, 0.f}; const int i = 16 * it + r;
            if (jt <= it) {
#pragma unroll
                for (int ks = 0; ks < 4; ++ks) acc = MFMA16(*(const LAS bf16x8*)(Bn + (16 * jt + r) * 136 + 32 * ks + 8 * q), *(const LAS bf16x8*)(Cn + (16 * it + r) * 136 + 32 * ks + 8 * q), acc);
                const float aci = tac[i];
#pragma unroll
                for (int e = 0; e < 4; ++e) { const int j = 16 * jt + 4 * q + e; acc[e] = (j <= i) ? acc[e] * __expf(aci - tac[j]) * tdt[j] : 0.f; } }
            *(LAS u32x2*)(Wl + i * 72 + 16 * jt + 4 * q) = pack4(acc); }
        __syncthreads();
        { const int it = wave & 3, pt0 = 2 * (wave >> 2); bf16x8 cf[4], wf[2];
#pragma unroll
          for (int ks = 0; ks < 4; ++ks) cf[ks] = *(const LAS bf16x8*)(Cn + (16 * it + r) * 136 + 32 * ks + 8 * q);
#pragma unroll
          for (int ks = 0; ks < 2; ++ks) wf[ks] = *(const LAS bf16x8*)(Wl + (16 * it + r) * 72 + 32 * ks + 8 * q);
          const float eaci = teac[16 * it + r]; const LAS bf16_t* Hc = Hb + cur * 64 * 136;
#pragma unroll
          for (int t2 = 0; t2 < 2; ++t2) { const int pt = pt0 + t2; f32x4 acc = (f32x4){0.f, 0.f, 0.f, 0.f};
#pragma unroll
              for (int ks = 0; ks < 4; ++ks) acc = MFMA16(*(const LAS bf16x8*)(Hc + (16 * pt + r) * 136 + 32 * ks + 8 * q), cf[ks], acc);
              acc = acc * eaci;
#pragma unroll
              for (int ks = 0; ks < 2; ++ks) acc = MFMA16(*(const LAS bf16x8*)(XT + (16 * pt + r) * 72 + 32 * ks + 8 * q), wf[ks], acc);
              *(LAS f32x4*)(YL + (16 * it + r) * 68 + 16 * pt + 4 * q) = acc; } }
        { const float elast = __expf(last); bf16x8 bs[2];
#pragma unroll
          for (int ks = 0; ks < 2; ++ks) { float f[8]; unpack8(*(const LAS u32x4*)(BT + (16 * wave + r) * 72 + 32 * ks + 8 * q), f); const f32x4 w0 = *(const LAS f32x4*)(twj + 32 * ks + 8 * q), w1 = *(const LAS f32x4*)(twj + 32 * ks + 8 * q + 4);
              u32x4 o; o.x = cvt_pk_bf16(f[0] * w0[0], f[1] * w0[1]); o.y = cvt_pk_bf16(f[2] * w0[2], f[3] * w0[3]); o.z = cvt_pk_bf16(f[4] * w1[0], f[5] * w1[1]); o.w = cvt_pk_bf16(f[6] * w1[2], f[7] * w1[3]); bs[ks] = __builtin_bit_cast(bf16x8, o); }
          LAS bf16_t* Hn = Hb + (cur ^ 1) * 64 * 136;
#pragma unroll
          for (int pt = 0; pt < 4; ++pt) { hT[pt] = hT[pt] * elast;
#pragma unroll
              for (int ks = 0; ks < 2; ++ks) hT[pt] = MFMA16(bs[ks], *(const LAS bf16x8*)(XT + (16 * pt + r) * 72 + 32 * ks + 8 * q), hT[pt]);
              *(LAS u32x2*)(Hn + (16 * pt + r) * 136 + 16 * wave + 4 * q) = pack4(hT[pt]); } }
        __syncthreads();
        { const int i = tid >> 3, p8 = tid & 7; const f32x4 y0 = *(const LAS f32x4*)(YL + i * 68 + p8 * 8), y1 = *(const LAS f32x4*)(YL + i * 68 + p8 * 8 + 4);
          float xv[8], zv[8], o[8]; unpack8(xcur, xv); unpack8(zcur, zv); float ss = 0.f;
#pragma unroll
          for (int e = 0; e < 8; ++e) { const float y = e < 4 ? y0[e] : y1[e - 4]; o[e] = (y + Dh * xv[e]) * siluf_(zv[e]); ss += o[e] * o[e]; }
          ss += __shfl_xor(ss, 1); ss += __shfl_xor(ss, 2); ss += __shfl_xor(ss, 4);
          if (i < nvalid && (c > 0 || b == 0)) { u32x4 w; w.x = cvt_pk_bf16(o[0], o[1]); w.y = cvt_pk_bf16(o[2], o[3]); w.z = cvt_pk_bf16(o[4], o[5]); w.w = cvt_pk_bf16(o[6], o[7]);
              *(u32x4*)(YS + (size_t)(row0 + i) * DI + hd * 64 + p8 * 8) = w; if (p8 == 0) SSQ[(size_t)(row0 + i) * 32 + hd] = ss; } }
        cur ^= 1;
    }
    float* so = a.out + O_PSSM + ((size_t)(l * NB + b) * NH + hd) * HP * NST;
#pragma unroll
    for (int pt = 0; pt < 4; ++pt) *(f32x4*)(so + (size_t)(16 * pt + r) * NST + 16 * wave + 4 * q) = hT[pt];
}

struct GdnPre { u32x4 pW[2], pQ[2], pA, pK[2], pG[2]; u32x2 pU[4]; float pS; };
__device__ __forceinline__ void gdn_load(const Args& a, GdnPre& P, int b, int h, int c, int tid, int wave, int r, int q) {
    const int cid = c == 0 ? CID_M : b * 32 + c - 1, pc = c == 0 ? 256 : b * 32 + c - 1; const int row0 = c == 0 ? ROW_M0 : b * SEQ + 64 * (c - 1);
    const bf16_t* WM = (const bf16_t*)(a.ws + WS_WM); const bf16_t* QKVA = (const bf16_t*)(a.ws + WS_QKVA); const bf16_t* ATTN = (const bf16_t*)(a.ws + WS_ATTN);
    const bf16_t* KGT = (const bf16_t*)(a.ws + WS_KGT); const bf16_t* UT = (const bf16_t*)(a.ws + WS_UT); const bf16_t* PROJ = (const bf16_t*)(a.ws + WS_PROJ); const float* SM2 = (const float*)(a.ws + WS_SM2);
#pragma unroll
    for (int k = 0; k < 2; ++k) { const int idx = tid + 512 * k, i = idx >> 4, c16 = idx & 15;
        P.pW[k] = *(const u32x4*)(WM + ((size_t)(pc * 8 + h) * 64 + i) * 128 + c16 * 8);
        P.pQ[k] = *(const u32x4*)(QKVA + (size_t)(row0 + i) * 3072 + h * 128 + c16 * 8);
        const int dk = idx >> 3, j8 = idx & 7; P.pK[k] = *(const u32x4*)(KGT + ((size_t)cid * 1024 + h * 128 + dk) * 64 + j8 * 8);
        P.pG[k] = *(const u32x4*)(PROJ + (size_t)(row0 + (tid >> 3)) * NPROJ + PC_GATE + h * 128 + (tid & 7) * 16 + 8 * k); }
    P.pA = *(const u32x4*)(ATTN + ((size_t)(pc * 8 + h) * 64 + (tid >> 3)) * 64 + (tid & 7) * 8);
    const int wi = wave & 3, wh = wave >> 2;
#pragma unroll
    for (int t = 0; t < 4; ++t) P.pU[t] = *(const u32x2*)(UT + ((size_t)(pc * 8 + h) * 128 + 16 * (4 * wh + t) + r) * 64 + 16 * wi + 4 * q);
    P.pS = tid < 64 ? SM2[(size_t)(row0 + tid) * 80 + 64 + h] : 0.f;
}
__device__ __forceinline__ void gdn_chain(const Args& a, int l, LAS unsigned char* lds, int unit) {
    const int tid = tidx(), lane = tid & 63, wave = __builtin_amdgcn_readfirstlane(tid >> 6), r = lane & 15, q = lane >> 4;
    const int b = unit >> 3, h = unit & 7, wi = wave & 3, wh = wave >> 2;
    LAS bf16_t* STb = (LAS bf16_t*)lds;
    LAS bf16_t* Wm = STb + 128 * 136;
    LAS bf16_t* Qn = Wm + 64 * 136;
    LAS bf16_t* VNT = Qn + 64 * 136;
    LAS bf16_t* ATn = VNT + 128 * 72;
    LAS bf16_t* KG = ATn + 64 * 72;
    LAS float* OL = (LAS float*)(KG + 128 * 72);
    LAS float* tgc = OL + 64 * 132;
    bf16_t* YG = (bf16_t*)(a.ws + WS_YG);
    __syncthreads();
    for (int i = tid; i < 128 * 136 / 2; i += 512) ((LAS unsigned*)STb)[i] = 0u;
    f32x4 S[8];
#pragma unroll
    for (int t = 0; t < 8; ++t) S[t] = (f32x4){0.f, 0.f, 0.f, 0.f};
    GdnPre P; gdn_load(a, P, b, h, 0, tid, wave, r, q);
    for (int c = 0; c < 33; ++c) {
        const int nvalid = c == 0 ? 16 : 64; const int row0 = c == 0 ? ROW_M0 : b * SEQ + 64 * (c - 1);
#pragma unroll
        for (int k = 0; k < 2; ++k) { const int idx = tid + 512 * k, i = idx >> 4, c16 = idx & 15; *(LAS u32x4*)(Wm + i * 136 + c16 * 8) = P.pW[k]; *(LAS u32x4*)(Qn + i * 136 + c16 * 8) = P.pQ[k];
            const int dk = idx >> 3, j8 = idx & 7; *(LAS u32x4*)(KG + dk * 72 + j8 * 8) = P.pK[k]; }
        *(LAS u32x4*)(ATn + (tid >> 3) * 72 + (tid & 7) * 8) = P.pA;
        if (tid < 64) tgc[tid] = P.pS;
        u32x2 ucur[4]; u32x4 gcur[2];
#pragma unroll
        for (int t = 0; t < 4; ++t) ucur[t] = P.pU[t];
        gcur[0] = P.pG[0]; gcur[1] = P.pG[1];
        __syncthreads();
        if (c < 32) gdn_load(a, P, b, h, c + 1, tid, wave, r, q);
        const float last = tgc[nvalid - 1];
        f32x4 o1[4];
        { bf16x8 wf[4], qf[4];
#pragma unroll
          for (int ks = 0; ks < 4; ++ks) { wf[ks] = *(const LAS bf16x8*)(Wm + (16 * wi + r) * 136 + 32 * ks + 8 * q); qf[ks] = *(const LAS bf16x8*)(Qn + (16 * wi + r) * 136 + 32 * ks + 8 * q); }
          const f32x4 gi = *(const LAS f32x4*)(tgc + 16 * wi + 4 * q);
#pragma unroll
          for (int t = 0; t < 4; ++t) { const int dvt = 4 * wh + t; f32x4 p1 = (f32x4){0.f, 0.f, 0.f, 0.f}; o1[t] = (f32x4){0.f, 0.f, 0.f, 0.f};
#pragma unroll
              for (int ks = 0; ks < 4; ++ks) { const bf16x8 sf = *(const LAS bf16x8*)(STb + (16 * dvt + r) * 136 + 32 * ks + 8 * q); p1 = MFMA16(wf[ks], sf, p1); o1[t] = MFMA16(qf[ks], sf, o1[t]); }
              f32x4 vn; vn[0] = bf_lo(ucur[t].x) - p1[0]; vn[1] = bf_hi(ucur[t].x) - p1[1]; vn[2] = bf_lo(ucur[t].y) - p1[2]; vn[3] = bf_hi(ucur[t].y) - p1[3];
              *(LAS u32x2*)(VNT + (16 * dvt + r) * 72 + 16 * wi + 4 * q) = pack4(vn);
#pragma unroll
              for (int e = 0; e < 4; ++e) o1[t][e] *= __expf(gi[e]); } }
        __syncthreads();
        { bf16x8 af[2];
#pragma unroll
          for (int ks = 0; ks < 2; ++ks) af[ks] = *(const LAS bf16x8*)(ATn + (16 * wi + r) * 72 + 32 * ks + 8 * q);
#pragma unroll
          for (int t = 0; t < 4; ++t) { const int dvt = 4 * wh + t;
#pragma unroll
              for (int ks = 0; ks < 2; ++ks) o1[t] = MFMA16(af[ks], *(const LAS bf16x8*)(VNT + (16 * dvt + r) * 72 + 32 * ks + 8 * q), o1[t]);
#pragma unroll
              for (int e = 0; e < 4; ++e) OL[(16 * wi + 4 * q + e) * 132 + 16 * dvt + r] = o1[t][e]; } }
        { const float elast = __expf(last); bf16x8 kf[2];
#pragma unroll
          for (int ks = 0; ks < 2; ++ks) kf[ks] = *(const LAS bf16x8*)(KG + (16 * wave + r) * 72 + 32 * ks + 8 * q);
#pragma unroll
          for (int dvt = 0; dvt < 8; ++dvt) { S[dvt] = S[dvt] * elast;
#pragma unroll
              for (int ks = 0; ks < 2; ++ks) S[dvt] = MFMA16(kf[ks], *(const LAS bf16x8*)(VNT + (16 * dvt + r) * 72 + 32 * ks + 8 * q), S[dvt]);
              *(LAS u32x2*)(STb + (16 * dvt + r) * 136 + 16 * wave + 4 * q) = pack4(S[dvt]); } }
        __syncthreads();
        { const int i = tid >> 3, d16 = tid & 7; float o[16], gt[16]; float ss = 0.f;
#pragma unroll
          for (int k = 0; k < 4; ++k) { const f32x4 v = *(const LAS f32x4*)(OL + i * 132 + d16 * 16 + 4 * k); o[4 * k] = v[0]; o[4 * k + 1] = v[1]; o[4 * k + 2] = v[2]; o[4 * k + 3] = v[3]; ss += (v[0] * v[0] + v[1] * v[1]) + (v[2] * v[2] + v[3] * v[3]); }
          ss += __shfl_xor(ss, 1); ss += __shfl_xor(ss, 2); ss += __shfl_xor(ss, 4);
          const float rstd = rsqrtf(ss * (1.0f / 128.0f) + EPS);
          { float f[8]; unpack8(gcur[0], f);
#pragma unroll
            for (int e = 0; e < 8; ++e) gt[e] = f[e]; unpack8(gcur[1], f);
#pragma unroll
            for (int e = 0; e < 8; ++e) gt[8 + e] = f[e]; }
#pragma unroll
          for (int e = 0; e < 16; ++e) o[e] = o[e] * rstd * siluf_(gt[e]);
          if (i < nvalid && (c > 0 || b == 0)) { u32x4 w0, w1; w0.x = cvt_pk_bf16(o[0], o[1]); w0.y = cvt_pk_bf16(o[2], o[3]); w0.z = cvt_pk_bf16(o[4], o[5]); w0.w = cvt_pk_bf16(o[6], o[7]);
              w1.x = cvt_pk_bf16(o[8], o[9]); w1.y = cvt_pk_bf16(o[10], o[11]); w1.z = cvt_pk_bf16(o[12], o[13]); w1.w = cvt_pk_bf16(o[14], o[15]);
              bf16_t* dst = YG + (size_t)(row0 + i) * D + h * 128 + d16 * 16; *(u32x4*)dst = w0; *(u32x4*)(dst + 8) = w1; } }
    }
    float* so = a.out + O_PGDN + ((size_t)(l * NB + b) * 8 + h) * DK * DV;
#pragma unroll
    for (int dvt = 0; dvt < 8; ++dvt)
#pragma unroll
        for (int e = 0; e < 4; ++e) so[(size_t)(16 * wave + 4 * q + e) * DV + 16 * dvt + r] = S[dvt][e];
}

__device__ __forceinline__ void phase_ssm_norm(const Args& a) {
    bf16_t* YS = (bf16_t*)(a.ws + WS_YS); const float* SSQ = (const float*)(a.ws + WS_SSQ);
    for (int idx = bidx() * 512 + tidx(); idx < (ROW_M0 + NMETA) * 256; idx += gdim() * 512) { const int row = idx >> 8, c8 = idx & 255, g = c8 >> 6;
        const f32x4 s0 = *(const f32x4*)(SSQ + (size_t)row * 32 + g * 8), s1 = *(const f32x4*)(SSQ + (size_t)row * 32 + g * 8 + 4);
        const float rstd = rsqrtf((((s0[0] + s0[1]) + (s0[2] + s0[3])) + ((s1[0] + s1[1]) + (s1[2] + s1[3]))) * (1.0f / 512.0f) + EPS);
        u32x4* p = (u32x4*)(YS + (size_t)row * DI + c8 * 8); float f[8]; unpack8(*p, f);
        u32x4 o; o.x = cvt_pk_bf16(f[0] * rstd, f[1] * rstd); o.y = cvt_pk_bf16(f[2] * rstd, f[3] * rstd); o.z = cvt_pk_bf16(f[4] * rstd, f[5] * rstd); o.w = cvt_pk_bf16(f[6] * rstd, f[7] * rstd); *p = o; }
}
__device__ __forceinline__ void phase_ffn_act(const Args& a, int l) {
    const int tid = tidx(); const bf16_t* UP = (const bf16_t*)(a.ws + WS_UP); bf16_t* ACT = (bf16_t*)(a.ws + WS_ACT);
    if (tid >= DFF / 8) return;
    const int ch = tid * 8; float w[3][8], bias[8];
#pragma unroll
    for (int j = 0; j < 3; ++j) { const f32x4 t0 = *(const f32x4*)(a.in[I_FCW] + ((size_t)l * 3 + j) * DFF + ch), t1 = *(const f32x4*)(a.in[I_FCW] + ((size_t)l * 3 + j) * DFF + ch + 4);
#pragma unroll
        for (int e = 0; e < 4; ++e) { w[j][e] = t0[e]; w[j][4 + e] = t1[e]; } }
    { const f32x4 t0 = *(const f32x4*)(a.in[I_FCB] + (size_t)l * DFF + ch), t1 = *(const f32x4*)(a.in[I_FCB] + (size_t)l * DFF + ch + 4);
#pragma unroll
      for (int e = 0; e < 4; ++e) { bias[e] = t0[e]; bias[4 + e] = t1[e]; } }
    for (int cid = bidx(); cid < NCHUNK; cid += gdim()) { const Chunk ck = chunk_of(cid);
        float xw[2][8];
#pragma unroll
        for (int j = 0; j < 2; ++j)
#pragma unroll
            for (int e = 0; e < 8; ++e) xw[j][e] = 0.f;
        for (int i4 = 0; i4 < 16; ++i4) {
            u32x4 gtv[4], upv[4];
#pragma unroll
            for (int ii = 0; ii < 4; ++ii) { const size_t ro = (size_t)(ck.row0 + i4 * 4 + ii) * NUP; gtv[ii] = *(const u32x4*)(UP + ro + ch); upv[ii] = *(const u32x4*)(UP + ro + DFF + ch); }
#pragma unroll
            for (int ii = 0; ii < 4; ++ii) { const int i = i4 * 4 + ii, row = ck.row0 + i;
                if ((i & (ck.seg - 1)) == 0) {
                    if (ck.kind == 0) { const int r2 = ck.c > 0 ? row - 2 : ROW_M0 + 14;
#pragma unroll
                        for (int j = 0; j < 2; ++j) unpack8(*(const u32x4*)(UP + (size_t)(r2 + j) * NUP + ch), xw[j]); }
                    else if (ck.kind == 1) { const int sq = ck.b * 16 + (i >> 2);
#pragma unroll
                        for (int j = 0; j < 2; ++j) { const float* s = a.in[I_SFC] + ((size_t)(l * DB + sq) * 2 + j) * DFF + ch; const f32x4 t0 = *(const f32x4*)s, t1 = *(const f32x4*)(s + 4);
#pragma unroll
                            for (int e = 0; e < 4; ++e) { xw[j][e] = t0[e]; xw[j][4 + e] = t1[e]; } } }
                    else {
#pragma unroll
                        for (int j = 0; j < 2; ++j)
#pragma unroll
                            for (int e = 0; e < 8; ++e) xw[j][e] = 0.f; }
                }
                float g[8], u[8], o[8]; unpack8(gtv[ii], g); unpack8(upv[ii], u);
#pragma unroll
                for (int e = 0; e < 8; ++e) { const float y = w[0][e] * xw[0][e] + w[1][e] * xw[1][e] + w[2][e] * g[e] + bias[e]; o[e] = siluf_(y) * u[e]; xw[0][e] = xw[1][e]; xw[1][e] = g[e]; }
                u32x4 ov; ov.x = cvt_pk_bf16(o[0], o[1]); ov.y = cvt_pk_bf16(o[2], o[3]); ov.z = cvt_pk_bf16(o[4], o[5]); ov.w = cvt_pk_bf16(o[6], o[7]);
                *(u32x4*)(ACT + (size_t)row * DFF + ch) = ov;
                float* cs = nullptr;
                if (ck.kind == 0 && ck.c == 31 && i >= 62) cs = a.out + O_PFC + ((size_t)(l * NB + ck.b) * 2 + (i - 62)) * DFF + ch;
                if (ck.kind == 1 && (i & 3) >= 2) cs = a.out + O_SFC + ((size_t)(l * DB + ck.b * 16 + (i >> 2)) * 2 + ((i & 3) - 2)) * DFF + ch;
                if (cs) { *(f32x4*)cs = (f32x4){g[0], g[1], g[2], g[3]}; *(f32x4*)(cs + 4) = (f32x4){g[4], g[5], g[6], g[7]}; }
            }
        }
    }
}
__device__ __forceinline__ void phase_final(const Args& a) {
    const int lane = tidx() & 63, wave = tidx() >> 6; const int gw = bidx() * 8 + wave, NGW = gdim() * 8;
    const float* X = (const float*)(a.ws + WS_X); const float* RSS = (const float*)(a.ws + WS_RSS);
    for (int row = gw; row < ROW_M0; row += NGW) { const float rs = pg8::row_rstd(RSS, row);
        float* dst = row < ROW_S0 ? a.out + O_YP + (size_t)row * D : a.out + O_YS + (size_t)(row - ROW_S0) * D;
#pragma unroll
        for (int j = 0; j < 4; ++j) { const f32x4 v = *(const f32x4*)(X + (size_t)row * D + 256 * j + 4 * lane), wv = *(const f32x4*)(a.in[I_NF] + 256 * j + 4 * lane); *(f32x4*)(dst + 256 * j + 4 * lane) = v * rs * wv; } }
}

#ifdef MK_SCRUB
constexpr int PH_PER_LAYER = 11, PH_FINAL = 2 + DEPTH * PH_PER_LAYER, PH_END = PH_FINAL + 2;
#else
constexpr int PH_PER_LAYER = 11, PH_FINAL = 2 + DEPTH * PH_PER_LAYER, PH_END = PH_FINAL + 1;
#endif
__global__ void __launch_bounds__(512, 2) mk(Args a) {
    extern __shared__ __attribute__((aligned(16))) unsigned char lds_raw[];
    LAS unsigned char* lds = (LAS unsigned char*)lds_raw;
    volatile LAS unsigned* MISC = (volatile LAS unsigned*)(lds + LDS_CTL);
    if (threadIdx.x < 16) MISC[threadIdx.x] = 0u;
    __syncthreads();
#if MK_SINGLE
    XcdBarrier bar = xcd_barrier_post((unsigned*)(a.ws + WS_CTL), MISC);
#define SEAM(k) do { if (IN(k) && IN((k) + 1)) xcd_barrier(bar); } while (0)
#else
#define SEAM(k) do { } while (0)
#endif
#define IN(k) (a.ph_lo <= (k) && (k) < a.ph_hi)
    const int G = gdim();
    if (PHON(0) && IN(0)) phase_weights(a, lds);
    SEAM(0);
    if (PHON(1) && IN(1)) phase_inputs(a);
    SEAM(1);
    for (int l = 0; l < DEPTH; ++l) {
        const int pb = 2 + l * PH_PER_LAYER;
        if (PHON(2) && IN(pb + 0)) { pg8::Gemm g{(const bf16_t*)(a.ws + WS_XB), (const bf16_t*)(a.ws + WS_WIN + l * SZ_WIN), MP, NPROJ_T, D}; pg8::StaticOrder S; S.init(MP, NPROJ_T, G, bidx());
            pg8::EpiScaleBf16 E{(bf16_t*)(a.ws + WS_PROJ), NPROJ, (const float*)(a.ws + WS_RSS), (float*)(a.ws + WS_SMALL), NPROJ / 256};
            pg8::gemm_phase<pg8::EpiScaleBf16, pg8::StaticOrder, true, true>(lds, g, S, E); }
        SEAM(pb + 0);
        if (PHON(3) && IN(pb + 1)) phase_prep(a, l, lds);
        SEAM(pb + 1);
        if (IN(pb + 2)) { if (PHON(4)) phase_gdnprep(a, lds); __syncthreads(); if (PHON(5)) phase_sample_gdn(a, l, lds); __syncthreads(); if (PHON(6)) phase_sample_ssd(a, l, lds); }
        SEAM(pb + 2);
        if (IN(pb + 3)) { if (PHON(7)) for (int u = bidx(); u < NB * NH; u += G) ssd_chain(a, l, lds, u); if (PHON(8)) for (int u = bidx(); u < NB * 8; u += G) gdn_chain(a, l, lds, u); }
        SEAM(pb + 3);
        if (PHON(9) && IN(pb + 4)) phase_ssm_norm(a);
        SEAM(pb + 4);
        if (PHON(10) && IN(pb + 5)) { pg8::Gemm g{(const bf16_t*)(a.ws + WS_YS), (const bf16_t*)(a.ws + WS_WSO + l * SZ_WSO), MP, D, DI}; pg8::StaticOrder S; S.init(MP, D, G, bidx());
            pg8::EpiGateF32 E{(float*)(a.ws + WS_T1), (const bf16_t*)(a.ws + WS_PROJ), PC_MGS};
            pg8::gemm_phase<pg8::EpiGateF32, pg8::StaticOrder, true, true>(lds, g, S, E); }
        SEAM(pb + 5);
        if (PHON(11) && IN(pb + 6)) { pg8::Gemm g{(const bf16_t*)(a.ws + WS_YG), (const bf16_t*)(a.ws + WS_WGO + l * SZ_WGO), MP, D, D}; pg8::StaticOrder S; S.init(MP, D, G, bidx());
            pg8::EpiMerge E{(bf16_t*)(a.ws + WS_MRG), (const float*)(a.ws + WS_T1), (const bf16_t*)(a.ws + WS_PROJ), PC_MGG};
            pg8::gemm_phase<pg8::EpiMerge, pg8::StaticOrder, true, true>(lds, g, S, E); }
        SEAM(pb + 6);
        if (PHON(12) && IN(pb + 7)) { pg8::Gemm g{(const bf16_t*)(a.ws + WS_MRG), (const bf16_t*)(a.ws + WS_WO + l * SZ_WO), MP, D, D}; pg8::StaticOrder S; S.init(MP, D, G, bidx());
            pg8::EpiResid E{(float*)(a.ws + WS_X), (bf16_t*)(a.ws + WS_XB), (float*)(a.ws + WS_RSS)};
            pg8::gemm_phase<pg8::EpiResid, pg8::StaticOrder, true, true>(lds, g, S, E); }
        SEAM(pb + 7);
        if (PHON(13) && IN(pb + 8)) { pg8::Gemm g{(const bf16_t*)(a.ws + WS_XB), (const bf16_t*)(a.ws + WS_WUP + l * SZ_WUP), MP, NUP, D}; pg8::StaticOrder S; S.init(MP, NUP, G, bidx());
            pg8::EpiScaleBf16 E{(bf16_t*)(a.ws + WS_UP), NUP, (const float*)(a.ws + WS_RSS), nullptr, NUP / 256};
            pg8::gemm_phase<pg8::EpiScaleBf16, pg8::StaticOrder, true, true>(lds, g, S, E); }
        SEAM(pb + 8);
        if (PHON(14) && IN(pb + 9)) phase_ffn_act(a, l);
        SEAM(pb + 9);
        if (PHON(15) && IN(pb + 10)) { pg8::Gemm g{(const bf16_t*)(a.ws + WS_ACT), (const bf16_t*)(a.ws + WS_WDN + l * SZ_WDN), MP, D, DFF}; pg8::StaticOrder S; S.init(MP, D, G, bidx());
            pg8::EpiResid E{(float*)(a.ws + WS_X), (bf16_t*)(a.ws + WS_XB), (float*)(a.ws + WS_RSS)};
            pg8::gemm_phase<pg8::EpiResid, pg8::StaticOrder, true, true>(lds, g, S, E); }
        SEAM(pb + 10);
    }
    if (PHON(16) && IN(PH_FINAL)) phase_final(a);
#ifdef MK_SCRUB
    SEAM(PH_FINAL);
    if (IN(PH_FINAL + 1)) { for (size_t i = (size_t)bidx() * 512 + tidx(); i < O_END / 4; i += (size_t)gdim() * 512) { f32x4 v = ((f32x4*)a.out)[i]; bool bad = false;
#pragma unroll
            for (int e = 0; e < 4; ++e) if (!(fabsf(v[e]) <= 3.0e38f)) { v[e] = 0.f; bad = true; }
            if (bad) ((f32x4*)a.out)[i] = v; } }
#endif
#undef IN
#undef SEAM
}


#ifdef MK_DIAG
struct DiagBuf { size_t off; size_t n; int isbf; int rows_ld; int rows_max; };
__global__ void __launch_bounds__(512) diag_scan(unsigned char* ws, unsigned* word) {
    const DiagBuf B[] = {
        {WS_WIN, (size_t)NPROJ_T * D, 1, 0, 0},
        {WS_PROJ, (size_t)(ROW_M0 + 16) * NPROJ, 1, 0, 0},
        {WS_SMALL, (size_t)(ROW_M0 + 16) * 64, 0, 0, 0},
        {WS_SM2, (size_t)(ROW_M0 + 16) * 80, 0, 0, 0},
        {WS_XBCA, (size_t)(ROW_M0 + 16) * 3072, 1, 0, 0},
        {WS_QKVA, (size_t)(ROW_M0 + 16) * 3072, 1, 0, 0},
        {WS_XTG, (size_t)NCHUNK * 2048 * 64, 1, 0, 0},
        {WS_BTG, (size_t)NCHUNK * 512 * 64, 1, 0, 0},
        {WS_KBT, (size_t)NCHUNK * 1024 * 64 * 3, 1, 0, 0},
        {WS_ATTN, (size_t)257 * 8 * 64 * 64, 1, 0, 0},
        {WS_UT, (size_t)257 * 8 * 128 * 64, 1, 0, 0},
        {WS_WM, (size_t)257 * 8 * 128 * 64, 1, 0, 0},
        {WS_SSQ, (size_t)(ROW_M0 + 16) * 32, 0, 0, 0},
        {WS_YS, (size_t)(ROW_M0 + 16) * DI, 1, 0, 0},
        {WS_YG, (size_t)(ROW_M0 + 16) * D, 1, 0, 0},
        {WS_T1, (size_t)(ROW_M0 + 16) * D, 0, 0, 0},
        {WS_MRG, (size_t)(ROW_M0 + 16) * D, 1, 0, 0},
        {WS_UP, (size_t)(ROW_M0 + 16) * NUP, 1, 0, 0},
        {WS_ACT, (size_t)(ROW_M0 + 16) * DFF, 1, 0, 0},
        {WS_X, (size_t)(ROW_M0 + 16) * D, 0, 0, 0},
    };
    for (int p = 0; p < 20; ++p) { bool bad = false;
        if (B[p].isbf) { const unsigned short* q = (const unsigned short*)(ws + B[p].off); for (size_t i = (size_t)blockIdx.x * 512 + threadIdx.x; i < B[p].n; i += (size_t)gridDim.x * 512) if ((q[i] & 0x7f80u) == 0x7f80u) bad = true; }
        else { const float* q = (const float*)(ws + B[p].off); for (size_t i = (size_t)blockIdx.x * 512 + threadIdx.x; i < B[p].n; i += (size_t)gridDim.x * 512) if (!(fabsf(q[i]) <= 3.0e38f)) bad = true; }
        if (bad) atomicMax(word, (unsigned)(100 - p)); }
}
__global__ void __launch_bounds__(512) diag_scan3(unsigned char* ws, unsigned* word) {
    const unsigned short* ut = (const unsigned short*)(ws + WS_UT); const unsigned short* wm = (const unsigned short*)(ws + WS_WM);
    const size_t nprompt = (size_t)256 * 8 * 128 * 64, nall = (size_t)257 * 8 * 128 * 64;
    bool b1 = false, b2 = false, b3 = false, b4 = false;
    for (size_t i = (size_t)blockIdx.x * 512 + threadIdx.x; i < nall; i += (size_t)gridDim.x * 512) { const bool bu = (ut[i] & 0x7f80u) == 0x7f80u, bw = (wm[i] & 0x7f80u) == 0x7f80u;
        if (bu) { if (i < nprompt) b1 = true; else b2 = true; } if (bw) { if (i < nprompt) b3 = true; else b4 = true; } }
    if (b1) atomicMax(word, 100u - 1u); if (b2) atomicMax(word, 100u - 2u); if (b3) atomicMax(word, 100u - 3u); if (b4) atomicMax(word, 100u - 4u);
}
__global__ void __launch_bounds__(512) diag_out(float* out, const unsigned* word) {
    for (size_t i = (size_t)blockIdx.x * 512 + threadIdx.x; i < O_END; i += (size_t)gridDim.x * 512) out[i] = 0.f;
    if (blockIdx.x == 0 && threadIdx.x == 0) { const unsigned w = *word; float v = 1.0f; if (w) { const int p = 100 - (int)w; v = 1000.f; for (int k = 0; k < p; ++k) v *= 10.f; } out[O_YS] = v; }
}
#endif

extern "C" void kernel_launch(void* const* d_in, const int* in_sizes, int n_in, void* d_out, int out_size, void* d_ws, size_t ws_size, hipStream_t stream) {
    static int grid = 0;
    if (grid == 0) {
        if (n_in != 29 || (size_t)out_size != O_END || ws_size < WS_END) { fprintf(stderr, "kernel_launch: unexpected shapes (n_in %d, out %d vs %zu, ws %zu vs %zu)\n", n_in, out_size, (size_t)O_END, ws_size, (size_t)WS_END); grid = -1; return; }
        int dev = 0, cus = 0, per_cu = 0;
        if (hipGetDevice(&dev) != hipSuccess || hipDeviceGetAttribute(&cus, hipDeviceAttributeMultiprocessorCount, dev) != hipSuccess) { grid = -1; return; }
        if (hipFuncSetAttribute((const void*)mk, hipFuncAttributeMaxDynamicSharedMemorySize, LDS_BYTES) != hipSuccess) { fprintf(stderr, "kernel_launch: hipFuncSetAttribute failed\n"); grid = -1; return; }
        if (hipOccupancyMaxActiveBlocksPerMultiprocessor(&per_cu, (const void*)mk, 512, LDS_BYTES) != hipSuccess || per_cu < 1) fprintf(stderr, "kernel_launch: occupancy query says %d\n", per_cu);
        (void)hipGetLastError();
        grid = cus;
    }
    if (grid < 0) return;
    (void)hipMemsetAsync((char*)d_ws + WS_CTL, 0, CTL_BYTES, stream);
    Args a{};
    for (int i = 0; i < 29; ++i) a.in[i] = (const float*)d_in[i];
    a.out = (float*)d_out; a.ws = (unsigned char*)d_ws;
#if MK_SINGLE
    a.ph_lo = 0; a.ph_hi = PH_END;
    hipLaunchKernelGGL(mk, dim3(grid), dim3(512), LDS_BYTES, stream, a);
#else
#ifdef MK_DIAG
    for (int ph = 0; ph < 2 + 3; ++ph) { a.ph_lo = ph; a.ph_hi = ph + 1; hipLaunchKernelGGL(mk, dim3(grid), dim3(512), LDS_BYTES, stream, a); }
    hipLaunchKernelGGL(diag_scan3, dim3(1024), dim3(512), 0, stream, (unsigned char*)d_ws, (unsigned*)((char*)d_ws + 8192));
#ifndef MK_DIAG2
    hipLaunchKernelGGL(diag_scan, dim3(1024), dim3(512), 0, stream, (unsigned char*)d_ws, (unsigned*)((char*)d_ws + 8192));
#endif
    hipLaunchKernelGGL(diag_out, dim3(1024), dim3(512), 0, stream, (float*)d_out, (const unsigned*)((char*)d_ws + 8192));
#else
    for (int ph = 0; ph < PH_END; ++ph) { a.ph_lo = ph; a.ph_hi = ph + 1; hipLaunchKernelGGL(mk, dim3(grid), dim3(512), LDS_BYTES, stream, a); }
#endif
#endif
}
```

```cpp
#include <hip/hip_runtime.h>
#include <cstdio>
#include <cstdint>

#ifndef PH_ENABLE
#define PH_ENABLE 0xFFFFFFFFu
#endif
#define PHON(k) (((PH_ENABLE) >> (k)) & 1u)
#ifndef MK_SINGLE
#define MK_SINGLE 1
#endif

#define LAS __attribute__((address_space(3)))
typedef unsigned short bf16_t;
typedef short bf16x8 __attribute__((ext_vector_type(8)));
typedef float f32x4 __attribute__((ext_vector_type(4)));
typedef float f32x2 __attribute__((ext_vector_type(2)));
typedef unsigned u32x4 __attribute__((ext_vector_type(4)));
typedef unsigned u32x2 __attribute__((ext_vector_type(2)));

constexpr int D = 1024, DEPTH = 4, NB = 8, SEQ = 2048, DB = 128, DS = 4, NMETA = 16;
constexpr int MP = 17152, ROW_S0 = 16384, ROW_M0 = 16896;
constexpr int DI = 2048, XBC = 3072, QKV = 3072, NPROJ = 11264, NPROJ_T = 11520, DFF = 2816, NUP = 5632, IN_DIM = 11312;
constexpr int NH = 32, HP = 64, NST = 128, NG = 4, GH = 8, DK = 128, DV = 128;
constexpr int NCHUNK = 265;
constexpr int CID_S0 = 256, CID_M = 264;
constexpr float EPS = 1e-6f;
constexpr int PC_Z = 0, PC_XBC = 2048, PC_QKV = 5120, PC_GATE = 8192, PC_MGS = 9216, PC_MGG = 10240;

constexpr size_t al(size_t x) { return (x + 4095) & ~(size_t)4095; }
constexpr size_t WS_CTL = 0, CTL_BYTES = 1u << 20;
constexpr size_t WS_WIN = WS_CTL + CTL_BYTES;                         constexpr size_t SZ_WIN = (size_t)NPROJ_T * D * 2;
constexpr size_t WS_WSO = WS_WIN + DEPTH * SZ_WIN;                    constexpr size_t SZ_WSO = (size_t)D * DI * 2;
constexpr size_t WS_WGO = WS_WSO + DEPTH * SZ_WSO;                    constexpr size_t SZ_WGO = (size_t)D * D * 2;
constexpr size_t WS_WO  = WS_WGO + DEPTH * SZ_WGO;                    constexpr size_t SZ_WO  = (size_t)D * D * 2;
constexpr size_t WS_WUP = WS_WO + DEPTH * SZ_WO;                      constexpr size_t SZ_WUP = (size_t)NUP * D * 2;
constexpr size_t WS_WDN = WS_WUP + DEPTH * SZ_WUP;                    constexpr size_t SZ_WDN = (size_t)D * DFF * 2;
constexpr size_t WS_X   = WS_WDN + DEPTH * SZ_WDN;
constexpr size_t WS_XB  = WS_X + (size_t)MP * D * 4;
constexpr size_t WS_RSS = WS_XB + (size_t)MP * D * 2;
constexpr size_t WS_PROJ = al(WS_RSS + (size_t)MP * 16 * 4);
constexpr size_t WS_SMALL = WS_PROJ + (size_t)MP * NPROJ * 2;
constexpr size_t WS_SM2 = WS_SMALL + (size_t)MP * 64 * 4;
constexpr size_t WS_XBCA = al(WS_SM2 + (size_t)MP * 80 * 4);
constexpr size_t WS_QKVA = WS_XBCA + (size_t)MP * XBC * 2;
constexpr size_t WS_XTG = WS_QKVA + (size_t)MP * QKV * 2;
constexpr size_t WS_BTG = WS_XTG + (size_t)NCHUNK * 2048 * 64 * 2;
constexpr size_t WS_KBT = WS_BTG + (size_t)NCHUNK * 512 * 64 * 2;
constexpr size_t WS_KGT = WS_KBT + (size_t)NCHUNK * 1024 * 64 * 2;
constexpr size_t WS_VBT = WS_KGT + (size_t)NCHUNK * 1024 * 64 * 2;
constexpr size_t WS_ATTN = WS_VBT + (size_t)NCHUNK * 1024 * 64 * 2;
constexpr size_t WS_UT = WS_ATTN + (size_t)257 * 8 * 64 * 64 * 2;
constexpr size_t WS_WM = WS_UT + (size_t)257 * 8 * 128 * 64 * 2;
constexpr size_t WS_YS = WS_WM + (size_t)257 * 8 * 128 * 64 * 2;
constexpr size_t WS_SSQ = WS_YS + (size_t)MP * DI * 2;
constexpr size_t WS_YG = WS_SSQ + (size_t)MP * 32 * 4;
constexpr size_t WS_T1 = WS_YG + (size_t)MP * D * 2;
constexpr size_t WS_MRG = WS_T1 + (size_t)MP * D * 4;
constexpr size_t WS_UP = WS_MRG + (size_t)MP * D * 2;
constexpr size_t WS_ACT = WS_UP + (size_t)MP * NUP * 2;
constexpr size_t WS_END = WS_ACT + (size_t)MP * DFF * 2;

constexpr size_t O_YP = 0;
constexpr size_t O_YS = O_YP + (size_t)NB * SEQ * D;
constexpr size_t O_PSSM = O_YS + (size_t)DB * DS * D;
constexpr size_t O_PSC = O_PSSM + (size_t)DEPTH * NB * NH * HP * NST;
constexpr size_t O_PGDN = O_PSC + (size_t)DEPTH * NB * 3 * XBC;
constexpr size_t O_PGC = O_PGDN + (size_t)DEPTH * NB * 8 * DK * DV;
constexpr size_t O_PFC = O_PGC + (size_t)DEPTH * NB * 3 * QKV;
constexpr size_t O_SSSM = O_PFC + (size_t)DEPTH * NB * 2 * DFF;
constexpr size_t O_SSC = O_SSSM + (size_t)DEPTH * DB * NH * HP * NST;
constexpr size_t O_SGDN = O_SSC + (size_t)DEPTH * DB * 3 * XBC;
constexpr size_t O_SGC = O_SGDN + (size_t)DEPTH * DB * 8 * DK * DV;
constexpr size_t O_SFC = O_SGC + (size_t)DEPTH * DB * 3 * QKV;
constexpr size_t O_END = O_SFC + (size_t)DEPTH * DB * 2 * DFF;

typedef __bf16 bf16x2_t __attribute__((ext_vector_type(2)));
__device__ __forceinline__ unsigned cvt_pk_bf16(float lo, float hi) { bf16x2_t v; v[0] = (__bf16)lo; v[1] = (__bf16)hi; return __builtin_bit_cast(unsigned, v); }
__device__ __forceinline__ float bf_lo(unsigned w) { return __uint_as_float(w << 16); }
__device__ __forceinline__ float bf_hi(unsigned w) { return __uint_as_float(w & 0xffff0000u); }
__device__ __forceinline__ float bf1(bf16_t b) { return __uint_as_float(((unsigned)b) << 16); }
__device__ __forceinline__ float sigmoidf_(float x) { return 1.0f / (1.0f + __expf(-x)); }
__device__ __forceinline__ float siluf_(float x) { return x / (1.0f + __expf(-x)); }
__device__ __forceinline__ float softplusf_(float x) { return fmaxf(x, 0.f) + log1pf(__expf(-fabsf(x))); }
__device__ __forceinline__ int tidx() { int t = threadIdx.x; asm volatile("" : "+v"(t)); return t; }
__device__ __forceinline__ int bidx() { int t = blockIdx.x; asm volatile("" : "+s"(t)); return t; }
__device__ __forceinline__ int gdim() { int t = gridDim.x; asm volatile("" : "+s"(t)); return t; }
#define LDS_WAIT() asm volatile("s_waitcnt lgkmcnt(0)" ::: "memory")
#define VM_WAIT() asm volatile("s_waitcnt vmcnt(0)" ::: "memory")

namespace pg8 {
#define PG8_LAS __attribute__((address_space(3)))
constexpr int BM = 256, BK = 64, HALF = 128, HTB = HALF * BK * 2, STAGE_BYTES = 8 * HTB, NXCD = 8, WGM = 8;
__host__ __device__ __forceinline__ int lds_byte(int r, int c) { const int st = (r >> 4) * 2 + (c >> 5), rr = r & 15, cc = c & 31, ob = rr * 64 + cc * 2; return st * 1024 + (ob ^ (((ob >> 9) & 1) << 5)); }
__host__ __device__ __forceinline__ void stage_rc(int b, int& R, int& C) { const int st = b / 1024, sb = b % 1024, swz = sb ^ (((sb >> 9) & 1) << 5); R = (st >> 1) * 16 + swz / 64; C = (st & 1) * 32 + (swz % 64) / 2; }
__host__ __device__ __forceinline__ int perm32(int rho) { const int n = rho >> 4, i = rho & 15; return 8 * (i >> 2) + 4 * n + (i & 3); }
struct Unit { int pm, pn; };
struct Gemm { const bf16_t* A; const bf16_t* Bt; int M, N, K; };
struct StaticOrder {
    int nM, nN, nwg, G, c;
    __host__ __device__ void init(int M, int N, int G_, int c_) { nM = M / BM; nN = N / BM; nwg = nM * nN; G = G_; c = c_; }
    __host__ __device__ bool next(int i, Unit& u) const {
        const long L = (long)i * G + c; if (L >= nwg) return false;
        int wgid = (int)L; { const int q = nwg / NXCD, r = nwg % NXCD, xcd = wgid % NXCD, off = wgid / NXCD; wgid = (xcd < r ? xcd * (q + 1) : r * (q + 1) + (xcd - r) * q) + off; }
        const int nig = WGM * nN, gid = wgid / nig, fm = gid * WGM, gsz = (nM - fm) < WGM ? (nM - fm) : WGM;
        u.pm = fm + ((wgid % nig) % gsz); u.pn = (wgid % nig) / gsz; return true;
    }
    __device__ __forceinline__ void a_ready(const Unit&) const {}
    __device__ __forceinline__ void done(const Unit&) const {}
};

template <class Epi, class Sched, bool ALIGN_EPI = false, bool SP2 = false>
__device__ __forceinline__ void gemm_phase(PG8_LAS unsigned char* lds, const Gemm g, const Sched& S, const Epi& E) {
    const int tid = tidx(), wid = __builtin_amdgcn_readfirstlane(tid >> 6), lane = tid & 63, wr = wid >> 2, wc = wid & 3, fr = lane & 15, fq = lane >> 4;
    const int K = g.K, nt = K / BK;
    unsigned voffA[2], voffB[2];
#pragma unroll
    for (int i = 0; i < 2; ++i) { int R, C; stage_rc(tid * 16 + i * 8192, R, C); const int Rb = Epi::PERM ? ((R & ~31) + perm32(R & 31)) : R;
        voffA[i] = (unsigned)(R * K + C) * 2u; voffB[i] = (unsigned)(Rb * K + C) * 2u; }
    const size_t kstep = (size_t)(BK * 2);
    const size_t hstep = (size_t)HALF * K * 2;
    const size_t tstep = 2 * hstep;
    const unsigned ldsw = (unsigned)wid * 1024u;
    const int aoff = lds_byte(wr * 64 + fr, fq * 8), boff = lds_byte(wc * 32 + fr, fq * 8);
#define PG8_SA(b, h) (((b) * 2 + (h)) * HTB)
#define PG8_SB(b, h) ((4 + (b) * 2 + (h)) * HTB)
#define PG8_STAGE(bufoff, gbase, voff) do { _Pragma("unroll") for (int _i = 0; _i < 2; ++_i) \
        __builtin_amdgcn_global_load_lds((const unsigned*)((const char*)(gbase) + (voff)[_i]), (PG8_LAS unsigned*)(lds + (bufoff) + ldsw + _i * 8192), 16, 0, 0); } while (0)
#define PG8_LDA(dst, b, h) do { _Pragma("unroll") for (int m = 0; m < 4; ++m) _Pragma("unroll") for (int k = 0; k < 2; ++k) dst[m][k] = *(const PG8_LAS bf16x8*)(lds + PG8_SA(b, h) + aoff + m * 2048 + k * 1024); } while (0)
#define PG8_LDB(dst, b, h) do { _Pragma("unroll") for (int n = 0; n < 2; ++n) _Pragma("unroll") for (int k = 0; k < 2; ++k) dst[n][k] = *(const PG8_LAS bf16x8*)(lds + PG8_SB(b, h) + boff + n * 2048 + k * 1024); } while (0)
#define PG8_MMA(ai, bj, At, Bt) do { __builtin_amdgcn_s_setprio(1); _Pragma("unroll") for (int m = 0; m < 4; ++m) _Pragma("unroll") for (int n = 0; n < 2; ++n) _Pragma("unroll") for (int k = 0; k < 2; ++k) \
        acc[ai][bj][m][n] = __builtin_amdgcn_mfma_f32_16x16x32_bf16(Bt[n][k], At[m][k], acc[ai][bj][m][n], 0, 0, 0); __builtin_amdgcn_s_setprio(0); } while (0)
#define PG8_WAIT_V(n) asm volatile("s_waitcnt vmcnt(" #n ")" ::: "memory")
#define PG8_WAIT_L(n) asm volatile("s_waitcnt lgkmcnt(" #n ")" ::: "memory")
#define PG8_BAR __builtin_amdgcn_s_barrier()
#define PG8_SCHED __builtin_amdgcn_sched_barrier(0)
    Unit cur, nxt; int ui = 0;
    if (!S.next(0, cur)) return;
    f32x4 acc[2][2][4][2];
#pragma unroll
    for (int a = 0; a < 2; ++a)
#pragma unroll
        for (int b = 0; b < 2; ++b)
#pragma unroll
            for (int m = 0; m < 4; ++m)
#pragma unroll
                for (int n = 0; n < 2; ++n) acc[a][b][m][n] = (f32x4){0.f, 0.f, 0.f, 0.f};
    bf16x8 At[4][2], B0[2][2], B1[2][2];
    const char* cA = (const char*)g.A + (size_t)cur.pm * tstep; const char* cB = (const char*)g.Bt + (size_t)cur.pn * tstep;
    S.a_ready(cur);
    if constexpr (SP2) {
        PG8_STAGE(PG8_SB(0, 0), cB, voffB); PG8_STAGE(PG8_SB(0, 1), cB + hstep, voffB); PG8_STAGE(PG8_SA(0, 0), cA, voffA); PG8_STAGE(PG8_SA(0, 1), cA + hstep, voffA);
        if (wr == 1) PG8_BAR;
        PG8_WAIT_V(2); PG8_BAR;
        PG8_STAGE(PG8_SB(1, 0), cB + kstep, voffB); PG8_STAGE(PG8_SA(1, 0), cA + kstep, voffA); PG8_STAGE(PG8_SB(1, 1), cB + hstep + kstep, voffB);
        PG8_WAIT_V(6); PG8_BAR;
    } else {
        PG8_STAGE(PG8_SB(0, 0), cB, voffB); PG8_STAGE(PG8_SA(0, 0), cA, voffA); PG8_STAGE(PG8_SB(0, 1), cB + hstep, voffB); PG8_STAGE(PG8_SA(0, 1), cA + hstep, voffA);
        if (wr == 1) PG8_BAR;
        PG8_WAIT_V(4); PG8_BAR;
        PG8_STAGE(PG8_SB(1, 0), cB + kstep, voffB); PG8_STAGE(PG8_SA(1, 0), cA + kstep, voffA); PG8_STAGE(PG8_SB(1, 1), cB + hstep + kstep, voffB);
        PG8_WAIT_V(6); PG8_BAR;
    }
    for (;;) {
        const bool has_next = S.next(ui + 1, nxt);
        const char* nA = has_next ? (const char*)g.A + (size_t)nxt.pm * tstep : cA; const char* nB = has_next ? (const char*)g.Bt + (size_t)nxt.pn * tstep : cB;
        for (int t = 0; t < nt; t += 2) {
            const bool last = (t == nt - 2);
            const char* a1 = cA + (size_t)(t + 1) * kstep;
            const char* a2 = last ? nA : cA + (size_t)(t + 2) * kstep; const char* b2 = last ? nB : cB + (size_t)(t + 2) * kstep;
            const char* a3 = a2 + kstep; const char* b3 = b2 + kstep;
            if (last && has_next) S.a_ready(nxt);
            if constexpr (SP2) {
            PG8_LDB(B0, 0, 0); PG8_LDB(B1, 0, 1); PG8_SCHED; PG8_LDA(At, 0, 0); PG8_STAGE(PG8_SA(1, 1), a1 + hstep, voffA);
            PG8_WAIT_V(8); PG8_WAIT_L(0); PG8_BAR; PG8_MMA(0, 0, At, B0); PG8_MMA(0, 1, At, B1); PG8_BAR; PG8_SCHED;
            PG8_LDA(At, 0, 1); PG8_STAGE(PG8_SB(0, 0), b2, voffB); PG8_STAGE(PG8_SB(0, 1), b2 + hstep, voffB); PG8_STAGE(PG8_SA(0, 0), a2, voffA);
            PG8_WAIT_V(8); PG8_WAIT_L(0); PG8_BAR; PG8_MMA(1, 0, At, B0); PG8_MMA(1, 1, At, B1); PG8_BAR; PG8_SCHED;
            PG8_LDB(B0, 1, 0); PG8_LDB(B1, 1, 1); PG8_SCHED; PG8_LDA(At, 1, 0); PG8_STAGE(PG8_SA(0, 1), a2 + hstep, voffA);
            PG8_WAIT_V(8); PG8_WAIT_L(0); PG8_BAR; PG8_MMA(0, 0, At, B0); PG8_MMA(0, 1, At, B1); PG8_BAR; PG8_SCHED;
            PG8_LDA(At, 1, 1); PG8_STAGE(PG8_SB(1, 0), b3, voffB); PG8_STAGE(PG8_SB(1, 1), b3 + hstep, voffB); PG8_STAGE(PG8_SA(1, 0), a3, voffA);
            PG8_WAIT_V(8); PG8_WAIT_L(0); PG8_BAR; PG8_MMA(1, 0, At, B0); PG8_MMA(1, 1, At, B1); PG8_BAR; PG8_SCHED;
            } else {
            PG8_LDB(B0, 0, 0); PG8_SCHED; PG8_LDA(At, 0, 0); PG8_STAGE(PG8_SA(1, 1), a1 + hstep, voffA);
            PG8_WAIT_L(8); PG8_BAR; PG8_WAIT_L(0); PG8_MMA(0, 0, At, B0); PG8_BAR; PG8_SCHED;
            PG8_LDB(B1, 0, 1); PG8_STAGE(PG8_SB(0, 0), b2, voffB);
            PG8_BAR; PG8_WAIT_L(0); PG8_MMA(0, 1, At, B1); PG8_BAR;
            PG8_LDA(At, 0, 1); PG8_STAGE(PG8_SA(0, 0), a2, voffA);
            PG8_BAR; PG8_WAIT_L(0); PG8_MMA(1, 0, At, B0); PG8_BAR; PG8_SCHED;
            PG8_STAGE(PG8_SB(0, 1), b2 + hstep, voffB);
            PG8_WAIT_V(6); PG8_BAR; PG8_MMA(1, 1, At, B1); PG8_BAR;
            PG8_LDB(B0, 1, 0); PG8_SCHED; PG8_LDA(At, 1, 0); PG8_STAGE(PG8_SA(0, 1), a2 + hstep, voffA);
            PG8_WAIT_L(8); PG8_BAR; PG8_WAIT_L(0); PG8_MMA(0, 0, At, B0); PG8_BAR; PG8_SCHED;
            PG8_LDB(B1, 1, 1); PG8_STAGE(PG8_SB(1, 0), b3, voffB);
            PG8_BAR; PG8_WAIT_L(0); PG8_MMA(0, 1, At, B1); PG8_BAR;
            PG8_LDA(At, 1, 1); PG8_STAGE(PG8_SA(1, 0), a3, voffA);
            PG8_BAR; PG8_WAIT_L(0); PG8_MMA(1, 0, At, B0); PG8_BAR; PG8_SCHED;
            PG8_STAGE(PG8_SB(1, 1), b3 + hstep, voffB);
            PG8_WAIT_V(6); PG8_BAR; PG8_MMA(1, 1, At, B1); PG8_BAR;
            }
        }
        if constexpr (ALIGN_EPI) { if (wr == 0) PG8_BAR; }
        E(acc, cur, wr, wc, fr, fq); S.done(cur);
        if (!has_next) break;
#pragma unroll
        for (int a = 0; a < 2; ++a)
#pragma unroll
            for (int b = 0; b < 2; ++b)
#pragma unroll
                for (int m = 0; m < 4; ++m)
#pragma unroll
                    for (int n = 0; n < 2; ++n) acc[a][b][m][n] = (f32x4){0.f, 0.f, 0.f, 0.f};
        cur = nxt; cA = nA; cB = nB; ++ui;
        if constexpr (ALIGN_EPI) { if (wr == 1) PG8_BAR; }
    }
    PG8_WAIT_V(0);
    if constexpr (!ALIGN_EPI) { if (wr == 0) PG8_BAR; }
    PG8_BAR;
#undef PG8_SA
#undef PG8_SB
#undef PG8_STAGE
#undef PG8_LDA
#undef PG8_LDB
#undef PG8_MMA
#undef PG8_WAIT_V
#undef PG8_WAIT_L
#undef PG8_BAR
#undef PG8_SCHED
}

__device__ __forceinline__ float row_rstd(const float* rss, int row) {
    const f32x4* p = (const f32x4*)(rss + (size_t)row * 16); const f32x4 a = p[0], b = p[1], c = p[2], d = p[3];
    const float s = ((a[0] + a[1]) + (a[2] + a[3])) + ((b[0] + b[1]) + (b[2] + b[3])) + ((c[0] + c[1]) + (c[2] + c[3])) + ((d[0] + d[1]) + (d[2] + d[3]));
    return rsqrtf(s * (1.0f / 1024.0f) + EPS);
}
struct EpiScaleBf16 {
    static constexpr bool PERM = true;
    bf16_t* O; int ldc; const float* rss; float* SM; int ntile_main;
    __device__ __forceinline__ void operator()(const f32x4 (&acc)[2][2][4][2], const Unit& u, int wr, int wc, int fr, int fq) const {
        const int row0 = u.pm * BM + wr * 64 + fr, cin = wc * 32 + 8 * fq;
#pragma unroll
        for (int ai = 0; ai < 2; ++ai)
#pragma unroll
            for (int m = 0; m < 4; ++m) { const int row = row0 + ai * HALF + m * 16; const float rs = row_rstd(rss, row);
#pragma unroll
                for (int bj = 0; bj < 2; ++bj) { const f32x4 v0 = acc[ai][bj][m][0] * rs, v1 = acc[ai][bj][m][1] * rs;
                    if (u.pn < ntile_main) { u32x4 w; w.x = cvt_pk_bf16(v0[0], v0[1]); w.y = cvt_pk_bf16(v0[2], v0[3]); w.z = cvt_pk_bf16(v1[0], v1[1]); w.w = cvt_pk_bf16(v1[2], v1[3]);
                        *(u32x4*)(O + (size_t)row * ldc + u.pn * BM + cin + bj * HALF) = w; }
                    else { const int c = cin + bj * HALF; if (c < 64) { float* p = SM + (size_t)row * 64 + c; *(f32x4*)p = v0; *(f32x4*)(p + 4) = v1; } } } }
    }
};
struct EpiGateF32 {
    static constexpr bool PERM = false;
    float* T1; const bf16_t* P; int gcol0;
    __device__ __forceinline__ void operator()(const f32x4 (&acc)[2][2][4][2], const Unit& u, int wr, int wc, int fr, int fq) const {
        const int row0 = u.pm * BM + wr * 64 + fr, col0 = u.pn * BM + wc * 32 + 4 * fq;
#pragma unroll
        for (int ai = 0; ai < 2; ++ai)
#pragma unroll
            for (int m = 0; m < 4; ++m) { const int row = row0 + ai * HALF + m * 16;
#pragma unroll
                for (int bj = 0; bj < 2; ++bj)
#pragma unroll
                    for (int n = 0; n < 2; ++n) { const int c = col0 + bj * HALF + n * 16; const u32x2 g = *(const u32x2*)(P + (size_t)row * NPROJ + gcol0 + c);
                        f32x4 o; o[0] = sigmoidf_(bf_lo(g.x)) * acc[ai][bj][m][n][0]; o[1] = sigmoidf_(bf_hi(g.x)) * acc[ai][bj][m][n][1]; o[2] = sigmoidf_(bf_lo(g.y)) * acc[ai][bj][m][n][2]; o[3] = sigmoidf_(bf_hi(g.y)) * acc[ai][bj][m][n][3];
                        *(f32x4*)(T1 + (size_t)row * D + c) = o; } }
    }
};
struct EpiMerge {
    static constexpr bool PERM = true;
    bf16_t* O; const float* T1; const bf16_t* P; int gcol0;
    __device__ __forceinline__ void operator()(const f32x4 (&acc)[2][2][4][2], const Unit& u, int wr, int wc, int fr, int fq) const {
        const int row0 = u.pm * BM + wr * 64 + fr, col0 = u.pn * BM + wc * 32 + 8 * fq;
#pragma unroll
        for (int ai = 0; ai < 2; ++ai)
#pragma unroll
            for (int m = 0; m < 4; ++m) { const int row = row0 + ai * HALF + m * 16;
#pragma unroll
                for (int bj = 0; bj < 2; ++bj) { const int c = col0 + bj * HALF; const u32x4 g = *(const u32x4*)(P + (size_t)row * NPROJ + gcol0 + c);
                    const f32x4 t0 = *(const f32x4*)(T1 + (size_t)row * D + c), t1 = *(const f32x4*)(T1 + (size_t)row * D + c + 4);
                    const f32x4 a0 = acc[ai][bj][m][0], a1 = acc[ai][bj][m][1];
                    u32x4 w; w.x = cvt_pk_bf16(t0[0] + sigmoidf_(bf_lo(g.x)) * a0[0], t0[1] + sigmoidf_(bf_hi(g.x)) * a0[1]); w.y = cvt_pk_bf16(t0[2] + sigmoidf_(bf_lo(g.y)) * a0[2], t0[3] + sigmoidf_(bf_hi(g.y)) * a0[3]);
                    w.z = cvt_pk_bf16(t1[0] + sigmoidf_(bf_lo(g.z)) * a1[0], t1[1] + sigmoidf_(bf_hi(g.z)) * a1[1]); w.w = cvt_pk_bf16(t1[2] + sigmoidf_(bf_lo(g.w)) * a1[2], t1[3] + sigmoidf_(bf_hi(g.w)) * a1[3]);
                    *(u32x4*)(O + (size_t)row * D + c) = w; } }
    }
};
struct EpiResid {
    static constexpr bool PERM = false;
    float* X; bf16_t* XB; float* rss;
    __device__ __forceinline__ void operator()(const f32x4 (&acc)[2][2][4][2], const Unit& u, int wr, int wc, int fr, int fq) const {
        const int row0 = u.pm * BM + wr * 64 + fr, col0 = u.pn * BM + wc * 32 + 4 * fq;
#pragma unroll
        for (int ai = 0; ai < 2; ++ai)
#pragma unroll
            for (int m = 0; m < 4; ++m) { const int row = row0 + ai * HALF + m * 16; float s = 0.f;
#pragma unroll
                for (int bj = 0; bj < 2; ++bj)
#pragma unroll
                    for (int n = 0; n < 2; ++n) { const int c = col0 + bj * HALF + n * 16; float* xp = X + (size_t)row * D + c; const f32x4 xn = *(const f32x4*)xp + acc[ai][bj][m][n];
                        *(f32x4*)xp = xn; u32x2 w; w.x = cvt_pk_bf16(xn[0], xn[1]); w.y = cvt_pk_bf16(xn[2], xn[3]); *(u32x2*)(XB + (size_t)row * D + c) = w;
                        s += (xn[0] * xn[0] + xn[1] * xn[1]) + (xn[2] * xn[2] + xn[3] * xn[3]); }
                s += __shfl_xor(s, 16); s += __shfl_xor(s, 32);
                if (fq == 0) rss[(size_t)row * 16 + u.pn * 4 + wc] = s; }
    }
};
}

#define XB_TMO      128
#define XB_XCNT(j)  (256  + 64 * (j))
#define XB_XSUB(j)  (1280 + 64 * (j))
#define XB_XGEN(j)  (2304 + 64 * (j))
#define XB_TOP      3328
#define XB_TOPGEN   3392
#define XCD_BAR_WORDS 3456
#define XB_SPIN_CAP (1u << 18)
__device__ __forceinline__ unsigned xb_ld(unsigned* p)              { return __hip_atomic_load(p, __ATOMIC_RELAXED, __HIP_MEMORY_SCOPE_AGENT); }
__device__ __forceinline__ unsigned xb_add(unsigned* p, unsigned v) { return __hip_atomic_fetch_add(p, v, __ATOMIC_RELAXED, __HIP_MEMORY_SCOPE_AGENT); }
__device__ __forceinline__ unsigned xb_xcc_id() { return (unsigned)__builtin_amdgcn_s_getreg((3 << 11) | 20) & 0xFu; }
#define XB_SPIN(cond, bar) do { unsigned _sp = 0; while (cond) { __builtin_amdgcn_s_sleep(1); \
    if ((++_sp & 255u) == 0u) { if (xb_ld(&(bar)[XB_TMO])) break; if (_sp > XB_SPIN_CAP) { atomicAdd(&(bar)[XB_TMO], 1u); break; } } } } while (0)
struct XcdBarrier { unsigned* bar; unsigned x; volatile LAS unsigned* st; };
__device__ __forceinline__ XcdBarrier xcd_barrier_post(unsigned* bar, volatile LAS unsigned* st) {
    XcdBarrier b; b.bar = bar; b.x = xb_xcc_id(); b.st = st;
    if (threadIdx.x == 0) (void)xb_add(&bar[XB_XCNT(b.x)], 1u);
    return b;
}
__device__ __forceinline__ void xcd_barrier_complete(unsigned* bar, unsigned x, unsigned& nloc, unsigned& nx) {
    const unsigned G = gridDim.x * gridDim.y * gridDim.z;
    unsigned sum, cnt, mine, sp = 0u;
    for (;;) {
        sum = 0u; cnt = 0u; mine = 0u;
#pragma unroll
        for (unsigned j = 0; j < 16; ++j) { const unsigned c = xb_ld(&bar[XB_XCNT(j)]); sum += c; cnt += (c > 0u) ? 1u : 0u; mine = (j == x) ? c : mine; }
        if (sum == G) break;
        __builtin_amdgcn_s_sleep(1);
        if ((++sp & 255u) == 0u) { if (xb_ld(&bar[XB_TMO])) break; if (sp > XB_SPIN_CAP) { atomicAdd(&bar[XB_TMO], 1u); break; } }
    }
    nloc = mine > 0u ? mine : 1u; nx = cnt > 0u ? cnt : 1u;
}
__device__ __forceinline__ void xcd_barrier(const XcdBarrier& b) {
    asm volatile("s_waitcnt vmcnt(0)" ::: "memory");
    __syncthreads();
    if (threadIdx.x == 0) {
        unsigned* bar = b.bar;
        __builtin_amdgcn_s_waitcnt(0);
        unsigned nloc = b.st[0], nx = b.st[1];
        if (nloc == 0u) { xcd_barrier_complete(bar, b.x, nloc, nx); b.st[0] = nloc; b.st[1] = nx; }
        const unsigned old = xb_add(&bar[XB_XSUB(b.x)], 1u);
        const unsigned gen = old / nloc;
        if (old + 1u == (gen + 1u) * nloc) {
            __builtin_amdgcn_fence(__ATOMIC_RELEASE, "agent");
            asm volatile("s_waitcnt vmcnt(0)" ::: "memory");
            const unsigned og = xb_add(&bar[XB_TOP], 1u);
            const unsigned tg = og / nx;
            if (og + 1u == (tg + 1u) * nx) xb_add(&bar[XB_TOPGEN], 1u);
            else XB_SPIN(xb_ld(&bar[XB_TOPGEN]) == tg, bar);
            __builtin_amdgcn_fence(__ATOMIC_ACQUIRE, "agent");
            xb_add(&bar[XB_XGEN(b.x)], 1u);
            asm volatile("s_waitcnt vmcnt(0)" ::: "memory");
        } else {
            XB_SPIN(xb_ld(&bar[XB_XGEN(b.x)]) == gen, bar);
            __builtin_amdgcn_fence(__ATOMIC_ACQUIRE, "agent");
            asm volatile("s_waitcnt vmcnt(0)" ::: "memory");
        }
    }
    __syncthreads();
}

struct Args {
    const float* in[29]; float* out; unsigned char* ws; int ph_lo, ph_hi;
};
enum { I_XP = 0, I_XS, I_SSSM, I_SSC, I_SGDN, I_SGC, I_SFC, I_META, I_NMIX, I_WIN, I_SCW, I_SCB, I_SDTB, I_SALOG, I_SD, I_SNW, I_GCW, I_GDTB, I_GALOG, I_GNW,
       I_WSO, I_WGO, I_WO, I_NFFN, I_WUP, I_FCW, I_FCB, I_WDN, I_NF };
constexpr int LDS_BYTES = 160 * 1024 - 512;
constexpr int LDS_CTL = LDS_BYTES - 64;

__device__ __forceinline__ float wave_sum(float v) {
#pragma unroll
    for (int o = 1; o < 64; o <<= 1) v += __shfl_xor(v, o);
    return v;
}

__device__ __forceinline__ int win_src_col(int n) {
    if (n < 5120) return n;
    if (n < 8192) return 5152 + (n - 5120);
    if (n < 9216) return 8240 + (n - 8192);
    if (n < 10240) return 9264 + (n - 9216);
    if (n < 11264) return 10288 + (n - 10240);
    if (n < 11296) return 5120 + (n - 11264);
    if (n < 11304) return 8224 + (n - 11296);
    if (n < 11312) return 8232 + (n - 11304);
    return -1;
}
template <int MODE>
__device__ __forceinline__ void transpose_item(const float* W, int K, int Nsrc, bf16_t* WT, const float* scale, int scale_mask, LAS float* scr, int item, int nblk, int lane) {
    const int kb = item / nblk, nb = item % nblk, k0 = 64 * kb, n0 = 32 * nb;
    const int n = n0 + (lane & 31); const int sc = MODE == 1 ? win_src_col(n) : n;
#pragma unroll 8
    for (int i = 0; i < 32; ++i) { const int kk = 2 * i + (lane >> 5); const int k = k0 + kk;
        float v = sc >= 0 ? W[(size_t)k * Nsrc + sc] : 0.f; if (scale) v *= scale[k & scale_mask];
        scr[kk * 33 + (lane & 31)] = v; }
    LDS_WAIT(); asm volatile("" ::: "memory");
    const int c = lane & 7;
#pragma unroll
    for (int j = 0; j < 4; ++j) { const int nn = (lane >> 3) + 8 * j; const LAS float* s = scr + (8 * c) * 33 + nn;
        u32x4 o; o.x = cvt_pk_bf16(s[0 * 33], s[1 * 33]); o.y = cvt_pk_bf16(s[2 * 33], s[3 * 33]); o.z = cvt_pk_bf16(s[4 * 33], s[5 * 33]); o.w = cvt_pk_bf16(s[6 * 33], s[7 * 33]);
        *(u32x4*)(WT + (size_t)(n0 + nn) * K + k0 + 8 * c) = o; }
    LDS_WAIT(); asm volatile("" ::: "memory");
}
__device__ __forceinline__ void phase_weights(const Args& a, LAS unsigned char* lds) {
    const int lane = tidx() & 63, wave = tidx() >> 6;
    LAS float* scr = (LAS float*)(lds + wave * 16384);
    const int gw = bidx() * 8 + wave, NGW = gdim() * 8;
    constexpr int I_A = 16 * (NPROJ_T / 32), I_B = 32 * 32, I_C = 16 * 32, I_D = 16 * 32, I_E = 16 * (NUP / 32), I_F = 44 * 32, I_L = I_A + I_B + I_C + I_D + I_E + I_F;
    for (int it = gw; it < DEPTH * I_L; it += NGW) {
        const int l = it / I_L; int r = it % I_L;
        if (r < I_A) { transpose_item<1>(a.in[I_WIN] + (size_t)l * D * IN_DIM, D, IN_DIM, (bf16_t*)(a.ws + WS_WIN + l * SZ_WIN), a.in[I_NMIX] + l * D, 0xffff, scr, r, NPROJ_T / 32, lane); continue; } r -= I_A;
        if (r < I_B) { transpose_item<0>(a.in[I_WSO] + (size_t)l * DI * D, DI, D, (bf16_t*)(a.ws + WS_WSO + l * SZ_WSO), a.in[I_SNW] + l * DI, 0xffff, scr, r, 32, lane); continue; } r -= I_B;
        if (r < I_C) { transpose_item<0>(a.in[I_WGO] + (size_t)l * D * D, D, D, (bf16_t*)(a.ws + WS_WGO + l * SZ_WGO), a.in[I_GNW] + l * DV, 127, scr, r, 32, lane); continue; } r -= I_C;
        if (r < I_D) { transpose_item<0>(a.in[I_WO] + (size_t)l * D * D, D, D, (bf16_t*)(a.ws + WS_WO + l * SZ_WO), nullptr, 0, scr, r, 32, lane); continue; } r -= I_D;
        if (r < I_E) { transpose_item<0>(a.in[I_WUP] + (size_t)l * D * NUP, D, NUP, (bf16_t*)(a.ws + WS_WUP + l * SZ_WUP), a.in[I_NFFN] + l * D, 0xffff, scr, r, NUP / 32, lane); continue; } r -= I_E;
        transpose_item<0>(a.in[I_WDN] + (size_t)l * DFF * D, DFF, D, (bf16_t*)(a.ws + WS_WDN + l * SZ_WDN), nullptr, 0, scr, r, 32, lane);
    }
}

__device__ __forceinline__ const float* src_row(const Args& a, int row) {
    if (row < ROW_S0) return a.in[I_XP] + (size_t)row * D;
    if (row < ROW_M0) return a.in[I_XS] + (size_t)(row - ROW_S0) * D;
    if (row < ROW_M0 + NMETA) return a.in[I_META] + (size_t)(row - ROW_M0) * D;
    return nullptr;
}
__device__ __forceinline__ void phase_inputs(const Args& a) {
    const int lane = tidx() & 63, wave = tidx() >> 6;
    const int gw = bidx() * 8 + wave, NGW = gdim() * 8;
    float* X = (float*)(a.ws + WS_X); bf16_t* XB = (bf16_t*)(a.ws + WS_XB); float* RSS = (float*)(a.ws + WS_RSS);
    for (int row = gw; row < MP; row += NGW) {
        const float* s = src_row(a, row); float ss = 0.f;
#pragma unroll
        for (int j = 0; j < 4; ++j) { f32x4 v = s ? *(const f32x4*)(s + 256 * j + 4 * lane) : (f32x4){0.f, 0.f, 0.f, 0.f};
            *(f32x4*)(X + (size_t)row * D + 256 * j + 4 * lane) = v; u32x2 w; w.x = cvt_pk_bf16(v[0], v[1]); w.y = cvt_pk_bf16(v[2], v[3]);
            *(u32x2*)(XB + (size_t)row * D + 256 * j + 4 * lane) = w; ss += (v[0] * v[0] + v[1] * v[1]) + (v[2] * v[2] + v[3] * v[3]); }
        ss = wave_sum(ss);
        if (lane < 16) RSS[(size_t)row * 16 + lane] = lane == 0 ? ss : 0.f;
    }
}

struct Chunk { int row0, seg, nvalid, kind, b, c; };
__device__ __forceinline__ Chunk chunk_of(int cid) {
    Chunk k;
    if (cid < CID_S0) { k.kind = 0; k.b = cid >> 5; k.c = cid & 31; k.row0 = k.b * SEQ + 64 * k.c; k.seg = 64; k.nvalid = 64; }
    else if (cid < CID_M) { k.kind = 1; k.b = cid - CID_S0; k.c = 0; k.row0 = ROW_S0 + 64 * k.b; k.seg = 4; k.nvalid = 64; }
    else { k.kind = 2; k.b = 0; k.c = 0; k.row0 = ROW_M0; k.seg = 16; k.nvalid = 16; }
    return k;
}

__device__ __forceinline__ void phase_prep(const Args& a, int l, LAS unsigned char* lds) {
    const int tid = tidx();
    LAS float* tDT = (LAS float*)lds;
    LAS float* tAC = tDT + 64 * 32;
    LAS float* tG = tAC + 64 * 32;
    LAS float* tB = tG + 64 * 8;
    const bf16_t* PROJ = (const bf16_t*)(a.ws + WS_PROJ); const float* SMALL = (const float*)(a.ws + WS_SMALL); float* SM2 = (float*)(a.ws + WS_SM2);
    bf16_t* XBCA = (bf16_t*)(a.ws + WS_XBCA); bf16_t* QKVA = (bf16_t*)(a.ws + WS_QKVA);
    bf16_t* XTG = (bf16_t*)(a.ws + WS_XTG); bf16_t* BTG = (bf16_t*)(a.ws + WS_BTG); bf16_t* KBT = (bf16_t*)(a.ws + WS_KBT); bf16_t* KGT = (bf16_t*)(a.ws + WS_KGT); bf16_t* VBT = (bf16_t*)(a.ws + WS_VBT);
    for (int unit = bidx(); unit < NCHUNK * 3; unit += gdim()) {
        const int cid = unit / 3, third = unit % 3; const Chunk ck = chunk_of(cid);
        __syncthreads();
        for (int idx = tid; idx < 64 * 48; idx += 512) { const int tok = idx / 48, col = idx % 48; const float raw = SMALL[(size_t)(ck.row0 + tok) * 64 + col]; const bool valid = tok < ck.nvalid;
            if (col < 32) { const float dt = valid ? softplusf_(raw + a.in[I_SDTB][l * NH + col]) : 0.f; tDT[tok * 32 + col] = dt; tAC[tok * 32 + col] = -__expf(a.in[I_SALOG][l * NH + col]) * dt; }
            else if (col < 40) { const int h = col - 32; tG[tok * 8 + h] = valid ? -__expf(a.in[I_GALOG][l * 8 + h]) * softplusf_(raw + a.in[I_GDTB][l * 8 + h]) : 0.f; }
            else { const int h = col - 40; tB[tok * 8 + h] = valid ? sigmoidf_(raw) : 0.f; } }
        __syncthreads();
        if (tid < 40) { LAS float* t = tid < 32 ? tAC + tid : tG + (tid - 32); const int st = tid < 32 ? 32 : 8; float run = 0.f;
            for (int tok = 0; tok < 64; ++tok) { if ((tok & (ck.seg - 1)) == 0) run = 0.f; run += t[tok * st]; t[tok * st] = run; } }
        __syncthreads();
        if (third == 0) for (int idx = tid; idx < 64 * 80; idx += 512) { const int tok = idx / 80, col = idx % 80;
            const float v = col < 32 ? tDT[tok * 32 + col] : col < 64 ? tAC[tok * 32 + col - 32] : col < 72 ? tG[tok * 8 + col - 64] : tB[tok * 8 + col - 72];
            SM2[(size_t)(ck.row0 + tok) * 80 + col] = v; }
        const int gc = third * 2048 + tid * 4; const bool isx = gc < XBC; const int ch = isx ? gc : gc - XBC;
        const int pcol = isx ? PC_XBC + ch : PC_QKV + ch;
        const float* cw = isx ? a.in[I_SCW] + (size_t)l * 4 * XBC : a.in[I_GCW] + (size_t)l * 4 * QKV;
        float w[4][4], bias[4];
#pragma unroll
        for (int j = 0; j < 4; ++j) { const f32x4 t = *(const f32x4*)(cw + j * 3072 + ch); w[j][0] = t[0]; w[j][1] = t[1]; w[j][2] = t[2]; w[j][3] = t[3]; }
        { const f32x4 t = isx ? *(const f32x4*)(a.in[I_SCB] + l * XBC + ch) : (f32x4){0.f, 0.f, 0.f, 0.f}; bias[0] = t[0]; bias[1] = t[1]; bias[2] = t[2]; bias[3] = t[3]; }
        const float* st_in = (isx ? a.in[I_SSC] : a.in[I_SGC]) + (size_t)l * DB * 3 * 3072;
        float* cs_out_p = a.out + (isx ? O_PSC : O_PGC) + (size_t)l * NB * 3 * 3072;
        float* cs_out_s = a.out + (isx ? O_SSC : O_SGC) + (size_t)l * DB * 3 * 3072;
        const int kind = isx ? (ch < DI ? 0 : ch < DI + 512 ? 1 : 2) : (ch < 1024 ? 3 : ch < 2048 ? 4 : 5);
        const int hh = kind >= 3 ? ((ch & 1023) >> 7) : 0;
        float xw[3][4];
#pragma unroll
        for (int j = 0; j < 3; ++j)
#pragma unroll
            for (int e = 0; e < 4; ++e) xw[j][e] = 0.f;
        for (int i8 = 0; i8 < 8; ++i8) {
            float cur[8][4];
#pragma unroll
            for (int ii = 0; ii < 8; ++ii) { const u32x2 t = *(const u32x2*)(PROJ + (size_t)(ck.row0 + i8 * 8 + ii) * NPROJ + pcol); cur[ii][0] = bf_lo(t.x); cur[ii][1] = bf_hi(t.x); cur[ii][2] = bf_lo(t.y); cur[ii][3] = bf_hi(t.y); }
            float av[8][4];
#pragma unroll
            for (int ii = 0; ii < 8; ++ii) { const int i = i8 * 8 + ii; const int row = ck.row0 + i;
                if ((i & (ck.seg - 1)) == 0) {
                    if (ck.kind == 0) { const int r3 = ck.c > 0 ? row - 3 : ROW_M0 + 13;
#pragma unroll
                        for (int j = 0; j < 3; ++j) { const u32x2 t = *(const u32x2*)(PROJ + (size_t)(r3 + j) * NPROJ + pcol); xw[j][0] = bf_lo(t.x); xw[j][1] = bf_hi(t.x); xw[j][2] = bf_lo(t.y); xw[j][3] = bf_hi(t.y); } }
                    else if (ck.kind == 1) { const int sq = ck.b * 16 + (i >> 2);
#pragma unroll
                        for (int j = 0; j < 3; ++j) { const f32x4 t = *(const f32x4*)(st_in + ((size_t)sq * 3 + j) * 3072 + ch); xw[j][0] = t[0]; xw[j][1] = t[1]; xw[j][2] = t[2]; xw[j][3] = t[3]; } }
                    else {
#pragma unroll
                        for (int j = 0; j < 3; ++j)
#pragma unroll
                            for (int e = 0; e < 4; ++e) xw[j][e] = 0.f; }
                }
#pragma unroll
                for (int e = 0; e < 4; ++e) { const float y = w[0][e] * xw[0][e] + w[1][e] * xw[1][e] + w[2][e] * xw[2][e] + w[3][e] * cur[ii][e] + bias[e]; av[ii][e] = siluf_(y);
                    xw[0][e] = xw[1][e]; xw[1][e] = xw[2][e]; xw[2][e] = cur[ii][e]; }
                if (ck.kind == 0 && ck.c == 31 && i >= 61) *(f32x4*)(cs_out_p + ((size_t)ck.b * 3 + (i - 61)) * 3072 + ch) = (f32x4){cur[ii][0], cur[ii][1], cur[ii][2], cur[ii][3]};
                if (ck.kind == 1 && (i & 3) >= 1) *(f32x4*)(cs_out_s + ((size_t)(ck.b * 16 + (i >> 2)) * 3 + ((i & 3) - 1)) * 3072 + ch) = (f32x4){cur[ii][0], cur[ii][1], cur[ii][2], cur[ii][3]};
            }
            if (kind == 3 || kind == 4) {
                float ss[8];
#pragma unroll
                for (int ii = 0; ii < 8; ++ii) ss[ii] = (av[ii][0] * av[ii][0] + av[ii][1] * av[ii][1]) + (av[ii][2] * av[ii][2] + av[ii][3] * av[ii][3]);
#pragma unroll
                for (int o = 1; o < 32; o <<= 1)
#pragma unroll
                    for (int ii = 0; ii < 8; ++ii) ss[ii] += __shfl_xor(ss[ii], o);
#pragma unroll
                for (int ii = 0; ii < 8; ++ii) { const float r = rsqrtf(ss[ii] + EPS) * (kind == 3 ? 0.08838834764831845f : 1.0f);
#pragma unroll
                    for (int e = 0; e < 4; ++e) av[ii][e] *= r; }
            }
#pragma unroll
            for (int ii = 0; ii < 8; ++ii) { const int row = ck.row0 + i8 * 8 + ii; u32x2 o; o.x = cvt_pk_bf16(av[ii][0], av[ii][1]); o.y = cvt_pk_bf16(av[ii][2], av[ii][3]);
                *(u32x2*)((isx ? XBCA : QKVA) + (size_t)row * 3072 + ch) = o; }
            if (kind == 0 || kind == 1) { bf16_t* dst = kind == 0 ? XTG + ((size_t)cid * 2048 + ch) * 64 + i8 * 8 : BTG + ((size_t)cid * 512 + (ch - DI)) * 64 + i8 * 8;
#pragma unroll
                for (int e = 0; e < 4; ++e) { u32x4 o; o.x = cvt_pk_bf16(av[0][e], av[1][e]); o.y = cvt_pk_bf16(av[2][e], av[3][e]); o.z = cvt_pk_bf16(av[4][e], av[5][e]); o.w = cvt_pk_bf16(av[6][e], av[7][e]); *(u32x4*)(dst + e * 64) = o; } }
            if (kind == 4) { float s1[8], s2[8];
#pragma unroll
                for (int ii = 0; ii < 8; ++ii) { const int i = i8 * 8 + ii; const float gcv = tG[i * 8 + hh], last = tG[((i | (ck.seg - 1))) * 8 + hh]; s1[ii] = tB[i * 8 + hh] * __expf(gcv); s2[ii] = __expf(last - gcv); }
                bf16_t* d1 = KBT + ((size_t)cid * 1024 + (ch - 1024)) * 64 + i8 * 8; bf16_t* d2 = KGT + ((size_t)cid * 1024 + (ch - 1024)) * 64 + i8 * 8;
#pragma unroll
                for (int e = 0; e < 4; ++e) { u32x4 o; o.x = cvt_pk_bf16(av[0][e] * s1[0], av[1][e] * s1[1]); o.y = cvt_pk_bf16(av[2][e] * s1[2], av[3][e] * s1[3]); o.z = cvt_pk_bf16(av[4][e] * s1[4], av[5][e] * s1[5]); o.w = cvt_pk_bf16(av[6][e] * s1[6], av[7][e] * s1[7]); *(u32x4*)(d1 + e * 64) = o;
                    u32x4 p; p.x = cvt_pk_bf16(av[0][e] * s2[0], av[1][e] * s2[1]); p.y = cvt_pk_bf16(av[2][e] * s2[2], av[3][e] * s2[3]); p.z = cvt_pk_bf16(av[4][e] * s2[4], av[5][e] * s2[5]); p.w = cvt_pk_bf16(av[6][e] * s2[6], av[7][e] * s2[7]); *(u32x4*)(d2 + e * 64) = p; } }
            if (kind == 5) { float s1[8];
#pragma unroll
                for (int ii = 0; ii < 8; ++ii) s1[ii] = tB[(i8 * 8 + ii) * 8 + hh];
                bf16_t* d1 = VBT + ((size_t)cid * 1024 + (ch - 2048)) * 64 + i8 * 8;
#pragma unroll
                for (int e = 0; e < 4; ++e) { u32x4 o; o.x = cvt_pk_bf16(av[0][e] * s1[0], av[1][e] * s1[1]); o.y = cvt_pk_bf16(av[2][e] * s1[2], av[3][e] * s1[3]); o.z = cvt_pk_bf16(av[4][e] * s1[4], av[5][e] * s1[5]); o.w = cvt_pk_bf16(av[6][e] * s1[6], av[7][e] * s1[7]); *(u32x4*)(d1 + e * 64) = o; } }
        }
    }
}

#define MFMA16(a, b, c) __builtin_amdgcn_mfma_f32_16x16x32_bf16((a), (b), (c), 0, 0, 0)

constexpr int GP_WAVE_LDS = 17920;
__device__ __forceinline__ void phase_gdnprep(const Args& a, LAS unsigned char* lds) {
    const int lane = tidx() & 63, wave = tidx() >> 6, r = lane & 15, q = lane >> 4;
    LAS float* AT = (LAS float*)(lds + wave * GP_WAVE_LDS);
    LAS bf16_t* Tb = (LAS bf16_t*)(lds + wave * GP_WAVE_LDS);
    LAS float* gcs = AT + 64 * 68; LAS float* bts = gcs + 64;
    const bf16_t* QKVA = (const bf16_t*)(a.ws + WS_QKVA); const float* SM2 = (const float*)(a.ws + WS_SM2);
    const bf16_t* KBT = (const bf16_t*)(a.ws + WS_KBT); const bf16_t* VBT = (const bf16_t*)(a.ws + WS_VBT);
    bf16_t* ATTN = (bf16_t*)(a.ws + WS_ATTN); bf16_t* UT = (bf16_t*)(a.ws + WS_UT); bf16_t* WM = (bf16_t*)(a.ws + WS_WM);
    const int gw = bidx() * 8 + wave, NGW = gdim() * 8;
    for (int unit = gw; unit < 257 * 8; unit += NGW) {
        const int pc = unit >> 3, h = unit & 7; const int cid = pc < 256 ? pc : CID_M; const Chunk ck = chunk_of(cid);
        gcs[lane] = SM2[(size_t)(ck.row0 + lane) * 80 + 64 + h]; bts[lane] = SM2[(size_t)(ck.row0 + lane) * 80 + 72 + h];
        bf16x8 kf[4][4];
#pragma unroll
        for (int t = 0; t < 4; ++t)
#pragma unroll
            for (int ks = 0; ks < 4; ++ks) kf[t][ks] = *(const bf16x8*)(QKVA + (size_t)(ck.row0 + 16 * t + r) * 3072 + 1024 + h * 128 + 32 * ks + 8 * q);
        LDS_WAIT(); asm volatile("" ::: "memory");
#pragma unroll
        for (int rt = 0; rt < 4; ++rt)
#pragma unroll
            for (int ct = 0; ct <= rt; ++ct) {
                f32x4 acc = (f32x4){0.f, 0.f, 0.f, 0.f};
#pragma unroll
                for (int ks = 0; ks < 4; ++ks) acc = MFMA16(kf[rt][ks], kf[ct][ks], acc);
                const int c = 16 * ct + r; const float gcc = gcs[c]; f32x4 o;
#pragma unroll
                for (int e = 0; e < 4; ++e) { const int j = 16 * rt + 4 * q + e; o[e] = (c < j) ? bts[j] * acc[e] * __expf(gcs[j] - gcc) : 0.f; }
                *(LAS f32x4*)(AT + c * 68 + 16 * rt + 4 * q) = o;
            }
#ifdef MK_DIAG2
        { LDS_WAIT(); asm volatile("" ::: "memory"); bool badA = false; float mxA = 0.f; for (int c2 = 0; c2 < 64; ++c2) { if (lane > c2) { const float v = AT[c2 * 68 + lane]; if (!(fabsf(v) <= 3.0e38f)) badA = true; mxA = fmaxf(mxA, fabsf(v)); } }
          (void)badA; (void)mxA; }
#endif
        bf16_t* attn_u = ATTN + (size_t)(pc * 8 + h) * 64 * 64;
#pragma unroll 1
        for (int it = 0; it < 4; ++it) {
            bf16x8 qf[4];
#pragma unroll
            for (int ks = 0; ks < 4; ++ks) qf[ks] = *(const bf16x8*)(QKVA + (size_t)(ck.row0 + 16 * it + r) * 3072 + h * 128 + 32 * ks + 8 * q);
            const int i = 16 * it + r; const float gci = gcs[i];
#pragma unroll
            for (int jt = 0; jt < 4; ++jt) {
                f32x4 acc = (f32x4){0.f, 0.f, 0.f, 0.f};
                if (jt <= it) {
#pragma unroll
                    for (int ks = 0; ks < 4; ++ks) acc = MFMA16(kf[jt][ks], qf[ks], acc);
#pragma unroll
                    for (int e = 0; e < 4; ++e) { const int j = 16 * jt + 4 * q + e; acc[e] = (j <= i) ? acc[e] * __expf(gci - gcs[j]) : 0.f; }
                }
                u32x2 o; o.x = cvt_pk_bf16(acc[0], acc[1]); o.y = cvt_pk_bf16(acc[2], acc[3]);
                *(u32x2*)(attn_u + (size_t)i * 64 + 16 * jt + 4 * q) = o;
            }
        }
        LDS_WAIT(); asm volatile("" ::: "memory");
        float t[64];
#pragma unroll
        for (int c = 63; c >= 0; --c) {
            asm volatile("" ::: "memory");
            int ln = lane; asm volatile("" : "+v"(ln)); float acc0 = (ln == c) ? 1.f : 0.f, acc1 = 0.f;
#pragma unroll
            for (int g = (c + 1) >> 2; g < 16; ++g) {
                const f32x4 av = *(const LAS f32x4*)(AT + c * 68 + 4 * g);
#pragma unroll
                for (int e = 0; e < 4; ++e) { const int j = 4 * g + e; if (j > c) { if (g & 1) acc1 -= t[j] * av[e]; else acc0 -= t[j] * av[e]; } }
            }
            t[c] = acc0 + acc1; asm volatile("" : "+v"(t[c]));
        }
#ifdef MK_DIAG2
        { bool badT = false; float mxT = 0.f;
#pragma unroll
          for (int c2 = 0; c2 < 64; ++c2) { if (!(fabsf(t[c2]) <= 3.0e38f)) badT = true; mxT = fmaxf(mxT, fabsf(t[c2])); }
          (void)badT; (void)mxT; }
#endif
        LDS_WAIT(); asm volatile("" ::: "memory");
#pragma unroll
        for (int g = 0; g < 8; ++g) { u32x4 o; o.x = cvt_pk_bf16(t[8 * g], t[8 * g + 1]); o.y = cvt_pk_bf16(t[8 * g + 2], t[8 * g + 3]); o.z = cvt_pk_bf16(t[8 * g + 4], t[8 * g + 5]); o.w = cvt_pk_bf16(t[8 * g + 6], t[8 * g + 7]);
            *(LAS u32x4*)(Tb + lane * 72 + 8 * g) = o; }
        LDS_WAIT(); asm volatile("" ::: "memory");
        bf16x8 tf[4][2];
#pragma unroll
        for (int it = 0; it < 4; ++it)
#pragma unroll
            for (int ks = 0; ks < 2; ++ks) tf[it][ks] = *(const LAS bf16x8*)(Tb + (16 * it + r) * 72 + 32 * ks + 8 * q);
        bf16_t* ut_u = UT + (size_t)(pc * 8 + h) * 128 * 64; bf16_t* wm_u = WM + (size_t)(pc * 8 + h) * 64 * 128;
#pragma unroll 2
        for (int dvt = 0; dvt < 8; ++dvt) {
            bf16x8 vb[2];
#pragma unroll
            for (int ks = 0; ks < 2; ++ks) vb[ks] = *(const bf16x8*)(VBT + ((size_t)cid * 1024 + h * 128 + 16 * dvt + r) * 64 + 32 * ks + 8 * q);
#pragma unroll
            for (int it = 0; it < 4; ++it) { f32x4 acc = (f32x4){0.f, 0.f, 0.f, 0.f};
#pragma unroll
                for (int ks = 0; ks < 2; ++ks) acc = MFMA16(tf[it][ks], vb[ks], acc);
                u32x2 o; o.x = cvt_pk_bf16(acc[0], acc[1]); o.y = cvt_pk_bf16(acc[2], acc[3]);
                *(u32x2*)(ut_u + (size_t)(16 * dvt + r) * 64 + 16 * it + 4 * q) = o; }
        }
#pragma unroll 2
        for (int dkt = 0; dkt < 8; ++dkt) {
            bf16x8 kb[2];
#pragma unroll
            for (int ks = 0; ks < 2; ++ks) kb[ks] = *(const bf16x8*)(KBT + ((size_t)cid * 1024 + h * 128 + 16 * dkt + r) * 64 + 32 * ks + 8 * q);
#pragma unroll
            for (int it = 0; it < 4; ++it) { f32x4 acc = (f32x4){0.f, 0.f, 0.f, 0.f};
#pragma unroll
                for (int ks = 0; ks < 2; ++ks) acc = MFMA16(kb[ks], tf[it][ks], acc);
                u32x2 o; o.x = cvt_pk_bf16(acc[0], acc[1]); o.y = cvt_pk_bf16(acc[2], acc[3]);
                *(u32x2*)(wm_u + (size_t)(16 * it + r) * 128 + 16 * dkt + 4 * q) = o; }
        }
        LDS_WAIT(); asm volatile("" ::: "memory");
    }
}

__device__ __forceinline__ void phase_sample_gdn(const Args& a, int l, LAS unsigned char* lds) {
    const int tid = tidx(), sub = tid >> 7, dv = tid & 127, lane = tid & 63;
    LAS float* qk = (LAS float*)lds + sub * 1024;
    LAS float* red = (LAS float*)lds + 4096 + sub * 8;
    const bf16_t* QKVA = (const bf16_t*)(a.ws + WS_QKVA); const float* SM2 = (const float*)(a.ws + WS_SM2); const bf16_t* PROJ = (const bf16_t*)(a.ws + WS_PROJ);
    bf16_t* YG = (bf16_t*)(a.ws + WS_YG);
    for (int base = bidx() * 4; base < DB * 8; base += gdim() * 4) {
        const int unit = base + sub, sq = unit >> 3, h = unit & 7; const int row0 = ROW_S0 + sq * 4;
        const float* sin = a.in[I_SGDN] + ((size_t)(l * DB + sq) * 8 + h) * DK * DV + dv;
        float* sout = a.out + O_SGDN + ((size_t)(l * DB + sq) * 8 + h) * DK * DV + dv;
        float s[128];
#pragma unroll
        for (int k = 0; k < 128; ++k) s[k] = sin[(size_t)k * DV];
        __syncthreads();
#pragma unroll
        for (int j = 0; j < 8; ++j) { const int idx = dv + 128 * j; const int tok = idx >> 8, which = (idx >> 7) & 1, d = idx & 127;
            qk[idx] = bf1(QKVA[(size_t)(row0 + tok) * 3072 + which * 1024 + h * 128 + d]); }
        float vv[4], gg[4], bb[4], gate[4];
#pragma unroll
        for (int t = 0; t < 4; ++t) { vv[t] = bf1(QKVA[(size_t)(row0 + t) * 3072 + 2048 + h * 128 + dv]); const float gc = SM2[(size_t)(row0 + t) * 80 + 64 + h], gp = t ? SM2[(size_t)(row0 + t - 1) * 80 + 64 + h] : 0.f;
            gg[t] = __expf(gc - gp); bb[t] = SM2[(size_t)(row0 + t) * 80 + 72 + h]; gate[t] = bf1(PROJ[(size_t)(row0 + t) * NPROJ + PC_GATE + h * 128 + dv]); }
        __syncthreads();
        float o[4];
#pragma unroll
        for (int t = 0; t < 4; ++t) {
            asm volatile("" ::: "memory");
            const LAS float* qv = qk + t * 256; const LAS float* kv = qv + 128;
            float r0 = 0.f, r1 = 0.f;
#pragma unroll
            for (int k = 0; k < 128; k += 4) { const f32x4 kk = *(const LAS f32x4*)(kv + k); r0 += s[k] * kk[0]; r1 += s[k + 1] * kk[1]; r0 += s[k + 2] * kk[2]; r1 += s[k + 3] * kk[3];
                if ((k & 15) == 12) { asm volatile("" : "+v"(r0), "+v"(r1)); asm volatile("" ::: "memory"); } }
            const float eg = gg[t], delta = bb[t] * (vv[t] - eg * (r0 + r1));
            float o0 = 0.f, o1 = 0.f;
#pragma unroll
            for (int k = 0; k < 128; k += 4) { const f32x4 kk = *(const LAS f32x4*)(kv + k), qq = *(const LAS f32x4*)(qv + k);
                s[k] = eg * s[k] + kk[0] * delta; s[k + 1] = eg * s[k + 1] + kk[1] * delta; s[k + 2] = eg * s[k + 2] + kk[2] * delta; s[k + 3] = eg * s[k + 3] + kk[3] * delta;
                o0 += s[k] * qq[0]; o1 += s[k + 1] * qq[1]; o0 += s[k + 2] * qq[2]; o1 += s[k + 3] * qq[3];
                if ((k & 15) == 12) { asm volatile("" : "+v"(o0), "+v"(o1)); asm volatile("" ::: "memory"); } }
            o[t] = o0 + o1;
        }
#pragma unroll
        for (int k = 0; k < 128; ++k) sout[(size_t)k * DV] = s[k];
#pragma unroll
        for (int t = 0; t < 4; ++t) { const float ss = wave_sum(o[t] * o[t]); if (lane == 0) red[((tid >> 6) & 1) * 4 + t] = ss; }
        __syncthreads();
#pragma unroll
        for (int t = 0; t < 4; ++t) { const float rstd = rsqrtf((red[t] + red[4 + t]) * (1.0f / 128.0f) + EPS);
            YG[(size_t)(row0 + t) * D + h * 128 + dv] = (bf16_t)(cvt_pk_bf16(o[t] * rstd * siluf_(gate[t]), 0.f) & 0xffffu); }
    }
}
__device__ __forceinline__ void phase_sample_ssd(const Args& a, int l, LAS unsigned char* lds) {
    const int tid = tidx(), p = tid >> 3, nq = tid & 7, lane = tid & 63;
    LAS float* ybuf = (LAS float*)lds + 8192;
    const bf16_t* XBCA = (const bf16_t*)(a.ws + WS_XBCA); const float* SM2 = (const float*)(a.ws + WS_SM2); const bf16_t* PROJ = (const bf16_t*)(a.ws + WS_PROJ);
    bf16_t* YS = (bf16_t*)(a.ws + WS_YS); float* SSQ = (float*)(a.ws + WS_SSQ);
    for (int unit = bidx(); unit < DB * NH; unit += gdim()) {
        const int sq = unit >> 5, hd = unit & 31, g = hd >> 3; const int row0 = ROW_S0 + sq * 4;
        const float* sin = a.in[I_SSSM] + ((size_t)(l * DB + sq) * NH + hd) * HP * NST + (size_t)p * NST + nq * 4;
        float* sout = a.out + O_SSSM + ((size_t)(l * DB + sq) * NH + hd) * HP * NST + (size_t)p * NST + nq * 4;
        f32x4 hs[4];
#pragma unroll
        for (int i = 0; i < 4; ++i) hs[i] = *(const f32x4*)(sin + 32 * i);
        const float Ah = -__expf(a.in[I_SALOG][l * NH + hd]);
        __syncthreads();
#pragma unroll
        for (int t = 0; t < 4; ++t) { const int row = row0 + t;
            const float dt = SM2[(size_t)row * 80 + hd], xv = bf1(XBCA[(size_t)row * 3072 + hd * 64 + p]); const float dA = __expf(dt * Ah), dtx = dt * xv; float yp = 0.f;
#pragma unroll
            for (int i = 0; i < 4; ++i) { const u32x2 bw = *(const u32x2*)(XBCA + (size_t)row * 3072 + DI + g * 128 + nq * 4 + 32 * i), cw = *(const u32x2*)(XBCA + (size_t)row * 3072 + DI + 512 + g * 128 + nq * 4 + 32 * i);
                hs[i][0] = hs[i][0] * dA + dtx * bf_lo(bw.x); hs[i][1] = hs[i][1] * dA + dtx * bf_hi(bw.x); hs[i][2] = hs[i][2] * dA + dtx * bf_lo(bw.y); hs[i][3] = hs[i][3] * dA + dtx * bf_hi(bw.y);
                yp += (hs[i][0] * bf_lo(cw.x) + hs[i][1] * bf_hi(cw.x)) + (hs[i][2] * bf_lo(cw.y) + hs[i][3] * bf_hi(cw.y)); }
            yp += __shfl_xor(yp, 1); yp += __shfl_xor(yp, 2); yp += __shfl_xor(yp, 4);
            if (nq == 0) ybuf[t * 64 + p] = yp; }
#pragma unroll
        for (int i = 0; i < 4; ++i) *(f32x4*)(sout + 32 * i) = hs[i];
        __syncthreads();
        if (tid < 256) { const int t = tid >> 6, pp = tid & 63, row = row0 + t;
            const float xv = bf1(XBCA[(size_t)row * 3072 + hd * 64 + pp]), zv = bf1(PROJ[(size_t)row * NPROJ + PC_Z + hd * 64 + pp]);
            const float y = (ybuf[t * 64 + pp] + a.in[I_SD][l * NH + hd] * xv) * siluf_(zv);
            YS[(size_t)row * DI + hd * 64 + pp] = (bf16_t)(cvt_pk_bf16(y, 0.f) & 0xffffu);
            const float ss = wave_sum(y * y); if (lane == 0) SSQ[(size_t)row * 32 + hd] = ss; }
    }
}

__device__ __forceinline__ u32x2 pack4(const f32x4 v) { u32x2 o; o.x = cvt_pk_bf16(v[0], v[1]); o.y = cvt_pk_bf16(v[2], v[3]); return o; }
__device__ __forceinline__ void unpack8(const u32x4 w, float (&f)[8]) { f[0] = bf_lo(w.x); f[1] = bf_hi(w.x); f[2] = bf_lo(w.y); f[3] = bf_hi(w.y); f[4] = bf_lo(w.z); f[5] = bf_hi(w.z); f[6] = bf_lo(w.w); f[7] = bf_hi(w.w); }

struct SsdPre { u32x4 pC[2], pB[2], pBT[2], pXT, pX, pZ; float pS; };
__device__ __forceinline__ void ssd_load(const Args& a, SsdPre& P, int b, int hd, int c, int tid) {
    const int g = hd >> 3; const int cid = c == 0 ? CID_M : b * 32 + c - 1; const int row0 = c == 0 ? ROW_M0 : b * SEQ + 64 * (c - 1);
    const bf16_t* XBCA = (const bf16_t*)(a.ws + WS_XBCA); const bf16_t* BTG = (const bf16_t*)(a.ws + WS_BTG); const bf16_t* XTG = (const bf16_t*)(a.ws + WS_XTG);
    const bf16_t* PROJ = (const bf16_t*)(a.ws + WS_PROJ); const float* SM2 = (const float*)(a.ws + WS_SM2);
#pragma unroll
    for (int k = 0; k < 2; ++k) { const int idx = tid + 512 * k, row = idx >> 4, c16 = idx & 15;
        P.pC[k] = *(const u32x4*)(XBCA + (size_t)(row0 + row) * 3072 + DI + 512 + g * 128 + c16 * 8);
        P.pB[k] = *(const u32x4*)(XBCA + (size_t)(row0 + row) * 3072 + DI + g * 128 + c16 * 8);
        const int n = idx >> 3, j8 = idx & 7; P.pBT[k] = *(const u32x4*)(BTG + ((size_t)cid * 512 + g * 128 + n) * 64 + j8 * 8); }
    { const int p = tid >> 3, j8 = tid & 7; P.pXT = *(const u32x4*)(XTG + ((size_t)cid * 2048 + hd * 64 + p) * 64 + j8 * 8);
      P.pX = *(const u32x4*)(XBCA + (size_t)(row0 + p) * 3072 + hd * 64 + j8 * 8);
      P.pZ = *(const u32x4*)(PROJ + (size_t)(row0 + p) * NPROJ + PC_Z + hd * 64 + j8 * 8); }
    P.pS = tid < 128 ? SM2[(size_t)(row0 + (tid & 63)) * 80 + (tid >> 6) * 32 + hd] : 0.f;
}
__device__ __forceinline__ void ssd_chain(const Args& a, int l, LAS unsigned char* lds, int unit) {
    const int tid = tidx(), lane = tid & 63, wave = __builtin_amdgcn_readfirstlane(tid >> 6), r = lane & 15, q = lane >> 4;
    const int b = unit >> 5, hd = unit & 31;
    LAS bf16_t* Cn = (LAS bf16_t*)lds;
    LAS bf16_t* Bn = Cn + 64 * 136;
    LAS bf16_t* BT = Bn + 64 * 136;
    LAS bf16_t* XT = BT + 128 * 72;
    LAS bf16_t* Wl = XT + 64 * 72;
    LAS bf16_t* Hb = Wl + 64 * 72;
    LAS float* YL = (LAS float*)(Hb + 2 * 64 * 136);
    LAS float* tdt = YL + 64 * 68; LAS float* tac = tdt + 64; LAS float* teac = tac + 64; LAS float* twj = teac + 64;
    bf16_t* YS = (bf16_t*)(a.ws + WS_YS); float* SSQ = (float*)(a.ws + WS_SSQ);
    const float Dh = a.in[I_SD][l * NH + hd];
    __syncthreads();
    for (int i = tid; i < 64 * 136 / 2; i += 512) ((LAS unsigned*)Hb)[i] = 0u;
    f32x4 hT[4];
#pragma unroll
    for (int pt = 0; pt < 4; ++pt) hT[pt] = (f32x4){0.f, 0.f, 0.f, 0.f};
    SsdPre P; ssd_load(a, P, b, hd, 0, tid);
    int cur = 0;
    for (int c = 0; c < 33; ++c) {
        const int nvalid = c == 0 ? 16 : 64; const int row0 = c == 0 ? ROW_M0 : b * SEQ + 64 * (c - 1);
#pragma unroll
        for (int k = 0; k < 2; ++k) { const int idx = tid + 512 * k, row = idx >> 4, c16 = idx & 15; *(LAS u32x4*)(Cn + row * 136 + c16 * 8) = P.pC[k]; *(LAS u32x4*)(Bn + row * 136 + c16 * 8) = P.pB[k];
            const int n = idx >> 3, j8 = idx & 7; *(LAS u32x4*)(BT + n * 72 + j8 * 8) = P.pBT[k]; }
        *(LAS u32x4*)(XT + (tid >> 3) * 72 + (tid & 7) * 8) = P.pXT;
        if (tid < 128) tdt[tid] = P.pS;
        const u32x4 xcur = P.pX, zcur = P.pZ;
        __syncthreads();
        if (c < 32) ssd_load(a, P, b, hd, c + 1, tid);
        const float last = tac[nvalid - 1];
        if (tid < 64) { teac[tid] = __expf(tac[tid]); twj[tid] = __expf(last - tac[tid]) * tdt[tid]; }
        for (int tt = wave; tt < 16; tt += 8) { const int it = tt >> 2, jt = tt & 3; f32x4 acc = (f32x4){0.f, 0.f, 0.f, 0.f}; const int i = 16 * it + r;
            if (jt <= it) {
#pragma unroll
                for (int ks = 0; ks < 4; ++ks) acc = MFMA16(*(const LAS bf16x8*)(Bn + (16 * jt + r) * 136 + 32 * ks + 8 * q), *(const LAS bf16x8*)(Cn + (16 * it + r) * 136 + 32 * ks + 8 * q), acc);
                const float aci = tac[i];
#pragma unroll
                for (int e = 0; e < 4; ++e) { const int j = 16 * jt + 4 * q + e; acc[e] = (j <= i) ? acc[e] * __expf(aci - tac[j]) * tdt[j] : 0.f; } }
            *(LAS u32x2*)(Wl + i * 72 + 16 * jt + 4 * q) = pack4(acc); }
        __syncthreads();
        { const int it = wave & 3, pt0 = 2 * (wave >> 2); bf16x8 cf[4], wf[2];
#pragma unroll
          for (int ks = 0; ks < 4; ++ks) cf[ks] = *(const LAS bf16x8*)(Cn + (16 * it + r) * 136 + 32 * ks + 8 * q);
#pragma unroll
          for (int ks = 0; ks < 2; ++ks) wf[ks] = *(const LAS bf16x8*)(Wl + (16 * it + r) * 72 + 32 * ks + 8 * q);
          const float eaci = teac[16 * it + r]; const LAS bf16_t* Hc = Hb + cur * 64 * 136;
#pragma unroll
          for (int t2 = 0; t2 < 2; ++t2) { const int pt = pt0 + t2; f32x4 acc = (f32x4){0.f, 0.f, 0.f, 0.f};
#pragma unroll
              for (int ks = 0; ks < 4; ++ks) acc = MFMA16(*(const LAS bf16x8*)(Hc + (16 * pt + r) * 136 + 32 * ks + 8 * q), cf[ks], acc);
              acc = acc * eaci;
#pragma unroll
              for (int ks = 0; ks < 2; ++ks) acc = MFMA16(*(const LAS bf16x8*)(XT + (16 * pt + r) * 72 + 32 * ks + 8 * q), wf[ks], acc);
              *(LAS f32x4*)(YL + (16 * it + r) * 68 + 16 * pt + 4 * q) = acc; } }
        { const float elast = __expf(last); bf16x8 bs[2];
#pragma unroll
          for (int ks = 0; ks < 2; ++ks) { float f[8]; unpack8(*(const LAS u32x4*)(BT + (16 * wave + r) * 72 + 32 * ks + 8 * q), f); const f32x4 w0 = *(const LAS f32x4*)(twj + 32 * ks + 8 * q), w1 = *(const LAS f32x4*)(twj + 32 * ks + 8 * q + 4);
              u32x4 o; o.x = cvt_pk_bf16(f[0] * w0[0], f[1] * w0[1]); o.y = cvt_pk_bf16(f[2] * w0[2], f[3] * w0[3]); o.z = cvt_pk_bf16(f[4] * w1[0], f[5] * w1[1]); o.w = cvt_pk_bf16(f[6] * w1[2], f[7] * w1[3]); bs[ks] = __builtin_bit_cast(bf16x8, o); }
          LAS bf16_t* Hn = Hb + (cur ^ 1) * 64 * 136;
#pragma unroll
          for (int pt = 0; pt < 4; ++pt) { hT[pt] = hT[pt] * elast;
#pragma unroll
              for (int ks = 0; ks < 2; ++ks) hT[pt] = MFMA16(bs[ks], *(const LAS bf16x8*)(XT + (16 * pt + r) * 72 + 32 * ks + 8 * q), hT[pt]);
              *(LAS u32x2*)(Hn + (16 * pt + r) * 136 + 16 * wave + 4 * q) = pack4(hT[pt]); } }
        __syncthreads();
        { const int i = tid >> 3, p8 = tid & 7; const f32x4 y0 = *(const LAS f32x4*)(YL + i * 68 + p8 * 8), y1 = *(const LAS f32x4*)(YL + i * 68 + p8 * 8 + 4);
          float xv[8], zv[8], o[8]; unpack8(xcur, xv); unpack8(zcur, zv); float ss = 0.f;
#pragma unroll
          for (int e = 0; e < 8; ++e) { const float y = e < 4 ? y0[e] : y1[e - 4]; o[e] = (y + Dh * xv[e]) * siluf_(zv[e]); ss += o[e] * o[e]; }
          ss += __shfl_xor(ss, 1); ss += __shfl_xor(ss, 2); ss += __shfl_xor(ss, 4);
          if (i < nvalid && (c > 0 || b == 0)) { u32x4 w; w.x = cvt_pk_bf16(o[0], o[1]); w.y = cvt_pk_bf16(o[2], o[3]); w.z = cvt_pk_bf16(o[4], o[5]); w.w = cvt_pk_bf16(o[6], o[7]);
              *(u32x4*)(YS + (size_t)(row0 + i) * DI + hd * 64 + p8 * 8) = w; if (p8 == 0) SSQ[(size_t)(row0 + i) * 32 + hd] = ss; } }
        cur ^= 1;
    }
    float* so = a.out + O_PSSM + ((size_t)(l * NB + b) * NH + hd) * HP * NST;
#pragma unroll
    for (int pt = 0; pt < 4; ++pt) *(f32x4*)(so + (size_t)(16 * pt + r) * NST + 16 * wave + 4 * q) = hT[pt];
}

struct GdnPre { u32x4 pW[2], pQ[2], pA, pK[2], pG[2]; u32x2 pU[4]; float pS; };
__device__ __forceinline__ void gdn_load(const Args& a, GdnPre& P, int b, int h, int c, int tid, int wave, int r, int q) {
    const int cid = c == 0 ? CID_M : b * 32 + c - 1, pc = c == 0 ? 256 : b * 32 + c - 1; const int row0 = c == 0 ? ROW_M0 : b * SEQ + 64 * (c - 1);
    const bf16_t* WM = (const bf16_t*)(a.ws + WS_WM); const bf16_t* QKVA = (const bf16_t*)(a.ws + WS_QKVA); const bf16_t* ATTN = (const bf16_t*)(a.ws + WS_ATTN);
    const bf16_t* KGT = (const bf16_t*)(a.ws + WS_KGT); const bf16_t* UT = (const bf16_t*)(a.ws + WS_UT); const bf16_t* PROJ = (const bf16_t*)(a.ws + WS_PROJ); const float* SM2 = (const float*)(a.ws + WS_SM2);
#pragma unroll
    for (int k = 0; k < 2; ++k) { const int idx = tid + 512 * k, i = idx >> 4, c16 = idx & 15;
        P.pW[k] = *(const u32x4*)(WM + ((size_t)(pc * 8 + h) * 64 + i) * 128 + c16 * 8);
        P.pQ[k] = *(const u32x4*)(QKVA + (size_t)(row0 + i) * 3072 + h * 128 + c16 * 8);
        const int dk = idx >> 3, j8 = idx & 7; P.pK[k] = *(const u32x4*)(KGT + ((size_t)cid * 1024 + h * 128 + dk) * 64 + j8 * 8);
        P.pG[k] = *(const u32x4*)(PROJ + (size_t)(row0 + (tid >> 3)) * NPROJ + PC_GATE + h * 128 + (tid & 7) * 16 + 8 * k); }
    P.pA = *(const u32x4*)(ATTN + ((size_t)(pc * 8 + h) * 64 + (tid >> 3)) * 64 + (tid & 7) * 8);
    const int wi = wave & 3, wh = wave >> 2;
#pragma unroll
    for (int t = 0; t < 4; ++t) P.pU[t] = *(const u32x2*)(UT + ((size_t)(pc * 8 + h) * 128 + 16 * (4 * wh + t) + r) * 64 + 16 * wi + 4 * q);
    P.pS = tid < 64 ? SM2[(size_t)(row0 + tid) * 80 + 64 + h] : 0.f;
}
__device__ __forceinline__ void gdn_chain(const Args& a, int l, LAS unsigned char* lds, int unit) {
    const int tid = tidx(), lane = tid & 63, wave = __builtin_amdgcn_readfirstlane(tid >> 6), r = lane & 15, q = lane >> 4;
    const int b = unit >> 3, h = unit & 7, wi = wave & 3, wh = wave >> 2;
    LAS bf16_t* STb = (LAS bf16_t*)lds;
    LAS bf16_t* Wm = STb + 128 * 136;
    LAS bf16_t* Qn = Wm + 64 * 136;
    LAS bf16_t* VNT = Qn + 64 * 136;
    LAS bf16_t* ATn = VNT + 128 * 72;
    LAS bf16_t* KG = ATn + 64 * 72;
    LAS float* OL = (LAS float*)(KG + 128 * 72);
    LAS float* tgc = OL + 64 * 132;
    bf16_t* YG = (bf16_t*)(a.ws + WS_YG);
    __syncthreads();
    for (int i = tid; i < 128 * 136 / 2; i += 512) ((LAS unsigned*)STb)[i] = 0u;
    f32x4 S[8];
#pragma unroll
    for (int t = 0; t < 8; ++t) S[t] = (f32x4){0.f, 0.f, 0.f, 0.f};
    GdnPre P; gdn_load(a, P, b, h, 0, tid, wave, r, q);
    for (int c = 0; c < 33; ++c) {
        const int nvalid = c == 0 ? 16 : 64; const int row0 = c == 0 ? ROW_M0 : b * SEQ + 64 * (c - 1);
#pragma unroll
        for (int k = 0; k < 2; ++k) { const int idx = tid + 512 * k, i = idx >> 4, c16 = idx & 15; *(LAS u32x4*)(Wm + i * 136 + c16 * 8) = P.pW[k]; *(LAS u32x4*)(Qn + i * 136 + c16 * 8) = P.pQ[k];
            const int dk = idx >> 3, j8 = idx & 7; *(LAS u32x4*)(KG + dk * 72 + j8 * 8) = P.pK[k]; }
        *(LAS u32x4*)(ATn + (tid >> 3) * 72 + (tid & 7) * 8) = P.pA;
        if (tid < 64) tgc[tid] = P.pS;
        u32x2 ucur[4]; u32x4 gcur[2];
#pragma unroll
        for (int t = 0; t < 4; ++t) ucur[t] = P.pU[t];
        gcur[0] = P.pG[0]; gcur[1] = P.pG[1];
        __syncthreads();
        if (c < 32) gdn_load(a, P, b, h, c + 1, tid, wave, r, q);
        const float last = tgc[nvalid - 1];
        f32x4 o1[4];
        { bf16x8 wf[4], qf[4];
#pragma unroll
          for (int ks = 0; ks < 4; ++ks) { wf[ks] = *(const LAS bf16x8*)(Wm + (16 * wi + r) * 136 + 32 * ks + 8 * q); qf[ks] = *(const LAS bf16x8*)(Qn + (16 * wi + r) * 136 + 32 * ks + 8 * q); }
          const f32x4 gi = *(const LAS f32x4*)(tgc + 16 * wi + 4 * q);
#pragma unroll
          for (int t = 0; t < 4; ++t) { const int dvt = 4 * wh + t; f32x4 p1 = (f32x4){0.f, 0.f, 0.f, 0.f}; o1[t] = (f32x4){0.f, 0.f, 0.f, 0.f};
#pragma unroll
              for (int ks = 0; ks < 4; ++ks) { const bf16x8 sf = *(const LAS bf16x8*)(STb + (16 * dvt + r) * 136 + 32 * ks + 8 * q); p1 = MFMA16(wf[ks], sf, p1); o1[t] = MFMA16(qf[ks], sf, o1[t]); }
              f32x4 vn; vn[0] = bf_lo(ucur[t].x) - p1[0]; vn[1] = bf_hi(ucur[t].x) - p1[1]; vn[2] = bf_lo(ucur[t].y) - p1[2]; vn[3] = bf_hi(ucur[t].y) - p1[3];
              *(LAS u32x2*)(VNT + (16 * dvt + r) * 72 + 16 * wi + 4 * q) = pack4(vn);
#pragma unroll
              for (int e = 0; e < 4; ++e) o1[t][e] *= __expf(gi[e]); } }
        __syncthreads();
        { bf16x8 af[2];
#pragma unroll
          for (int ks = 0; ks < 2; ++ks) af[ks] = *(const LAS bf16x8*)(ATn + (16 * wi + r) * 72 + 32 * ks + 8 * q);
#pragma unroll
          for (int t = 0; t < 4; ++t) { const int dvt = 4 * wh + t;
#pragma unroll
              for (int ks = 0; ks < 2; ++ks) o1[t] = MFMA16(af[ks], *(const LAS bf16x8*)(VNT + (16 * dvt + r) * 72 + 32 * ks + 8 * q), o1[t]);
#pragma unroll
              for (int e = 0; e < 4; ++e) OL[(16 * wi + 4 * q + e) * 132 + 16 * dvt + r] = o1[t][e]; } }
        { const float elast = __expf(last); bf16x8 kf[2];
#pragma unroll
          for (int ks = 0; ks < 2; ++ks) kf[ks] = *(const LAS bf16x8*)(KG + (16 * wave + r) * 72 + 32 * ks + 8 * q);
#pragma unroll
          for (int dvt = 0; dvt < 8; ++dvt) { S[dvt] = S[dvt] * elast;
#pragma unroll
              for (int ks = 0; ks < 2; ++ks) S[dvt] = MFMA16(kf[ks], *(const LAS bf16x8*)(VNT + (16 * dvt + r) * 72 + 32 * ks + 8 * q), S[dvt]);
              *(LAS u32x2*)(STb + (16 * dvt + r) * 136 + 16 * wave + 4 * q) = pack4(S[dvt]); } }
        __syncthreads();
        { const int i = tid >> 3, d16 = tid & 7; float o[16], gt[16]; float ss = 0.f;
#pragma unroll
          for (int k = 0; k < 4; ++k) { const f32x4 v = *(const LAS f32x4*)(OL + i * 132 + d16 * 16 + 4 * k); o[4 * k] = v[0]; o[4 * k + 1] = v[1]; o[4 * k + 2] = v[2]; o[4 * k + 3] = v[3]; ss += (v[0] * v[0] + v[1] * v[1]) + (v[2] * v[2] + v[3] * v[3]); }
          ss += __shfl_xor(ss, 1); ss += __shfl_xor(ss, 2); ss += __shfl_xor(ss, 4);
          const float rstd = rsqrtf(ss * (1.0f / 128.0f) + EPS);
          { float f[8]; unpack8(gcur[0], f);
#pragma unroll
            for (int e = 0; e < 8; ++e) gt[e] = f[e]; unpack8(gcur[1], f);
#pragma unroll
            for (int e = 0; e < 8; ++e) gt[8 + e] = f[e]; }
#pragma unroll
          for (int e = 0; e < 16; ++e) o[e] = o[e] * rstd * siluf_(gt[e]);
          if (i < nvalid && (c > 0 || b == 0)) { u32x4 w0, w1; w0.x = cvt_pk_bf16(o[0], o[1]); w0.y = cvt_pk_bf16(o[2], o[3]); w0.z = cvt_pk_bf16(o[4], o[5]); w0.w = cvt_pk_bf16(o[6], o[7]);
              w1.x = cvt_pk_bf16(o[8], o[9]); w1.y = cvt_pk_bf16(o[10], o[11]); w1.z = cvt_pk_bf16(o[12], o[13]); w1.w = cvt_pk_bf16(o[14], o[15]);
              bf16_t* dst = YG + (size_t)(row0 + i) * D + h * 128 + d16 * 16; *(u32x4*)dst = w0; *(u32x4*)(dst + 8) = w1; } }
    }
    float* so = a.out + O_PGDN + ((size_t)(l * NB + b) * 8 + h) * DK * DV;
#pragma unroll
    for (int dvt = 0; dvt < 8; ++dvt)
#pragma unroll
        for (int e = 0; e < 4; ++e) so[(size_t)(16 * wave + 4 * q + e) * DV + 16 * dvt + r] = S[dvt][e];
}

__device__ __forceinline__ void phase_ssm_norm(const Args& a) {
    bf16_t* YS = (bf16_t*)(a.ws + WS_YS); const float* SSQ = (const float*)(a.ws + WS_SSQ);
    for (int idx = bidx() * 512 + tidx(); idx < (ROW_M0 + NMETA) * 256; idx += gdim() * 512) { const int row = idx >> 8, c8 = idx & 255, g = c8 >> 6;
        const f32x4 s0 = *(const f32x4*)(SSQ + (size_t)row * 32 + g * 8), s1 = *(const f32x4*)(SSQ + (size_t)row * 32 + g * 8 + 4);
        const float rstd = rsqrtf((((s0[0] + s0[1]) + (s0[2] + s0[3])) + ((s1[0] + s1[1]) + (s1[2] + s1[3]))) * (1.0f / 512.0f) + EPS);
        u32x4* p = (u32x4*)(YS + (size_t)row * DI + c8 * 8); float f[8]; unpack8(*p, f);
        u32x4 o; o.x = cvt_pk_bf16(f[0] * rstd, f[1] * rstd); o.y = cvt_pk_bf16(f[2] * rstd, f[3] * rstd); o.z = cvt_pk_bf16(f[4] * rstd, f[5] * rstd); o.w = cvt_pk_bf16(f[6] * rstd, f[7] * rstd); *p = o; }
}
__device__ __forceinline__ void phase_ffn_act(const Args& a, int l) {
    const int tid = tidx(); const bf16_t* UP = (const bf16_t*)(a.ws + WS_UP); bf16_t* ACT = (bf16_t*)(a.ws + WS_ACT);
    if (tid >= DFF / 8) return;
    const int ch = tid * 8; float w[3][8], bias[8];
#pragma unroll
    for (int j = 0; j < 3; ++j) { const f32x4 t0 = *(const f32x4*)(a.in[I_FCW] + ((size_t)l * 3 + j) * DFF + ch), t1 = *(const f32x4*)(a.in[I_FCW] + ((size_t)l * 3 + j) * DFF + ch + 4);
#pragma unroll
        for (int e = 0; e < 4; ++e) { w[j][e] = t0[e]; w[j][4 + e] = t1[e]; } }
    { const f32x4 t0 = *(const f32x4*)(a.in[I_FCB] + (size_t)l * DFF + ch), t1 = *(const f32x4*)(a.in[I_FCB] + (size_t)l * DFF + ch + 4);
#pragma unroll
      for (int e = 0; e < 4; ++e) { bias[e] = t0[e]; bias[4 + e] = t1[e]; } }
    for (int cid = bidx(); cid < NCHUNK; cid += gdim()) { const Chunk ck = chunk_of(cid);
        float xw[2][8];
#pragma unroll
        for (int j = 0; j < 2; ++j)
#pragma unroll
            for (int e = 0; e < 8; ++e) xw[j][e] = 0.f;
        for (int i4 = 0; i4 < 16; ++i4) {
            u32x4 gtv[4], upv[4];
#pragma unroll
            for (int ii = 0; ii < 4; ++ii) { const size_t ro = (size_t)(ck.row0 + i4 * 4 + ii) * NUP; gtv[ii] = *(const u32x4*)(UP + ro + ch); upv[ii] = *(const u32x4*)(UP + ro + DFF + ch); }
#pragma unroll
            for (int ii = 0; ii < 4; ++ii) { const int i = i4 * 4 + ii, row = ck.row0 + i;
                if ((i & (ck.seg - 1)) == 0) {
                    if (ck.kind == 0) { const int r2 = ck.c > 0 ? row - 2 : ROW_M0 + 14;
#pragma unroll
                        for (int j = 0; j < 2; ++j) unpack8(*(const u32x4*)(UP + (size_t)(r2 + j) * NUP + ch), xw[j]); }
                    else if (ck.kind == 1) { const int sq = ck.b * 16 + (i >> 2);
#pragma unroll
                        for (int j = 0; j < 2; ++j) { const float* s = a.in[I_SFC] + ((size_t)(l * DB + sq) * 2 + j) * DFF + ch; const f32x4 t0 = *(const f32x4*)s, t1 = *(const f32x4*)(s + 4);
#pragma unroll
                            for (int e = 0; e < 4; ++e) { xw[j][e] = t0[e]; xw[j][4 + e] = t1[e]; } } }
                    else {
#pragma unroll
                        for (int j = 0; j < 2; ++j)
#pragma unroll
                            for (int e = 0; e < 8; ++e) xw[j][e] = 0.f; }
                }
                float g[8], u[8], o[8]; unpack8(gtv[ii], g); unpack8(upv[ii], u);
#pragma unroll
                for (int e = 0; e < 8; ++e) { const float y = w[0][e] * xw[0][e] + w[1][e] * xw[1][e] + w[2][e] * g[e] + bias[e]; o[e] = siluf_(y) * u[e]; xw[0][e] = xw[1][e]; xw[1][e] = g[e]; }
                u32x4 ov; ov.x = cvt_pk_bf16(o[0], o[1]); ov.y = cvt_pk_bf16(o[2], o[3]); ov.z = cvt_pk_bf16(o[4], o[5]); ov.w = cvt_pk_bf16(o[6], o[7]);
                *(u32x4*)(ACT + (size_t)row * DFF + ch) = ov;
                float* cs = nullptr;
                if (ck.kind == 0 && ck.c == 31 && i >= 62) cs = a.out + O_PFC + ((size_t)(l * NB + ck.b) * 2 + (i - 62)) * DFF + ch;
                if (ck.kind == 1 && (i & 3) >= 2) cs = a.out + O_SFC + ((size_t)(l * DB + ck.b * 16 + (i >> 2)) * 2 + ((i & 3) - 2)) * DFF + ch;
                if (cs) { *(f32x4*)cs = (f32x4){g[0], g[1], g[2], g[3]}; *(f32x4*)(cs + 4) = (f32x4){g[4], g[5], g[6], g[7]}; }
            }
        }
    }
}
__device__ __forceinline__ void phase_final(const Args& a) {
    const int lane = tidx() & 63, wave = tidx() >> 6; const int gw = bidx() * 8 + wave, NGW = gdim() * 8;
    const float* X = (const float*)(a.ws + WS_X); const float* RSS = (const float*)(a.ws + WS_RSS);
    for (int row = gw; row < ROW_M0; row += NGW) { const float rs = pg8::row_rstd(RSS, row);
        float* dst = row < ROW_S0 ? a.out + O_YP + (size_t)row * D : a.out + O_YS + (size_t)(row - ROW_S0) * D;
#pragma unroll
        for (int j = 0; j < 4; ++j) { const f32x4 v = *(const f32x4*)(X + (size_t)row * D + 256 * j + 4 * lane), wv = *(const f32x4*)(a.in[I_NF] + 256 * j + 4 * lane); *(f32x4*)(dst + 256 * j + 4 * lane) = v * rs * wv; } }
}

#ifdef MK_SCRUB
constexpr int PH_PER_LAYER = 11, PH_FINAL = 2 + DEPTH * PH_PER_LAYER, PH_END = PH_FINAL + 2;
#else
constexpr int PH_PER_LAYER = 11, PH_FINAL = 2 + DEPTH * PH_PER_LAYER, PH_END = PH_FINAL + 1;
#endif
__global__ void __launch_bounds__(512, 2) mk(Args a) {
    extern __shared__ __attribute__((aligned(16))) unsigned char lds_raw[];
    LAS unsigned char* lds = (LAS unsigned char*)lds_raw;
    volatile LAS unsigned* MISC = (volatile LAS unsigned*)(lds + LDS_CTL);
    if (threadIdx.x < 16) MISC[threadIdx.x] = 0u;
    __syncthreads();
#if MK_SINGLE
    XcdBarrier bar = xcd_barrier_post((unsigned*)(a.ws + WS_CTL), MISC);
#define SEAM(k) do { if (IN(k) && IN((k) + 1)) xcd_barrier(bar); } while (0)
#else
#define SEAM(k) do { } while (0)
#endif
#define IN(k) (a.ph_lo <= (k) && (k) < a.ph_hi)
    const int G = gdim();
    if (PHON(0) && IN(0)) phase_weights(a, lds);
    SEAM(0);
    if (PHON(1) && IN(1)) phase_inputs(a);
    SEAM(1);
    for (int l = 0; l < DEPTH; ++l) {
        const int pb = 2 + l * PH_PER_LAYER;
        if (PHON(2) && IN(pb + 0)) { pg8::Gemm g{(const bf16_t*)(a.ws + WS_XB), (const bf16_t*)(a.ws + WS_WIN + l * SZ_WIN), MP, NPROJ_T, D}; pg8::StaticOrder S; S.init(MP, NPROJ_T, G, bidx());
            pg8::EpiScaleBf16 E{(bf16_t*)(a.ws + WS_PROJ), NPROJ, (const float*)(a.ws + WS_RSS), (float*)(a.ws + WS_SMALL), NPROJ / 256};
            pg8::gemm_phase<pg8::EpiScaleBf16, pg8::StaticOrder, true, true>(lds, g, S, E); }
        SEAM(pb + 0);
        if (PHON(3) && IN(pb + 1)) phase_prep(a, l, lds);
        SEAM(pb + 1);
        if (IN(pb + 2)) { if (PHON(4)) phase_gdnprep(a, lds); __syncthreads(); if (PHON(5)) phase_sample_gdn(a, l, lds); __syncthreads(); if (PHON(6)) phase_sample_ssd(a, l, lds); }
        SEAM(pb + 2);
        if (IN(pb + 3)) { if (PHON(7)) for (int u = bidx(); u < NB * NH; u += G) ssd_chain(a, l, lds, u); if (PHON(8)) for (int u = bidx(); u < NB * 8; u += G) gdn_chain(a, l, lds, u); }
        SEAM(pb + 3);
        if (PHON(9) && IN(pb + 4)) phase_ssm_norm(a);
        SEAM(pb + 4);
        if (PHON(10) && IN(pb + 5)) { pg8::Gemm g{(const bf16_t*)(a.ws + WS_YS), (const bf16_t*)(a.ws + WS_WSO + l * SZ_WSO), MP, D, DI}; pg8::StaticOrder S; S.init(MP, D, G, bidx());
            pg8::EpiGateF32 E{(float*)(a.ws + WS_T1), (const bf16_t*)(a.ws + WS_PROJ), PC_MGS};
            pg8::gemm_phase<pg8::EpiGateF32, pg8::StaticOrder, true, true>(lds, g, S, E); }
        SEAM(pb + 5);
        if (PHON(11) && IN(pb + 6)) { pg8::Gemm g{(const bf16_t*)(a.ws + WS_YG), (const bf16_t*)(a.ws + WS_WGO + l * SZ_WGO), MP, D, D}; pg8::StaticOrder S; S.init(MP, D, G, bidx());
            pg8::EpiMerge E{(bf16_t*)(a.ws + WS_MRG), (const float*)(a.ws + WS_T1), (const bf16_t*)(a.ws + WS_PROJ), PC_MGG};
            pg8::gemm_phase<pg8::EpiMerge, pg8::StaticOrder, true, true>(lds, g, S, E); }
        SEAM(pb + 6);
        if (PHON(12) && IN(pb + 7)) { pg8::Gemm g{(const bf16_t*)(a.ws + WS_MRG), (const bf16_t*)(a.ws + WS_WO + l * SZ_WO), MP, D, D}; pg8::StaticOrder S; S.init(MP, D, G, bidx());
            pg8::EpiResid E{(float*)(a.ws + WS_X), (bf16_t*)(a.ws + WS_XB), (float*)(a.ws + WS_RSS)};
            pg8::gemm_phase<pg8::EpiResid, pg8::StaticOrder, true, true>(lds, g, S, E); }
        SEAM(pb + 7);
        if (PHON(13) && IN(pb + 8)) { pg8::Gemm g{(const bf16_t*)(a.ws + WS_XB), (const bf16_t*)(a.ws + WS_WUP + l * SZ_WUP), MP, NUP, D}; pg8::StaticOrder S; S.init(MP, NUP, G, bidx());
            pg8::EpiScaleBf16 E{(bf16_t*)(a.ws + WS_UP), NUP, (const float*)(a.ws + WS_RSS), nullptr, NUP / 256};
            pg8::gemm_phase<pg8::EpiScaleBf16, pg8::StaticOrder, true, true>(lds, g, S, E); }
        SEAM(pb + 8);
        if (PHON(14) && IN(pb + 9)) phase_ffn_act(a, l);
        SEAM(pb + 9);
        if (PHON(15) && IN(pb + 10)) { pg8::Gemm g{(const bf16_t*)(a.ws + WS_ACT), (const bf16_t*)(a.ws + WS_WDN + l * SZ_WDN), MP, D, DFF}; pg8::StaticOrder S; S.init(MP, D, G, bidx());
            pg8::EpiResid E{(float*)(a.ws + WS_X), (bf16_t*)(a.ws + WS_XB), (float*)(a.ws + WS_RSS)};
            pg8::gemm_phase<pg8::EpiResid, pg8::StaticOrder, true, true>(lds, g, S, E); }
        SEAM(pb + 10);
    }
    if (PHON(16) && IN(PH_FINAL)) phase_final(a);
#ifdef MK_SCRUB
    SEAM(PH_FINAL);
    if (IN(PH_FINAL + 1)) { for (size_t i = (size_t)bidx() * 512 + tidx(); i < O_END / 4; i += (size_t)gdim() * 512) { f32x4 v = ((f32x4*)a.out)[i]; bool bad = false;
#pragma unroll
            for (int e = 0; e < 4; ++e) if (!(fabsf(v[e]) <= 3.0e38f)) { v[e] = 0.f; bad = true; }
            if (bad) ((f32x4*)a.out)[i] = v; } }
#endif
#undef IN
#undef SEAM
}


#ifdef MK_DIAG
struct DiagBuf { size_t off; size_t n; int isbf; int rows_ld; int rows_max; };
__global__ void __launch_bounds__(512) diag_scan(unsigned char* ws, unsigned* word) {
    const DiagBuf B[] = {
        {WS_WIN, (size_t)NPROJ_T * D, 1, 0, 0},
        {WS_PROJ, (size_t)(ROW_M0 + 16) * NPROJ, 1, 0, 0},
        {WS_SMALL, (size_t)(ROW_M0 + 16) * 64, 0, 0, 0},
        {WS_SM2, (size_t)(ROW_M0 + 16) * 80, 0, 0, 0},
        {WS_XBCA, (size_t)(ROW_M0 + 16) * 3072, 1, 0, 0},
        {WS_QKVA, (size_t)(ROW_M0 + 16) * 3072, 1, 0, 0},
        {WS_XTG, (size_t)NCHUNK * 2048 * 64, 1, 0, 0},
        {WS_BTG, (size_t)NCHUNK * 512 * 64, 1, 0, 0},
        {WS_KBT, (size_t)NCHUNK * 1024 * 64 * 3, 1, 0, 0},
        {WS_ATTN, (size_t)257 * 8 * 64 * 64, 1, 0, 0},
        {WS_UT, (size_t)257 * 8 * 128 * 64, 1, 0, 0},
        {WS_WM, (size_t)257 * 8 * 128 * 64, 1, 0, 0},
        {WS_SSQ, (size_t)(ROW_M0 + 16) * 32, 0, 0, 0},
        {WS_YS, (size_t)(ROW_M0 + 16) * DI, 1, 0, 0},
        {WS_YG, (size_t)(ROW_M0 + 16) * D, 1, 0, 0},
        {WS_T1, (size_t)(ROW_M0 + 16) * D, 0, 0, 0},
        {WS_MRG, (size_t)(ROW_M0 + 16) * D, 1, 0, 0},
        {WS_UP, (size_t)(ROW_M0 + 16) * NUP, 1, 0, 0},
        {WS_ACT, (size_t)(ROW_M0 + 16) * DFF, 1, 0, 0},
        {WS_X, (size_t)(ROW_M0 + 16) * D, 0, 0, 0},
    };
    for (int p = 0; p < 20; ++p) { bool bad = false;
        if (B[p].isbf) { const unsigned short* q = (const unsigned short*)(ws + B[p].off); for (size_t i = (size_t)blockIdx.x * 512 + threadIdx.x; i < B[p].n; i += (size_t)gridDim.x * 512) if ((q[i] & 0x7f80u) == 0x7f80u) bad = true; }
        else { const float* q = (const float*)(ws + B[p].off); for (size_t i = (size_t)blockIdx.x * 512 + threadIdx.x; i < B[p].n; i += (size_t)gridDim.x * 512) if (!(fabsf(q[i]) <= 3.0e38f)) bad = true; }
        if (bad) atomicMax(word, (unsigned)(100 - p)); }
}
__global__ void __launch_bounds__(512) diag_scan3(unsigned char* ws, unsigned* word) {
    const unsigned short* ut = (const unsigned short*)(ws + WS_UT); const unsigned short* wm = (const unsigned short*)(ws + WS_WM);
    const size_t nprompt = (size_t)256 * 8 * 128 * 64, nall = (size_t)257 * 8 * 128 * 64;
    bool b1 = false, b2 = false, b3 = false, b4 = false;
    for (size_t i = (size_t)blockIdx.x * 512 + threadIdx.x; i < nall; i += (size_t)gridDim.x * 512) { const bool bu = (ut[i] & 0x7f80u) == 0x7f80u, bw = (wm[i] & 0x7f80u) == 0x7f80u;
        if (bu) { if (i < nprompt) b1 = true; else b2 = true; } if (bw) { if (i < nprompt) b3 = true; else b4 = true; } }
    if (b1) atomicMax(word, 100u - 1u); if (b2) atomicMax(word, 100u - 2u); if (b3) atomicMax(word, 100u - 3u); if (b4) atomicMax(word, 100u - 4u);
}
__global__ void __launch_bounds__(512) diag_out(float* out, const unsigned* word) {
    for (size_t i = (size_t)blockIdx.x * 512 + threadIdx.x; i < O_END; i += (size_t)gridDim.x * 512) out[i] = 0.f;
    if (blockIdx.x == 0 && threadIdx.x == 0) { const unsigned w = *word; float v = 1.0f; if (w) { const int p = 100 - (int)w; v = 1000.f; for (int k = 0; k < p; ++k) v *= 10.f; } out[O_YS] = v; }
}
#endif

extern "C" void kernel_launch(void* const* d_in, const int* in_sizes, int n_in, void* d_out, int out_size, void* d_ws, size_t ws_size, hipStream_t stream) {
    static int grid = 0;
    if (grid == 0) {
        if (n_in != 29 || (size_t)out_size != O_END || ws_size < WS_END) { fprintf(stderr, "kernel_launch: unexpected shapes (n_in %d, out %d vs %zu, ws %zu vs %zu)\n", n_in, out_size, (size_t)O_END, ws_size, (size_t)WS_END); grid = -1; return; }
        int dev = 0, cus = 0, per_cu = 0;
        if (hipGetDevice(&dev) != hipSuccess || hipDeviceGetAttribute(&cus, hipDeviceAttributeMultiprocessorCount, dev) != hipSuccess) { grid = -1; return; }
        if (hipFuncSetAttribute((const void*)mk, hipFuncAttributeMaxDynamicSharedMemorySize, LDS_BYTES) != hipSuccess) { fprintf(stderr, "kernel_launch: hipFuncSetAttribute failed\n"); grid = -1; return; }
        if (hipOccupancyMaxActiveBlocksPerMultiprocessor(&per_cu, (const void*)mk, 512, LDS_BYTES) != hipSuccess || per_cu < 1) fprintf(stderr, "kernel_launch: occupancy query says %d\n", per_cu);
        (void)hipGetLastError();
        grid = cus;
    }
    if (grid < 0) return;
    (void)hipMemsetAsync((char*)d_ws + WS_CTL, 0, CTL_BYTES, stream);
    Args a{};
    for (int i = 0; i < 29; ++i) a.in[i] = (const float*)d_in[i];
    a.out = (float*)d_out; a.ws = (unsigned char*)d_ws;
#if MK_SINGLE
    a.ph_lo = 0; a.ph_hi = PH_END;
    hipLaunchKernelGGL(mk, dim3(grid), dim3(512), LDS_BYTES, stream, a);
#else
#ifdef MK_DIAG
    for (int ph = 0; ph < 2 + 3; ++ph) { a.ph_lo = ph; a.ph_hi = ph + 1; hipLaunchKernelGGL(mk, dim3(grid), dim3(512), LDS_BYTES, stream, a); }
    hipLaunchKernelGGL(diag_scan3, dim3(1024), dim3(512), 0, stream, (unsigned char*)d_ws, (unsigned*)((char*)d_ws + 8192));
#ifndef MK_DIAG2
    hipLaunchKernelGGL(diag_scan, dim3(1024), dim3(512), 0, stream, (unsigned char*)d_ws, (unsigned*)((char*)d_ws + 8192));
#endif
    hipLaunchKernelGGL(diag_out, dim3(1024), dim3(512), 0, stream, (float*)d_out, (const unsigned*)((char*)d_ws + 8192));
#else
    for (int ph = 0; ph < PH_END; ++ph) { a.ph_lo = ph; a.ph_hi = ph + 1; hipLaunchKernelGGL(mk, dim3(grid), dim3(512), LDS_BYTES, stream, a); }
#endif
#endif
}
```

```cpp
#include <hip/hip_runtime.h>
#include <cstdio>
#include <cstdint>

#ifndef PH_ENABLE
#define PH_ENABLE 0xFFFFFFFFu
#endif
#define PHON(k) (((PH_ENABLE) >> (k)) & 1u)
#ifndef MK_TIME_A
#define MK_TIME_A 0
#define MK_TIME_B 0
#endif
#ifndef MK_REP
#define MK_REP 0u
#endif
#define REPN(k) ((((MK_REP) >> (k)) & 1u) ? 2 : 1)
#ifndef MK_SINGLE
#define MK_SINGLE 1
#endif

#define LAS __attribute__((address_space(3)))
typedef unsigned short bf16_t;
typedef short bf16x8 __attribute__((ext_vector_type(8)));
typedef float f32x4 __attribute__((ext_vector_type(4)));
typedef float f32x2 __attribute__((ext_vector_type(2)));
typedef unsigned u32x4 __attribute__((ext_vector_type(4)));
typedef unsigned u32x2 __attribute__((ext_vector_type(2)));

constexpr int D = 1024, DEPTH = 4, NB = 8, SEQ = 2048, DB = 128, DS = 4, NMETA = 16;
constexpr int MP = 17152, ROW_S0 = 16384, ROW_M0 = 16896;
constexpr int DI = 2048, XBC = 3072, QKV = 3072, NPROJ = 11264, NPROJ_T = 11520, DFF = 2816, NUP = 5632, IN_DIM = 11312;
constexpr int NH = 32, HP = 64, NST = 128, NG = 4, GH = 8, DK = 128, DV = 128;
constexpr int NCHUNK = 265;
constexpr int CID_S0 = 256, CID_M = 264;
constexpr float EPS = 1e-6f;
constexpr int PC_Z = 0, PC_XBC = 2048, PC_QKV = 5120, PC_GATE = 8192, PC_MGS = 9216, PC_MGG = 10240;

constexpr size_t al(size_t x) { return (x + 4095) & ~(size_t)4095; }
constexpr size_t WS_CTL = 0, CTL_BYTES = 1u << 20;
constexpr size_t WS_WIN = WS_CTL + CTL_BYTES;                         constexpr size_t SZ_WIN = (size_t)NPROJ_T * D * 2;
constexpr size_t WS_WSO = WS_WIN + DEPTH * SZ_WIN;                    constexpr size_t SZ_WSO = (size_t)D * DI * 2;
constexpr size_t WS_WGO = WS_WSO + DEPTH * SZ_WSO;                    constexpr size_t SZ_WGO = (size_t)D * D * 2;
constexpr size_t WS_WO  = WS_WGO + DEPTH * SZ_WGO;                    constexpr size_t SZ_WO  = (size_t)D * D * 2;
constexpr size_t WS_WUP = WS_WO + DEPTH * SZ_WO;                      constexpr size_t SZ_WUP = (size_t)NUP * D * 2;
constexpr size_t WS_WDN = WS_WUP + DEPTH * SZ_WUP;                    constexpr size_t SZ_WDN = (size_t)D * DFF * 2;
constexpr size_t WS_X   = WS_WDN + DEPTH * SZ_WDN;
constexpr size_t WS_XB  = WS_X + (size_t)MP * D * 4;
constexpr size_t WS_RSS = WS_XB + (size_t)MP * D * 2;
constexpr size_t WS_PROJ = al(WS_RSS + (size_t)MP * 16 * 4);
constexpr size_t WS_SMALL = WS_PROJ + (size_t)MP * NPROJ * 2;
constexpr size_t WS_SM2 = WS_SMALL + (size_t)MP * 64 * 4;
constexpr size_t WS_XBCA = al(WS_SM2 + (size_t)MP * 80 * 4);
constexpr size_t WS_QKVA = WS_XBCA + (size_t)MP * XBC * 2;
constexpr size_t WS_XTG = WS_QKVA + (size_t)MP * QKV * 2;
constexpr size_t WS_BTG = WS_XTG + (size_t)NCHUNK * 2048 * 64 * 2;
constexpr size_t WS_KBT = WS_BTG + (size_t)NCHUNK * 512 * 64 * 2;
constexpr size_t WS_KGT = WS_KBT + (size_t)NCHUNK * 1024 * 64 * 2;
constexpr size_t WS_VBT = WS_KGT + (size_t)NCHUNK * 1024 * 64 * 2;
constexpr size_t WS_ATTN = WS_VBT + (size_t)NCHUNK * 1024 * 64 * 2;
constexpr size_t WS_UT = WS_ATTN + (size_t)257 * 8 * 64 * 64 * 2;
constexpr size_t WS_WM = WS_UT + (size_t)257 * 8 * 128 * 64 * 2;
constexpr size_t WS_YS = WS_WM + (size_t)257 * 8 * 128 * 64 * 2;
constexpr size_t WS_SSQ = WS_YS + (size_t)MP * DI * 2;
constexpr size_t WS_YG = WS_SSQ + (size_t)MP * 32 * 4;
constexpr size_t WS_T1 = WS_YG + (size_t)MP * D * 2;
constexpr size_t WS_MRG = WS_T1 + (size_t)MP * D * 4;
constexpr size_t WS_UP = WS_MRG + (size_t)MP * D * 2;
constexpr size_t WS_ACT = WS_UP + (size_t)MP * NUP * 2;
constexpr size_t WS_SLAB = WS_ACT + (size_t)MP * DFF * 2;
constexpr size_t WS_END = WS_SLAB + (size_t)268 * 65536 * 4;

constexpr size_t O_YP = 0;
constexpr size_t O_YS = O_YP + (size_t)NB * SEQ * D;
constexpr size_t O_PSSM = O_YS + (size_t)DB * DS * D;
constexpr size_t O_PSC = O_PSSM + (size_t)DEPTH * NB * NH * HP * NST;
constexpr size_t O_PGDN = O_PSC + (size_t)DEPTH * NB * 3 * XBC;
constexpr size_t O_PGC = O_PGDN + (size_t)DEPTH * NB * 8 * DK * DV;
constexpr size_t O_PFC = O_PGC + (size_t)DEPTH * NB * 3 * QKV;
constexpr size_t O_SSSM = O_PFC + (size_t)DEPTH * NB * 2 * DFF;
constexpr size_t O_SSC = O_SSSM + (size_t)DEPTH * DB * NH * HP * NST;
constexpr size_t O_SGDN = O_SSC + (size_t)DEPTH * DB * 3 * XBC;
constexpr size_t O_SGC = O_SGDN + (size_t)DEPTH * DB * 8 * DK * DV;
constexpr size_t O_SFC = O_SGC + (size_t)DEPTH * DB * 3 * QKV;
constexpr size_t O_END = O_SFC + (size_t)DEPTH * DB * 2 * DFF;

typedef __bf16 bf16x2_t __attribute__((ext_vector_type(2)));
__device__ __forceinline__ unsigned cvt_pk_bf16(float lo, float hi) { bf16x2_t v; v[0] = (__bf16)lo; v[1] = (__bf16)hi; return __builtin_bit_cast(unsigned, v); }
__device__ __forceinline__ float bf_lo(unsigned w) { return __uint_as_float(w << 16); }
__device__ __forceinline__ float bf_hi(unsigned w) { return __uint_as_float(w & 0xffff0000u); }
__device__ __forceinline__ float bf1(bf16_t b) { return __uint_as_float(((unsigned)b) << 16); }
__device__ __forceinline__ float sigmoidf_(float x) { return __builtin_amdgcn_rcpf(1.0f + __expf(-x)); }
__device__ __forceinline__ float siluf_(float x) { return x * __builtin_amdgcn_rcpf(1.0f + __expf(-x)); }
__device__ __forceinline__ float softplusf_(float x) { return fmaxf(x, 0.f) + log1pf(__expf(-fabsf(x))); }
__device__ __forceinline__ int tidx() { int t = threadIdx.x; asm volatile("" : "+v"(t)); return t; }
__device__ __forceinline__ int bidx() { int t = blockIdx.x; asm volatile("" : "+s"(t)); return t; }
__device__ __forceinline__ int gdim() { int t = gridDim.x; asm volatile("" : "+s"(t)); return t; }
__device__ __forceinline__ u32x2 pack4(const f32x4 v) { u32x2 o; o.x = cvt_pk_bf16(v[0], v[1]); o.y = cvt_pk_bf16(v[2], v[3]); return o; }
__device__ __forceinline__ void unpack8(const u32x4 w, float (&f)[8]) { f[0] = bf_lo(w.x); f[1] = bf_hi(w.x); f[2] = bf_lo(w.y); f[3] = bf_hi(w.y); f[4] = bf_lo(w.z); f[5] = bf_hi(w.z); f[6] = bf_lo(w.w); f[7] = bf_hi(w.w); }
#define LDS_WAIT() asm volatile("s_waitcnt lgkmcnt(0)" ::: "memory")
#define VM_WAIT() asm volatile("s_waitcnt vmcnt(0)" ::: "memory")

namespace pg8 {
#define PG8_LAS __attribute__((address_space(3)))
constexpr int BM = 256, BK = 64, HALF = 128, HTB = HALF * BK * 2, STAGE_BYTES = 8 * HTB, NXCD = 8, WGM = 8;
__host__ __device__ __forceinline__ int lds_byte(int r, int c) { const int st = (r >> 4) * 2 + (c >> 5), rr = r & 15, cc = c & 31, ob = rr * 64 + cc * 2; return st * 1024 + (ob ^ (((ob >> 9) & 1) << 5)); }
__host__ __device__ __forceinline__ void stage_rc(int b, int& R, int& C) { const int st = b / 1024, sb = b % 1024, swz = sb ^ (((sb >> 9) & 1) << 5); R = (st >> 1) * 16 + swz / 64; C = (st & 1) * 32 + (swz % 64) / 2; }
__host__ __device__ __forceinline__ int perm32(int rho) { const int n = rho >> 4, i = rho & 15; return 8 * (i >> 2) + 4 * n + (i & 3); }
struct Unit { int pm, pn, kt0, nkt, role, uid; };
struct Gemm { const bf16_t* A; const bf16_t* Bt; int M, N, K; };
struct StaticOrder {
    int nM, nN, nwg, G, c;
    __host__ __device__ void init(int M, int N, int G_, int c_) { nM = M / BM; nN = N / BM; nwg = nM * nN; G = G_; c = c_; }
    __host__ __device__ bool next(int i, Unit& u) const {
        const long L = (long)i * G + c; if (L >= nwg) return false;
        int wgid = (int)L; { const int q = nwg / NXCD, r = nwg % NXCD, xcd = wgid % NXCD, off = wgid / NXCD; wgid = (xcd < r ? xcd * (q + 1) : r * (q + 1) + (xcd - r) * q) + off; }
        const int nig = WGM * nN, gid = wgid / nig, fm = gid * WGM, gsz = (nM - fm) < WGM ? (nM - fm) : WGM;
        u.pm = fm + ((wgid % nig) % gsz); u.pn = (wgid % nig) / gsz; u.kt0 = 0; u.nkt = 0; u.role = 0; u.uid = 0; return true;
    }
    __device__ __forceinline__ void a_ready(const Unit&) const {}
    __device__ __forceinline__ void done(const Unit&) const {}
    template <class Epi> __device__ __forceinline__ void epilogue(f32x4 (&acc)[2][2][4][2], const Unit& u, const Epi& E, int wr, int wc, int fr, int fq) const { E(acc, u, wr, wc, fr, fq); }
};
struct StreamK {
    int nN, P, lo, hi; float* slab; unsigned* flags;
    __device__ __forceinline__ void init(int M, int N, int K, int G_, int c_, float* slab_, unsigned* flags_) { nN = N / BM; P = K / (2 * BK); const int c = (G_ % NXCD == 0) ? (c_ % NXCD) * (G_ / NXCD) + c_ / NXCD : c_;
        const int TP = (M / BM) * nN * P; lo = c * TP / G_; hi = (c + 1) * TP / G_; slab = slab_; flags = flags_; }
    __device__ __forceinline__ bool next(int i, Unit& u) const {
        const int st = i == 0 ? lo : (lo / P + i) * P; if (st >= hi) return false;
        const int ui = st / P, ub = ui * P, en = (ub + P) < hi ? (ub + P) : hi, p0 = st - ub, p1 = en - ub;
        u.pm = ui / nN; u.pn = ui - u.pm * nN; u.kt0 = 2 * p0; u.nkt = 2 * (p1 - p0); u.uid = ui; u.role = p0 > 0 ? 2 : (p1 < P ? 1 : 0); return true;
    }
    __device__ __forceinline__ void a_ready(const Unit&) const {}
    __device__ __forceinline__ void done(const Unit&) const {}
    template <class Epi> __device__ __forceinline__ void epilogue(f32x4 (&acc)[2][2][4][2], const Unit& u, const Epi& E, int wr, int wc, int fr, int fq) const {
        const int tid = threadIdx.x, lane = tid & 63; const int uid = __builtin_amdgcn_readfirstlane(u.uid);
        if (u.role == 2) {
            const __amdgpu_buffer_rsrc_t rs = __builtin_amdgcn_make_buffer_rsrc(slab + (size_t)uid * 65536, 0, 262144, 0x00020000);
#pragma unroll
            for (int k = 0; k < 32; ++k) __builtin_amdgcn_raw_buffer_store_b128(__builtin_bit_cast(u32x4, acc[k >> 4][(k >> 3) & 1][(k >> 1) & 3][k & 1]), rs, tid * 16, k * 8192, 16);
            asm volatile("s_waitcnt vmcnt(0)" ::: "memory");
            if (lane == 0) __hip_atomic_fetch_add(flags + uid, 1u, __ATOMIC_RELAXED, __HIP_MEMORY_SCOPE_AGENT);
            return;
        }
        if (u.role == 1) {
            unsigned sp = 0;
            while ((unsigned)__builtin_amdgcn_readfirstlane(__hip_atomic_load(flags + uid, __ATOMIC_RELAXED, __HIP_MEMORY_SCOPE_AGENT)) < 8u) { __builtin_amdgcn_s_sleep(2); if (++sp > (1u << 22)) break; }
            __builtin_amdgcn_fence(__ATOMIC_ACQUIRE, "agent"); asm volatile("s_waitcnt vmcnt(0)" ::: "memory");
            const __amdgpu_buffer_rsrc_t rl = __builtin_amdgcn_make_buffer_rsrc(slab + (size_t)uid * 65536, 0, 262144, 0x00020000);
#pragma unroll
            for (int k = 0; k < 32; ++k) acc[k >> 4][(k >> 3) & 1][(k >> 1) & 3][k & 1] += __builtin_bit_cast(f32x4, __builtin_amdgcn_raw_buffer_load_b128(rl, tid * 16, k * 8192, 16));
        }
        E(acc, u, wr, wc, fr, fq);
    }
};

template <class Epi, class Sched, bool ALIGN_EPI = false, bool SP2 = false>
__device__ __forceinline__ void gemm_phase(PG8_LAS unsigned char* lds, const Gemm g, const Sched& S, const Epi& E) {
    const int tid = tidx(), wid = __builtin_amdgcn_readfirstlane(tid >> 6), lane = tid & 63, wr = wid >> 2, wc = wid & 3, fr = lane & 15, fq = lane >> 4;
    const int K = g.K, nt = K / BK;
    unsigned voffA[2], voffB[2];
#pragma unroll
    for (int i = 0; i < 2; ++i) { int R, C; stage_rc(tid * 16 + i * 8192, R, C); const int Rb = Epi::PERM ? ((R & ~31) + perm32(R & 31)) : R;
        voffA[i] = (unsigned)(R * K + C) * 2u; voffB[i] = (unsigned)(Rb * K + C) * 2u; }
    const size_t kstep = (size_t)(BK * 2);
    const size_t hstep = (size_t)HALF * K * 2;
    const size_t tstep = 2 * hstep;
    const unsigned ldsw = (unsigned)wid * 1024u;
    const int aoff = lds_byte(wr * 64 + fr, fq * 8), boff = lds_byte(wc * 32 + fr, fq * 8);
#define PG8_SA(b, h) (((b) * 2 + (h)) * HTB)
#define PG8_SB(b, h) ((4 + (b) * 2 + (h)) * HTB)
#define PG8_STAGE(bufoff, gbase, voff) do { _Pragma("unroll") for (int _i = 0; _i < 2; ++_i) \
        __builtin_amdgcn_global_load_lds((const unsigned*)((const char*)(gbase) + (voff)[_i]), (PG8_LAS unsigned*)(lds + (bufoff) + ldsw + _i * 8192), 16, 0, 0); } while (0)
#define PG8_LDA(dst, b, h) do { _Pragma("unroll") for (int m = 0; m < 4; ++m) _Pragma("unroll") for (int k = 0; k < 2; ++k) dst[m][k] = *(const PG8_LAS bf16x8*)(lds + PG8_SA(b, h) + aoff + m * 2048 + k * 1024); } while (0)
#define PG8_LDB(dst, b, h) do { _Pragma("unroll") for (int n = 0; n < 2; ++n) _Pragma("unroll") for (int k = 0; k < 2; ++k) dst[n][k] = *(const PG8_LAS bf16x8*)(lds + PG8_SB(b, h) + boff + n * 2048 + k * 1024); } while (0)
#define PG8_MMA(ai, bj, At, Bt) do { __builtin_amdgcn_s_setprio(1); _Pragma("unroll") for (int m = 0; m < 4; ++m) _Pragma("unroll") for (int n = 0; n < 2; ++n) _Pragma("unroll") for (int k = 0; k < 2; ++k) \
        acc[ai][bj][m][n] = __builtin_amdgcn_mfma_f32_16x16x32_bf16(Bt[n][k], At[m][k], acc[ai][bj][m][n], 0, 0, 0); __builtin_amdgcn_s_setprio(0); } while (0)
#define PG8_WAIT_V(n) asm volatile("s_waitcnt vmcnt(" #n ")" ::: "memory")
#define PG8_WAIT_L(n) asm volatile("s_waitcnt lgkmcnt(" #n ")" ::: "memory")
#define PG8_BAR __builtin_amdgcn_s_barrier()
#define PG8_SCHED __builtin_amdgcn_sched_barrier(0)
    Unit cur, nxt; int ui = 0;
    if (!S.next(0, cur)) return;
    f32x4 acc[2][2][4][2];
#pragma unroll
    for (int a = 0; a < 2; ++a)
#pragma unroll
        for (int b = 0; b < 2; ++b)
#pragma unroll
            for (int m = 0; m < 4; ++m)
#pragma unroll
                for (int n = 0; n < 2; ++n) acc[a][b][m][n] = (f32x4){0.f, 0.f, 0.f, 0.f};
    bf16x8 At[4][2], B0[2][2], B1[2][2];
    const char* cA = (const char*)g.A + (size_t)cur.pm * tstep + (size_t)cur.kt0 * kstep; const char* cB = (const char*)g.Bt + (size_t)cur.pn * tstep + (size_t)cur.kt0 * kstep;
    S.a_ready(cur);
    if constexpr (SP2) {
        PG8_STAGE(PG8_SB(0, 0), cB, voffB); PG8_STAGE(PG8_SB(0, 1), cB + hstep, voffB); PG8_STAGE(PG8_SA(0, 0), cA, voffA); PG8_STAGE(PG8_SA(0, 1), cA + hstep, voffA);
        if (wr == 1) PG8_BAR;
        PG8_WAIT_V(2); PG8_BAR;
        PG8_STAGE(PG8_SB(1, 0), cB + kstep, voffB); PG8_STAGE(PG8_SA(1, 0), cA + kstep, voffA); PG8_STAGE(PG8_SB(1, 1), cB + hstep + kstep, voffB);
        PG8_WAIT_V(6); PG8_BAR;
    } else {
        PG8_STAGE(PG8_SB(0, 0), cB, voffB); PG8_STAGE(PG8_SA(0, 0), cA, voffA); PG8_STAGE(PG8_SB(0, 1), cB + hstep, voffB); PG8_STAGE(PG8_SA(0, 1), cA + hstep, voffA);
        if (wr == 1) PG8_BAR;
        PG8_WAIT_V(4); PG8_BAR;
        PG8_STAGE(PG8_SB(1, 0), cB + kstep, voffB); PG8_STAGE(PG8_SA(1, 0), cA + kstep, voffA); PG8_STAGE(PG8_SB(1, 1), cB + hstep + kstep, voffB);
        PG8_WAIT_V(6); PG8_BAR;
    }
    for (;;) {
        const bool has_next = S.next(ui + 1, nxt);
        const char* nA = has_next ? (const char*)g.A + (size_t)nxt.pm * tstep + (size_t)nxt.kt0 * kstep : cA; const char* nB = has_next ? (const char*)g.Bt + (size_t)nxt.pn * tstep + (size_t)nxt.kt0 * kstep : cB;
        const int ntc = cur.nkt ? cur.nkt : nt;
        for (int t = 0; t < ntc; t += 2) {
            const bool last = (t == ntc - 2);
            const char* a1 = cA + (size_t)(t + 1) * kstep;
            const char* a2 = last ? nA : cA + (size_t)(t + 2) * kstep; const char* b2 = last ? nB : cB + (size_t)(t + 2) * kstep;
            const char* a3 = a2 + kstep; const char* b3 = b2 + kstep;
            if (last && has_next) S.a_ready(nxt);
            if constexpr (SP2) {
            PG8_LDB(B0, 0, 0); PG8_LDB(B1, 0, 1); PG8_SCHED; PG8_LDA(At, 0, 0); PG8_STAGE(PG8_SA(1, 1), a1 + hstep, voffA);
            PG8_WAIT_V(8); PG8_WAIT_L(0); PG8_BAR; PG8_MMA(0, 0, At, B0); PG8_MMA(0, 1, At, B1); PG8_BAR; PG8_SCHED;
            PG8_LDA(At, 0, 1); PG8_STAGE(PG8_SB(0, 0), b2, voffB); PG8_STAGE(PG8_SB(0, 1), b2 + hstep, voffB); PG8_STAGE(PG8_SA(0, 0), a2, voffA);
            PG8_WAIT_V(8); PG8_WAIT_L(0); PG8_BAR; PG8_MMA(1, 0, At, B0); PG8_MMA(1, 1, At, B1); PG8_BAR; PG8_SCHED;
            PG8_LDB(B0, 1, 0); PG8_LDB(B1, 1, 1); PG8_SCHED; PG8_LDA(At, 1, 0); PG8_STAGE(PG8_SA(0, 1), a2 + hstep, voffA);
            PG8_WAIT_V(8); PG8_WAIT_L(0); PG8_BAR; PG8_MMA(0, 0, At, B0); PG8_MMA(0, 1, At, B1); PG8_BAR; PG8_SCHED;
            PG8_LDA(At, 1, 1); PG8_STAGE(PG8_SB(1, 0), b3, voffB); PG8_STAGE(PG8_SB(1, 1), b3 + hstep, voffB); PG8_STAGE(PG8_SA(1, 0), a3, voffA);
            PG8_WAIT_V(8); PG8_WAIT_L(0); PG8_BAR; PG8_MMA(1, 0, At, B0); PG8_MMA(1, 1, At, B1); PG8_BAR; PG8_SCHED;
            } else {
            PG8_LDB(B0, 0, 0); PG8_SCHED; PG8_LDA(At, 0, 0); PG8_STAGE(PG8_SA(1, 1), a1 + hstep, voffA);
            PG8_WAIT_L(8); PG8_BAR; PG8_WAIT_L(0); PG8_MMA(0, 0, At, B0); PG8_BAR; PG8_SCHED;
            PG8_LDB(B1, 0, 1); PG8_STAGE(PG8_SB(0, 0), b2, voffB);
            PG8_BAR; PG8_WAIT_L(0); PG8_MMA(0, 1, At, B1); PG8_BAR;
            PG8_LDA(At, 0, 1); PG8_STAGE(PG8_SA(0, 0), a2, voffA);
            PG8_BAR; PG8_WAIT_L(0); PG8_MMA(1, 0, At, B0); PG8_BAR; PG8_SCHED;
            PG8_STAGE(PG8_SB(0, 1), b2 + hstep, voffB);
            PG8_WAIT_V(6); PG8_BAR; PG8_MMA(1, 1, At, B1); PG8_BAR;
            PG8_LDB(B0, 1, 0); PG8_SCHED; PG8_LDA(At, 1, 0); PG8_STAGE(PG8_SA(0, 1), a2 + hstep, voffA);
            PG8_WAIT_L(8); PG8_BAR; PG8_WAIT_L(0); PG8_MMA(0, 0, At, B0); PG8_BAR; PG8_SCHED;
            PG8_LDB(B1, 1, 1); PG8_STAGE(PG8_SB(1, 0), b3, voffB);
            PG8_BAR; PG8_WAIT_L(0); PG8_MMA(0, 1, At, B1); PG8_BAR;
            PG8_LDA(At, 1, 1); PG8_STAGE(PG8_SA(1, 0), a3, voffA);
            PG8_BAR; PG8_WAIT_L(0); PG8_MMA(1, 0, At, B0); PG8_BAR; PG8_SCHED;
            PG8_STAGE(PG8_SB(1, 1), b3 + hstep, voffB);
            PG8_WAIT_V(6); PG8_BAR; PG8_MMA(1, 1, At, B1); PG8_BAR;
            }
        }
        if constexpr (ALIGN_EPI) { if (wr == 0) PG8_BAR; }
        S.epilogue(acc, cur, E, wr, wc, fr, fq); S.done(cur);
        if (!has_next) break;
#pragma unroll
        for (int a = 0; a < 2; ++a)
#pragma unroll
            for (int b = 0; b < 2; ++b)
#pragma unroll
                for (int m = 0; m < 4; ++m)
#pragma unroll
                    for (int n = 0; n < 2; ++n) acc[a][b][m][n] = (f32x4){0.f, 0.f, 0.f, 0.f};
        cur = nxt; cA = nA; cB = nB; ++ui;
        if constexpr (ALIGN_EPI) { if (wr == 1) PG8_BAR; }
    }
    PG8_WAIT_V(0);
    if constexpr (!ALIGN_EPI) { if (wr == 0) PG8_BAR; }
    PG8_BAR;
#undef PG8_SA
#undef PG8_SB
#undef PG8_STAGE
#undef PG8_LDA
#undef PG8_LDB
#undef PG8_MMA
#undef PG8_WAIT_V
#undef PG8_WAIT_L
#undef PG8_BAR
#undef PG8_SCHED
}

__device__ __forceinline__ float row_rstd(const float* rss, int row) {
    const f32x4* p = (const f32x4*)(rss + (size_t)row * 16); const f32x4 a = p[0], b = p[1], c = p[2], d = p[3];
    const float s = ((a[0] + a[1]) + (a[2] + a[3])) + ((b[0] + b[1]) + (b[2] + b[3])) + ((c[0] + c[1]) + (c[2] + c[3])) + ((d[0] + d[1]) + (d[2] + d[3]));
    return rsqrtf(s * (1.0f / 1024.0f) + EPS);
}
struct EpiScaleBf16 {
    static constexpr bool PERM = true;
    bf16_t* O; int ldc; const float* rss; float* SM; int ntile_main;
    __device__ __forceinline__ void operator()(const f32x4 (&acc)[2][2][4][2], const Unit& u, int wr, int wc, int fr, int fq) const {
        const int row0 = u.pm * BM + wr * 64 + fr, cin = wc * 32 + 8 * fq;
#pragma unroll
        for (int ai = 0; ai < 2; ++ai)
#pragma unroll
            for (int m = 0; m < 4; ++m) { const int row = row0 + ai * HALF + m * 16; const float rs = row_rstd(rss, row);
#pragma unroll
                for (int bj = 0; bj < 2; ++bj) { const f32x4 v0 = acc[ai][bj][m][0] * rs, v1 = acc[ai][bj][m][1] * rs;
                    if (u.pn < ntile_main) { u32x4 w; w.x = cvt_pk_bf16(v0[0], v0[1]); w.y = cvt_pk_bf16(v0[2], v0[3]); w.z = cvt_pk_bf16(v1[0], v1[1]); w.w = cvt_pk_bf16(v1[2], v1[3]);
                        *(u32x4*)(O + (size_t)row * ldc + u.pn * BM + cin + bj * HALF) = w; }
                    else { const int c = cin + bj * HALF; if (c < 64) { float* p = SM + (size_t)row * 64 + c; *(f32x4*)p = v0; *(f32x4*)(p + 4) = v1; } } } }
    }
};
struct EpiGateF32 {
    static constexpr bool PERM = true;
    float* T1; const bf16_t* P; int gcol0;
    __device__ __forceinline__ void operator()(const f32x4 (&acc)[2][2][4][2], const Unit& u, int wr, int wc, int fr, int fq) const {
        const int row0 = u.pm * BM + wr * 64 + fr, col0 = u.pn * BM + wc * 32 + 8 * fq;
#pragma unroll
        for (int ai = 0; ai < 2; ++ai)
#pragma unroll
            for (int m = 0; m < 4; ++m) { const int row = row0 + ai * HALF + m * 16;
#pragma unroll
                for (int bj = 0; bj < 2; ++bj) { const int c = col0 + bj * HALF; const u32x4 g = *(const u32x4*)(P + (size_t)row * NPROJ + gcol0 + c);
                    const f32x4 a0 = acc[ai][bj][m][0], a1 = acc[ai][bj][m][1]; f32x4 o0, o1;
                    o0[0] = sigmoidf_(bf_lo(g.x)) * a0[0]; o0[1] = sigmoidf_(bf_hi(g.x)) * a0[1]; o0[2] = sigmoidf_(bf_lo(g.y)) * a0[2]; o0[3] = sigmoidf_(bf_hi(g.y)) * a0[3];
                    o1[0] = sigmoidf_(bf_lo(g.z)) * a1[0]; o1[1] = sigmoidf_(bf_hi(g.z)) * a1[1]; o1[2] = sigmoidf_(bf_lo(g.w)) * a1[2]; o1[3] = sigmoidf_(bf_hi(g.w)) * a1[3];
                    *(f32x4*)(T1 + (size_t)row * D + c) = o0; *(f32x4*)(T1 + (size_t)row * D + c + 4) = o1; } }
    }
};
struct EpiMerge {
    static constexpr bool PERM = true;
    bf16_t* O; const float* T1; const bf16_t* P; int gcol0;
    __device__ __forceinline__ void operator()(const f32x4 (&acc)[2][2][4][2], const Unit& u, int wr, int wc, int fr, int fq) const {
        const int row0 = u.pm * BM + wr * 64 + fr, col0 = u.pn * BM + wc * 32 + 8 * fq;
#pragma unroll
        for (int ai = 0; ai < 2; ++ai)
#pragma unroll
            for (int m = 0; m < 4; ++m) { const int row = row0 + ai * HALF + m * 16;
#pragma unroll
                for (int bj = 0; bj < 2; ++bj) { const int c = col0 + bj * HALF; const u32x4 g = *(const u32x4*)(P + (size_t)row * NPROJ + gcol0 + c);
                    const f32x4 t0 = *(const f32x4*)(T1 + (size_t)row * D + c), t1 = *(const f32x4*)(T1 + (size_t)row * D + c + 4);
                    const f32x4 a0 = acc[ai][bj][m][0], a1 = acc[ai][bj][m][1];
                    u32x4 w; w.x = cvt_pk_bf16(t0[0] + sigmoidf_(bf_lo(g.x)) * a0[0], t0[1] + sigmoidf_(bf_hi(g.x)) * a0[1]); w.y = cvt_pk_bf16(t0[2] + sigmoidf_(bf_lo(g.y)) * a0[2], t0[3] + sigmoidf_(bf_hi(g.y)) * a0[3]);
                    w.z = cvt_pk_bf16(t1[0] + sigmoidf_(bf_lo(g.z)) * a1[0], t1[1] + sigmoidf_(bf_hi(g.z)) * a1[1]); w.w = cvt_pk_bf16(t1[2] + sigmoidf_(bf_lo(g.w)) * a1[2], t1[3] + sigmoidf_(bf_hi(g.w)) * a1[3]);
                    *(u32x4*)(O + (size_t)row * D + c) = w; } }
    }
};
struct EpiResid {
    static constexpr bool PERM = false;
    float* X; bf16_t* XB; float* rss;
    __device__ __forceinline__ void operator()(const f32x4 (&acc)[2][2][4][2], const Unit& u, int wr, int wc, int fr, int fq) const {
        const int row0 = u.pm * BM + wr * 64 + fr, col0 = u.pn * BM + wc * 32 + 4 * fq;
#pragma unroll
        for (int ai = 0; ai < 2; ++ai)
#pragma unroll
            for (int m = 0; m < 4; ++m) { const int row = row0 + ai * HALF + m * 16; float s = 0.f;
#pragma unroll
                for (int bj = 0; bj < 2; ++bj)
#pragma unroll
                    for (int n = 0; n < 2; ++n) { const int c = col0 + bj * HALF + n * 16; float* xp = X + (size_t)row * D + c; const f32x4 xn = *(const f32x4*)xp + acc[ai][bj][m][n];
                        *(f32x4*)xp = xn; u32x2 w; w.x = cvt_pk_bf16(xn[0], xn[1]); w.y = cvt_pk_bf16(xn[2], xn[3]); *(u32x2*)(XB + (size_t)row * D + c) = w;
                        s += (xn[0] * xn[0] + xn[1] * xn[1]) + (xn[2] * xn[2] + xn[3] * xn[3]); }
                s += __shfl_xor(s, 16); s += __shfl_xor(s, 32);
                if (fq == 0) rss[(size_t)row * 16 + u.pn * 4 + wc] = s; }
    }
};
}

#define XB_TMO      128
#define XB_XCNT(j)  (256  + 64 * (j))
#define XB_XSUB(j)  (1280 + 64 * (j))
#define XB_XGEN(j)  (2304 + 64 * (j))
#define XB_TOP      3328
#define XB_TOPGEN   3392
#define XCD_BAR_WORDS 3456
#define XB_SPIN_CAP (1u << 18)
__device__ __forceinline__ unsigned xb_ld(unsigned* p)              { return __hip_atomic_load(p, __ATOMIC_RELAXED, __HIP_MEMORY_SCOPE_AGENT); }
__device__ __forceinline__ unsigned xb_add(unsigned* p, unsigned v) { return __hip_atomic_fetch_add(p, v, __ATOMIC_RELAXED, __HIP_MEMORY_SCOPE_AGENT); }
__device__ __forceinline__ unsigned xb_xcc_id() { return (unsigned)__builtin_amdgcn_s_getreg((3 << 11) | 20) & 0xFu; }
#define XB_SPIN(cond, bar) do { unsigned _sp = 0; while (cond) { __builtin_amdgcn_s_sleep(1); \
    if ((++_sp & 255u) == 0u) { if (xb_ld(&(bar)[XB_TMO])) break; if (_sp > XB_SPIN_CAP) { atomicAdd(&(bar)[XB_TMO], 1u); break; } } } } while (0)
struct XcdBarrier { unsigned* bar; unsigned x; volatile LAS unsigned* st; };
__device__ __forceinline__ XcdBarrier xcd_barrier_post(unsigned* bar, volatile LAS unsigned* st) {
    XcdBarrier b; b.bar = bar; b.x = xb_xcc_id(); b.st = st;
    if (threadIdx.x == 0) (void)xb_add(&bar[XB_XCNT(b.x)], 1u);
    return b;
}
__device__ __forceinline__ void xcd_barrier_complete(unsigned* bar, unsigned x, unsigned& nloc, unsigned& nx) {
    const unsigned G = gridDim.x * gridDim.y * gridDim.z;
    unsigned sum, cnt, mine, sp = 0u;
    for (;;) {
        sum = 0u; cnt = 0u; mine = 0u;
#pragma unroll
        for (unsigned j = 0; j < 16; ++j) { const unsigned c = xb_ld(&bar[XB_XCNT(j)]); sum += c; cnt += (c > 0u) ? 1u : 0u; mine = (j == x) ? c : mine; }
        if (sum == G) break;
        __builtin_amdgcn_s_sleep(1);
        if ((++sp & 255u) == 0u) { if (xb_ld(&bar[XB_TMO])) break; if (sp > XB_SPIN_CAP) { atomicAdd(&bar[XB_TMO], 1u); break; } }
    }
    nloc = mine > 0u ? mine : 1u; nx = cnt > 0u ? cnt : 1u;
}
__device__ __forceinline__ void xcd_barrier(const XcdBarrier& b) {
    asm volatile("s_waitcnt vmcnt(0)" ::: "memory");
    __syncthreads();
    if (threadIdx.x == 0) {
        unsigned* bar = b.bar;
        __builtin_amdgcn_s_waitcnt(0);
        unsigned nloc = b.st[0], nx = b.st[1];
        if (nloc == 0u) { xcd_barrier_complete(bar, b.x, nloc, nx); b.st[0] = nloc; b.st[1] = nx; }
        const unsigned old = xb_add(&bar[XB_XSUB(b.x)], 1u);
        const unsigned gen = old / nloc;
        if (old + 1u == (gen + 1u) * nloc) {
            __builtin_amdgcn_fence(__ATOMIC_RELEASE, "agent");
            asm volatile("s_waitcnt vmcnt(0)" ::: "memory");
            const unsigned og = xb_add(&bar[XB_TOP], 1u);
            const unsigned tg = og / nx;
            if (og + 1u == (tg + 1u) * nx) xb_add(&bar[XB_TOPGEN], 1u);
            else XB_SPIN(xb_ld(&bar[XB_TOPGEN]) == tg, bar);
            __builtin_amdgcn_fence(__ATOMIC_ACQUIRE, "agent");
            xb_add(&bar[XB_XGEN(b.x)], 1u);
            asm volatile("s_waitcnt vmcnt(0)" ::: "memory");
        } else {
            XB_SPIN(xb_ld(&bar[XB_XGEN(b.x)]) == gen, bar);
            __builtin_amdgcn_fence(__ATOMIC_ACQUIRE, "agent");
            asm volatile("s_waitcnt vmcnt(0)" ::: "memory");
        }
    }
    __syncthreads();
}

struct Args {
    const float* in[29]; float* out; unsigned char* ws; int ph_lo, ph_hi;
};
enum { I_XP = 0, I_XS, I_SSSM, I_SSC, I_SGDN, I_SGC, I_SFC, I_META, I_NMIX, I_WIN, I_SCW, I_SCB, I_SDTB, I_SALOG, I_SD, I_SNW, I_GCW, I_GDTB, I_GALOG, I_GNW,
       I_WSO, I_WGO, I_WO, I_NFFN, I_WUP, I_FCW, I_FCB, I_WDN, I_NF };
constexpr int LDS_BYTES = 160 * 1024 - 512;
constexpr int LDS_CTL = LDS_BYTES - 64;

__device__ __forceinline__ float wave_sum(float v) {
#pragma unroll
    for (int o = 1; o < 64; o <<= 1) v += __shfl_xor(v, o);
    return v;
}

__device__ __forceinline__ int win_src_col(int n) {
    if (n < 5120) return n;
    if (n < 8192) return 5152 + (n - 5120);
    if (n < 9216) return 8240 + (n - 8192);
    if (n < 10240) return 9264 + (n - 9216);
    if (n < 11264) return 10288 + (n - 10240);
    if (n < 11296) return 5120 + (n - 11264);
    if (n < 11304) return 8224 + (n - 11296);
    if (n < 11312) return 8232 + (n - 11304);
    return -1;
}
template <int MODE>
__device__ __forceinline__ void transpose_item(const float* W, int K, int Nsrc, bf16_t* WT, const float* scale, int scale_mask, LAS float* scr, int item, int nblk, int lane) {
    const int kb = item / nblk, nb = item - kb * nblk, k0 = 64 * kb, n0 = 64 * nb;
    const int nq = lane & 15, kr = lane >> 4; const int n = n0 + 4 * nq; const int sc = MODE == 1 ? win_src_col(n) : n;
    f32x4 v[16];
#pragma unroll
    for (int i = 0; i < 16; ++i) { const int k = k0 + 4 * i + kr; v[i] = sc >= 0 ? *(const f32x4*)(W + (size_t)k * Nsrc + sc) : (f32x4){0.f, 0.f, 0.f, 0.f}; }
#pragma unroll
    for (int i = 0; i < 16; ++i) { const int kk = 4 * i + kr; const float sv = scale ? scale[(k0 + kk) & scale_mask] : 1.0f; LAS float* d = scr + kk * 65 + 4 * nq;
        d[0] = v[i][0] * sv; d[1] = v[i][1] * sv; d[2] = v[i][2] * sv; d[3] = v[i][3] * sv; }
    LDS_WAIT(); asm volatile("" ::: "memory");
    const int c = lane & 7;
#pragma unroll
    for (int j = 0; j < 8; ++j) { const int nn = (lane >> 3) + 8 * j; const LAS float* sp = scr + (8 * c) * 65 + nn;
        u32x4 o; o.x = cvt_pk_bf16(sp[0 * 65], sp[1 * 65]); o.y = cvt_pk_bf16(sp[2 * 65], sp[3 * 65]); o.z = cvt_pk_bf16(sp[4 * 65], sp[5 * 65]); o.w = cvt_pk_bf16(sp[6 * 65], sp[7 * 65]);
        *(u32x4*)(WT + (size_t)(n0 + nn) * K + k0 + 8 * c) = o; }
    LDS_WAIT(); asm volatile("" ::: "memory");
}
__device__ __forceinline__ void phase_weights(const Args& a, LAS unsigned char* lds) {
    const int lane = tidx() & 63, wave = tidx() >> 6;
    LAS float* scr = (LAS float*)(lds + wave * 17408);
    const int gw = bidx() * 8 + wave, NGW = gdim() * 8;
    constexpr int I_A = 16 * (NPROJ_T / 64), I_B = 32 * 16, I_C = 16 * 16, I_D = 16 * 16, I_E = 16 * (NUP / 64), I_F = 44 * 16, I_L = I_A + I_B + I_C + I_D + I_E + I_F;
    for (int it = gw; it < DEPTH * I_L; it += NGW) {
        const int l = it / I_L; int r = it % I_L;
        if (r < I_A) { transpose_item<1>(a.in[I_WIN] + (size_t)l * D * IN_DIM, D, IN_DIM, (bf16_t*)(a.ws + WS_WIN + l * SZ_WIN), a.in[I_NMIX] + l * D, 0xffff, scr, r, NPROJ_T / 64, lane); continue; } r -= I_A;
        if (r < I_B) { transpose_item<0>(a.in[I_WSO] + (size_t)l * DI * D, DI, D, (bf16_t*)(a.ws + WS_WSO + l * SZ_WSO), a.in[I_SNW] + l * DI, 0xffff, scr, r, 16, lane); continue; } r -= I_B;
        if (r < I_C) { transpose_item<0>(a.in[I_WGO] + (size_t)l * D * D, D, D, (bf16_t*)(a.ws + WS_WGO + l * SZ_WGO), a.in[I_GNW] + l * DV, 127, scr, r, 16, lane); continue; } r -= I_C;
        if (r < I_D) { transpose_item<0>(a.in[I_WO] + (size_t)l * D * D, D, D, (bf16_t*)(a.ws + WS_WO + l * SZ_WO), nullptr, 0, scr, r, 16, lane); continue; } r -= I_D;
        if (r < I_E) { transpose_item<0>(a.in[I_WUP] + (size_t)l * D * NUP, D, NUP, (bf16_t*)(a.ws + WS_WUP + l * SZ_WUP), a.in[I_NFFN] + l * D, 0xffff, scr, r, NUP / 64, lane); continue; } r -= I_E;
        transpose_item<0>(a.in[I_WDN] + (size_t)l * DFF * D, DFF, D, (bf16_t*)(a.ws + WS_WDN + l * SZ_WDN), nullptr, 0, scr, r, 16, lane);
    }
}

__device__ __forceinline__ const float* src_row(const Args& a, int row) {
    if (row < ROW_S0) return a.in[I_XP] + (size_t)row * D;
    if (row < ROW_M0) return a.in[I_XS] + (size_t)(row - ROW_S0) * D;
    if (row < ROW_M0 + NMETA) return a.in[I_META] + (size_t)(row - ROW_M0) * D;
    return nullptr;
}
__device__ __forceinline__ void phase_inputs(const Args& a) {
    const int lane = tidx() & 63, wave = tidx() >> 6;
    const int gw = bidx() * 8 + wave, NGW = gdim() * 8;
    float* X = (float*)(a.ws + WS_X); bf16_t* XB = (bf16_t*)(a.ws + WS_XB); float* RSS = (float*)(a.ws + WS_RSS);
    for (int row = gw; row < MP; row += NGW) {
        const float* s = src_row(a, row); float ss = 0.f;
#pragma unroll
        for (int j = 0; j < 4; ++j) { f32x4 v = s ? *(const f32x4*)(s + 256 * j + 4 * lane) : (f32x4){0.f, 0.f, 0.f, 0.f};
            *(f32x4*)(X + (size_t)row * D + 256 * j + 4 * lane) = v; u32x2 w; w.x = cvt_pk_bf16(v[0], v[1]); w.y = cvt_pk_bf16(v[2], v[3]);
            *(u32x2*)(XB + (size_t)row * D + 256 * j + 4 * lane) = w; ss += (v[0] * v[0] + v[1] * v[1]) + (v[2] * v[2] + v[3] * v[3]); }
        ss = wave_sum(ss);
        if (lane < 16) RSS[(size_t)row * 16 + lane] = lane == 0 ? ss : 0.f;
    }
}

struct Chunk { int row0, seg, nvalid, kind, b, c; };
__device__ __forceinline__ Chunk chunk_of(int cid) {
    Chunk k;
    if (cid < CID_S0) { k.kind = 0; k.b = cid >> 5; k.c = cid & 31; k.row0 = k.b * SEQ + 64 * k.c; k.seg = 64; k.nvalid = 64; }
    else if (cid < CID_M) { k.kind = 1; k.b = cid - CID_S0; k.c = 0; k.row0 = ROW_S0 + 64 * k.b; k.seg = 4; k.nvalid = 64; }
    else { k.kind = 2; k.b = 0; k.c = 0; k.row0 = ROW_M0; k.seg = 16; k.nvalid = 16; }
    return k;
}

__device__ __forceinline__ void phase_prep(const Args& a, int l, LAS unsigned char* lds) {
    const int tid = tidx();
    LAS float* tDT = (LAS float*)lds;
    LAS float* tAC = tDT + 64 * 32;
    LAS float* tG = tAC + 64 * 32;
    LAS float* tB = tG + 64 * 8;
    const bf16_t* PROJ = (const bf16_t*)(a.ws + WS_PROJ); const float* SMALL = (const float*)(a.ws + WS_SMALL); float* SM2 = (float*)(a.ws + WS_SM2);
    bf16_t* XBCA = (bf16_t*)(a.ws + WS_XBCA); bf16_t* QKVA = (bf16_t*)(a.ws + WS_QKVA);
    bf16_t* XTG = (bf16_t*)(a.ws + WS_XTG); bf16_t* BTG = (bf16_t*)(a.ws + WS_BTG); bf16_t* KBT = (bf16_t*)(a.ws + WS_KBT); bf16_t* KGT = (bf16_t*)(a.ws + WS_KGT); bf16_t* VBT = (bf16_t*)(a.ws + WS_VBT);
    for (int unit = bidx(); unit < 256 * 3 + 9 * 6; unit += gdim()) {
        const int ex = unit - 256 * 3; const int cid = ex < 0 ? unit / 3 : 256 + ex / 6, third = ex < 0 ? unit % 3 : (ex % 6) >> 1, halfsel = ex < 0 ? -1 : (ex & 1); const Chunk ck = chunk_of(cid);
        __syncthreads();
        for (int idx = tid; idx < 64 * 48; idx += 512) { const int tok = idx / 48, col = idx % 48; const float raw = SMALL[(size_t)(ck.row0 + tok) * 64 + col]; const bool valid = tok < ck.nvalid;
            if (col < 32) { const float dt = valid ? softplusf_(raw + a.in[I_SDTB][l * NH + col]) : 0.f; tDT[tok * 32 + col] = dt; tAC[tok * 32 + col] = -__expf(a.in[I_SALOG][l * NH + col]) * dt; }
            else if (col < 40) { const int h = col - 32; tG[tok * 8 + h] = valid ? -__expf(a.in[I_GALOG][l * 8 + h]) * softplusf_(raw + a.in[I_GDTB][l * 8 + h]) : 0.f; }
            else { const int h = col - 40; tB[tok * 8 + h] = valid ? sigmoidf_(raw) : 0.f; } }
        __syncthreads();
        { const int lane = tid & 63, wv = tid >> 6;
#pragma unroll
          for (int cc = 0; cc < 5; ++cc) { const int col = wv * 5 + cc; LAS float* t = col < 32 ? tAC + col : tG + (col - 32); const int st = col < 32 ? 32 : 8;
              float v = t[lane * st];
#pragma unroll
              for (int o = 1; o < 64; o <<= 1) { const float up = __shfl_up(v, o); if (o < ck.seg && (lane & (ck.seg - 1)) >= o) v += up; }
              t[lane * st] = v; } }
        __syncthreads();
        if (third == 0 && halfsel <= 0) for (int idx = tid; idx < 64 * 80; idx += 512) { const int tok = idx / 80, col = idx % 80;
            const float v = col < 32 ? tDT[tok * 32 + col] : col < 64 ? tAC[tok * 32 + col - 32] : col < 72 ? tG[tok * 8 + col - 64] : tB[tok * 8 + col - 72];
            SM2[(size_t)(ck.row0 + tok) * 80 + col] = v; }
        const int gc = third * 2048 + tid * 4; const bool isx = gc < XBC; const int ch = isx ? gc : gc - XBC;
        const int pcol = isx ? PC_XBC + ch : PC_QKV + ch;
        const float* cw = isx ? a.in[I_SCW] + (size_t)l * 4 * XBC : a.in[I_GCW] + (size_t)l * 4 * QKV;
        float w[4][4], bias[4];
#pragma unroll
        for (int j = 0; j < 4; ++j) { const f32x4 t = *(const f32x4*)(cw + j * 3072 + ch); w[j][0] = t[0]; w[j][1] = t[1]; w[j][2] = t[2]; w[j][3] = t[3]; }
        { const f32x4 t = isx ? *(const f32x4*)(a.in[I_SCB] + l * XBC + ch) : (f32x4){0.f, 0.f, 0.f, 0.f}; bias[0] = t[0]; bias[1] = t[1]; bias[2] = t[2]; bias[3] = t[3]; }
        const float* st_in = (isx ? a.in[I_SSC] : a.in[I_SGC]) + (size_t)l * DB * 3 * 3072;
        float* cs_out_p = a.out + (isx ? O_PSC : O_PGC) + (size_t)l * NB * 3 * 3072;
        float* cs_out_s = a.out + (isx ? O_SSC : O_SGC) + (size_t)l * DB * 3 * 3072;
        const int kind = isx ? (ch < DI ? 0 : ch < DI + 512 ? 1 : 2) : (ch < 1024 ? 3 : ch < 2048 ? 4 : 5);
        const int hh = kind >= 3 ? ((ch & 1023) >> 7) : 0;
        float xw[3][4];
#pragma unroll
        for (int j = 0; j < 3; ++j)
#pragma unroll
            for (int e = 0; e < 4; ++e) xw[j][e] = 0.f;
        if (halfsel >= 0 && (tid >> 8) != halfsel) continue;
        const bool is_sample = ck.kind == 1, last_prompt = ck.kind == 0 && ck.c == 31;
        if (ck.kind == 0) { const int r3 = ck.c > 0 ? ck.row0 - 3 : ROW_M0 + 13;
#pragma unroll
            for (int j = 0; j < 3; ++j) { const u32x2 t = *(const u32x2*)(PROJ + (size_t)(r3 + j) * NPROJ + pcol); xw[j][0] = bf_lo(t.x); xw[j][1] = bf_hi(t.x); xw[j][2] = bf_lo(t.y); xw[j][3] = bf_hi(t.y); } }
        u32x2 nxt[8];
#pragma unroll
        for (int ii = 0; ii < 8; ++ii) nxt[ii] = *(const u32x2*)(PROJ + (size_t)(ck.row0 + ii) * NPROJ + pcol);
        for (int i8 = 0; i8 < 8; ++i8) {
            float cur[8][4];
#pragma unroll
            for (int ii = 0; ii < 8; ++ii) { const u32x2 t = nxt[ii]; cur[ii][0] = bf_lo(t.x); cur[ii][1] = bf_hi(t.x); cur[ii][2] = bf_lo(t.y); cur[ii][3] = bf_hi(t.y); }
            if (i8 < 7) {
#pragma unroll
                for (int ii = 0; ii < 8; ++ii) nxt[ii] = *(const u32x2*)(PROJ + (size_t)(ck.row0 + i8 * 8 + 8 + ii) * NPROJ + pcol); }
            float av[8][4];
#pragma unroll
            for (int ii = 0; ii < 8; ++ii) { const int i = i8 * 8 + ii;
                if (is_sample && (ii & 3) == 0) {
                    const int sq = ck.b * 16 + (i >> 2);
#pragma unroll
                    for (int j = 0; j < 3; ++j) { const f32x4 t = *(const f32x4*)(st_in + ((size_t)sq * 3 + j) * 3072 + ch); xw[j][0] = t[0]; xw[j][1] = t[1]; xw[j][2] = t[2]; xw[j][3] = t[3]; }
                }
#pragma unroll
                for (int e = 0; e < 4; ++e) { const float y = w[0][e] * xw[0][e] + w[1][e] * xw[1][e] + w[2][e] * xw[2][e] + w[3][e] * cur[ii][e] + bias[e]; av[ii][e] = siluf_(y);
                    xw[0][e] = xw[1][e]; xw[1][e] = xw[2][e]; xw[2][e] = cur[ii][e]; }
                if (ii >= 5 && last_prompt && i8 == 7) *(f32x4*)(cs_out_p + ((size_t)ck.b * 3 + (ii - 5)) * 3072 + ch) = (f32x4){cur[ii][0], cur[ii][1], cur[ii][2], cur[ii][3]};
                if ((ii & 3) >= 1 && is_sample) *(f32x4*)(cs_out_s + ((size_t)(ck.b * 16 + (i >> 2)) * 3 + ((ii & 3) - 1)) * 3072 + ch) = (f32x4){cur[ii][0], cur[ii][1], cur[ii][2], cur[ii][3]};
            }
            if (kind == 3 || kind == 4) {
                float ss[8];
#pragma unroll
                for (int ii = 0; ii < 8; ++ii) ss[ii] = (av[ii][0] * av[ii][0] + av[ii][1] * av[ii][1]) + (av[ii][2] * av[ii][2] + av[ii][3] * av[ii][3]);
#pragma unroll
                for (int o = 1; o < 32; o <<= 1)
#pragma unroll
                    for (int ii = 0; ii < 8; ++ii) ss[ii] += __shfl_xor(ss[ii], o);
#pragma unroll
                for (int ii = 0; ii < 8; ++ii) { const float r = rsqrtf(ss[ii] + EPS) * (kind == 3 ? 0.08838834764831845f : 1.0f);
#pragma unroll
                    for (int e = 0; e < 4; ++e) av[ii][e] *= r; }
            }
#pragma unroll
            for (int ii = 0; ii < 8; ++ii) { const int row = ck.row0 + i8 * 8 + ii; u32x2 o; o.x = cvt_pk_bf16(av[ii][0], av[ii][1]); o.y = cvt_pk_bf16(av[ii][2], av[ii][3]);
                *(u32x2*)((isx ? XBCA : QKVA) + (size_t)row * 3072 + ch) = o; }
            if (kind == 0 || kind == 1) { bf16_t* dst = kind == 0 ? XTG + ((size_t)(cid * 8 + i8) * 2048 + ch) * 8 : BTG + ((size_t)(cid * 8 + i8) * 512 + (ch - DI)) * 8;
#pragma unroll
                for (int e = 0; e < 4; ++e) { u32x4 o; o.x = cvt_pk_bf16(av[0][e], av[1][e]); o.y = cvt_pk_bf16(av[2][e], av[3][e]); o.z = cvt_pk_bf16(av[4][e], av[5][e]); o.w = cvt_pk_bf16(av[6][e], av[7][e]); *(u32x4*)(dst + e * 8) = o; } }
            if (kind == 4) { float s1[8], s2[8];
#pragma unroll
                for (int ii = 0; ii < 8; ++ii) { const int i = i8 * 8 + ii; const float gcv = tG[i * 8 + hh], last = tG[((i | (ck.seg - 1))) * 8 + hh]; s1[ii] = tB[i * 8 + hh] * __expf(gcv); s2[ii] = __expf(last - gcv); }
                bf16_t* d1 = KBT + ((size_t)(cid * 8 + i8) * 1024 + (ch - 1024)) * 8; bf16_t* d2 = KGT + ((size_t)(cid * 8 + i8) * 1024 + (ch - 1024)) * 8;
#pragma unroll
                for (int e = 0; e < 4; ++e) { u32x4 o; o.x = cvt_pk_bf16(av[0][e] * s1[0], av[1][e] * s1[1]); o.y = cvt_pk_bf16(av[2][e] * s1[2], av[3][e] * s1[3]); o.z = cvt_pk_bf16(av[4][e] * s1[4], av[5][e] * s1[5]); o.w = cvt_pk_bf16(av[6][e] * s1[6], av[7][e] * s1[7]); *(u32x4*)(d1 + e * 8) = o;
                    u32x4 p; p.x = cvt_pk_bf16(av[0][e] * s2[0], av[1][e] * s2[1]); p.y = cvt_pk_bf16(av[2][e] * s2[2], av[3][e] * s2[3]); p.z = cvt_pk_bf16(av[4][e] * s2[4], av[5][e] * s2[5]); p.w = cvt_pk_bf16(av[6][e] * s2[6], av[7][e] * s2[7]); *(u32x4*)(d2 + e * 8) = p; } }
            if (kind == 5) { float s1[8];
#pragma unroll
                for (int ii = 0; ii < 8; ++ii) s1[ii] = tB[(i8 * 8 + ii) * 8 + hh];
                bf16_t* d1 = VBT + ((size_t)(cid * 8 + i8) * 1024 + (ch - 2048)) * 8;
#pragma unroll
                for (int e = 0; e < 4; ++e) { u32x4 o; o.x = cvt_pk_bf16(av[0][e] * s1[0], av[1][e] * s1[1]); o.y = cvt_pk_bf16(av[2][e] * s1[2], av[3][e] * s1[3]); o.z = cvt_pk_bf16(av[4][e] * s1[4], av[5][e] * s1[5]); o.w = cvt_pk_bf16(av[6][e] * s1[6], av[7][e] * s1[7]); *(u32x4*)(d1 + e * 8) = o; } }
        }
    }
}

#define MFMA16(a, b, c) __builtin_amdgcn_mfma_f32_16x16x32_bf16((a), (b), (c), 0, 0, 0)

constexpr int GP_WAVE_LDS = 17920;
__device__ __forceinline__ void phase_gdnprep(const Args& a, LAS unsigned char* lds) {
    const int lane = tidx() & 63, wave = tidx() >> 6, r = lane & 15, q = lane >> 4;
    LAS float* AT = (LAS float*)(lds + wave * GP_WAVE_LDS);
    LAS bf16_t* Tb = (LAS bf16_t*)(lds + wave * GP_WAVE_LDS);
    LAS float* gcs = AT + 64 * 68; LAS float* bts = gcs + 64;
    const bf16_t* QKVA = (const bf16_t*)(a.ws + WS_QKVA); const float* SM2 = (const float*)(a.ws + WS_SM2);
    const bf16_t* KBT = (const bf16_t*)(a.ws + WS_KBT); const bf16_t* VBT = (const bf16_t*)(a.ws + WS_VBT);
    bf16_t* ATTN = (bf16_t*)(a.ws + WS_ATTN); bf16_t* UT = (bf16_t*)(a.ws + WS_UT); bf16_t* WM = (bf16_t*)(a.ws + WS_WM);
    const int gw = bidx() * 8 + wave, NGW = gdim() * 8;
    for (int unit = gw; unit < 257 * 8; unit += NGW) {
        const int pc = unit >> 3, h = unit & 7; const int cid = pc < 256 ? pc : CID_M; const Chunk ck = chunk_of(cid);
        gcs[lane] = SM2[(size_t)(ck.row0 + lane) * 80 + 64 + h]; bts[lane] = SM2[(size_t)(ck.row0 + lane) * 80 + 72 + h];
        bf16x8 kf[4][4];
#pragma unroll
        for (int t = 0; t < 4; ++t)
#pragma unroll
            for (int ks = 0; ks < 4; ++ks) kf[t][ks] = *(const bf16x8*)(QKVA + (size_t)(ck.row0 + 16 * t + r) * 3072 + 1024 + h * 128 + 32 * ks + 8 * q);
        bf16x8 qfa[4][4];
#pragma unroll
        for (int t = 0; t < 4; ++t)
#pragma unroll
            for (int ks = 0; ks < 4; ++ks) qfa[t][ks] = *(const bf16x8*)(QKVA + (size_t)(ck.row0 + 16 * t + r) * 3072 + h * 128 + 32 * ks + 8 * q);
        LDS_WAIT(); asm volatile("" ::: "memory");
        bf16_t* attn_u = ATTN + (size_t)(pc * 8 + h) * 64 * 64;
#pragma unroll
        for (int it = 0; it < 4; ++it) {
            const int i = 16 * it + r; const float gci = gcs[i];
#pragma unroll
            for (int jt = 0; jt < 4; ++jt) {
                f32x4 acc = (f32x4){0.f, 0.f, 0.f, 0.f};
                if (jt <= it) {
#pragma unroll
                    for (int ks = 0; ks < 4; ++ks) acc = MFMA16(kf[jt][ks], qfa[it][ks], acc);
#pragma unroll
                    for (int e = 0; e < 4; ++e) { const int j = 16 * jt + 4 * q + e; acc[e] = (j <= i) ? acc[e] * __expf(fminf(gci - gcs[j], 0.f)) : 0.f; }
                }
                u32x2 o; o.x = cvt_pk_bf16(acc[0], acc[1]); o.y = cvt_pk_bf16(acc[2], acc[3]);
                *(LAS u32x2*)(Tb + i * 68 + 16 * jt + 4 * q) = o;
            }
        }
        LDS_WAIT(); asm volatile("" ::: "memory");
#pragma unroll 4
        for (int k = 0; k < 8; ++k) { const int idx = k * 64 + lane, row = idx >> 3, c8 = idx & 7; const u32x2 a0 = *(const LAS u32x2*)(Tb + row * 68 + c8 * 8), a1 = *(const LAS u32x2*)(Tb + row * 68 + c8 * 8 + 4);
            *(u32x4*)(attn_u + (size_t)row * 64 + c8 * 8) = (u32x4){a0.x, a0.y, a1.x, a1.y}; }
        LDS_WAIT(); asm volatile("" ::: "memory");
#pragma unroll
        for (int rt = 0; rt < 4; ++rt)
#pragma unroll
            for (int ct = 0; ct <= rt; ++ct) {
                f32x4 acc = (f32x4){0.f, 0.f, 0.f, 0.f};
#pragma unroll
                for (int ks = 0; ks < 4; ++ks) acc = MFMA16(kf[rt][ks], kf[ct][ks], acc);
                const int c = 16 * ct + r; const float gcc = gcs[c]; f32x4 o;
#pragma unroll
                for (int e = 0; e < 4; ++e) { const int j = 16 * rt + 4 * q + e; o[e] = (c < j) ? bts[j] * acc[e] * __expf(fminf(gcs[j] - gcc, 0.f)) : 0.f;     }
                *(LAS f32x4*)(AT + c * 68 + 16 * rt + 4 * q) = o;
            }
        LDS_WAIT(); asm volatile("" ::: "memory");
        bf16x8 vba[8][2];
#pragma unroll
        for (int dvt = 0; dvt < 8; ++dvt)
#pragma unroll
            for (int ks = 0; ks < 2; ++ks) vba[dvt][ks] = *(const bf16x8*)(VBT + ((size_t)(cid * 8 + 4 * ks + q) * 1024 + h * 128 + 16 * dvt + r) * 8);
        float t[64];
#pragma unroll
        for (int c = 63; c >= 0; --c) {
            asm volatile("" ::: "memory");
            int ln = lane; asm volatile("" : "+v"(ln)); float acc0 = (ln == c) ? 1.f : 0.f, acc1 = 0.f;
#pragma unroll
            for (int g = (c + 1) >> 2; g < 16; ++g) {
                if (g >= 4 && pc == 256) continue;
                const f32x4 av = *(const LAS f32x4*)(AT + c * 68 + 4 * g);
#pragma unroll
                for (int e = 0; e < 4; ++e) { const int j = 4 * g + e; if (j > c) { if (g & 1) acc1 -= t[j] * av[e]; else acc0 -= t[j] * av[e]; } }
            }
            t[c] = acc0 + acc1; asm volatile("" : "+v"(t[c]));
        }
        LDS_WAIT(); asm volatile("" ::: "memory");
#pragma unroll
        for (int g = 0; g < 8; ++g) { u32x4 o; o.x = cvt_pk_bf16(t[8 * g], t[8 * g + 1]); o.y = cvt_pk_bf16(t[8 * g + 2], t[8 * g + 3]); o.z = cvt_pk_bf16(t[8 * g + 4], t[8 * g + 5]); o.w = cvt_pk_bf16(t[8 * g + 6], t[8 * g + 7]);
            *(LAS u32x4*)(Tb + lane * 72 + 8 * g) = o; }
        LDS_WAIT(); asm volatile("" ::: "memory");
        bf16x8 tf[4][2];
#pragma unroll
        for (int it = 0; it < 4; ++it)
#pragma unroll
            for (int ks = 0; ks < 2; ++ks) tf[it][ks] = *(const LAS bf16x8*)(Tb + (16 * it + r) * 72 + 32 * ks + 8 * q);
        bf16_t* ut_u = UT + (size_t)(pc * 8 + h) * 128 * 64; bf16_t* wm_u = WM + (size_t)(pc * 8 + h) * 64 * 128;
        bf16x8 kba[8][2];
#pragma unroll
        for (int dkt = 0; dkt < 8; ++dkt)
#pragma unroll
            for (int ks = 0; ks < 2; ++ks) kba[dkt][ks] = *(const bf16x8*)(KBT + ((size_t)(cid * 8 + 4 * ks + q) * 1024 + h * 128 + 16 * dkt + r) * 8);
#pragma unroll
        for (int dvt = 0; dvt < 8; ++dvt) {
#pragma unroll
            for (int it = 0; it < 4; ++it) { f32x4 acc = (f32x4){0.f, 0.f, 0.f, 0.f};
#pragma unroll
                for (int ks = 0; ks < 2; ++ks) acc = MFMA16(tf[it][ks], vba[dvt][ks], acc);
                u32x2 o; o.x = cvt_pk_bf16(acc[0], acc[1]); o.y = cvt_pk_bf16(acc[2], acc[3]);
                *(LAS u32x2*)(Tb + (16 * dvt + r) * 68 + 16 * it + 4 * q) = o; }
        }
        LDS_WAIT(); asm volatile("" ::: "memory");
#pragma unroll 4
        for (int k = 0; k < 16; ++k) { const int idx = k * 64 + lane, row = idx >> 3, c8 = idx & 7; const u32x2 a0 = *(const LAS u32x2*)(Tb + row * 68 + c8 * 8), a1 = *(const LAS u32x2*)(Tb + row * 68 + c8 * 8 + 4);
            *(u32x4*)(ut_u + (size_t)row * 64 + c8 * 8) = (u32x4){a0.x, a0.y, a1.x, a1.y}; }
        LDS_WAIT(); asm volatile("" ::: "memory");
#pragma unroll
        for (int dkt = 0; dkt < 8; ++dkt) {
#pragma unroll
            for (int it = 0; it < 4; ++it) { f32x4 acc = (f32x4){0.f, 0.f, 0.f, 0.f};
#pragma unroll
                for (int ks = 0; ks < 2; ++ks) acc = MFMA16(kba[dkt][ks], tf[it][ks], acc);
                u32x2 o; o.x = cvt_pk_bf16(acc[0], acc[1]); o.y = cvt_pk_bf16(acc[2], acc[3]);
                *(LAS u32x2*)(Tb + (16 * it + r) * 132 + 16 * dkt + 4 * q) = o; }
        }
        LDS_WAIT(); asm volatile("" ::: "memory");
#pragma unroll 4
        for (int k = 0; k < 16; ++k) { const int idx = k * 64 + lane, row = idx >> 4, c8 = idx & 15; const u32x2 a0 = *(const LAS u32x2*)(Tb + row * 132 + c8 * 8), a1 = *(const LAS u32x2*)(Tb + row * 132 + c8 * 8 + 4);
            *(u32x4*)(wm_u + (size_t)row * 128 + c8 * 8) = (u32x4){a0.x, a0.y, a1.x, a1.y}; }
        LDS_WAIT(); asm volatile("" ::: "memory");
    }
}

__device__ __forceinline__ void phase_sample_gdn(const Args& a, int l, LAS unsigned char* lds, int vb, int nvb) {
    const int tid = tidx(), sub = tid >> 7, dv = tid & 127, lane = tid & 63;
    LAS float* qk = (LAS float*)lds + sub * 1024;
    LAS float* red = (LAS float*)lds + 4096 + sub * 8;
    const bf16_t* QKVA = (const bf16_t*)(a.ws + WS_QKVA); const float* SM2 = (const float*)(a.ws + WS_SM2); const bf16_t* PROJ = (const bf16_t*)(a.ws + WS_PROJ);
    bf16_t* YG = (bf16_t*)(a.ws + WS_YG);
    for (int base = vb * 4; base < DB * 8; base += nvb * 4) {
        const int unit = base + sub, sq = unit >> 3, h = unit & 7; const int row0 = ROW_S0 + sq * 4;
        const float* sin = a.in[I_SGDN] + ((size_t)(l * DB + sq) * 8 + h) * DK * DV + dv;
        float* sout = a.out + O_SGDN + ((size_t)(l * DB + sq) * 8 + h) * DK * DV + dv;
        float s[128];
#pragma unroll
        for (int k = 0; k < 128; ++k) s[k] = sin[(size_t)k * DV];
        __syncthreads();
#pragma unroll
        for (int j = 0; j < 8; ++j) { const int idx = dv + 128 * j; const int tok = idx >> 8, which = (idx >> 7) & 1, d = idx & 127;
            qk[idx] = bf1(QKVA[(size_t)(row0 + tok) * 3072 + which * 1024 + h * 128 + d]); }
        float vv[4], gg[4], bb[4], gate[4];
#pragma unroll
        for (int t = 0; t < 4; ++t) { vv[t] = bf1(QKVA[(size_t)(row0 + t) * 3072 + 2048 + h * 128 + dv]); const float gc = SM2[(size_t)(row0 + t) * 80 + 64 + h], gp = t ? SM2[(size_t)(row0 + t - 1) * 80 + 64 + h] : 0.f;
            gg[t] = __expf(gc - gp); bb[t] = SM2[(size_t)(row0 + t) * 80 + 72 + h]; gate[t] = bf1(PROJ[(size_t)(row0 + t) * NPROJ + PC_GATE + h * 128 + dv]); }
        __syncthreads();
        float o[4];
#pragma unroll
        for (int t = 0; t < 4; ++t) {
            asm volatile("" ::: "memory");
            const LAS float* qv = qk + t * 256; const LAS float* kv = qv + 128;
            float r0 = 0.f, r1 = 0.f;
#pragma unroll
            for (int k = 0; k < 128; k += 4) { const f32x4 kk = *(const LAS f32x4*)(kv + k); r0 += s[k] * kk[0]; r1 += s[k + 1] * kk[1]; r0 += s[k + 2] * kk[2]; r1 += s[k + 3] * kk[3];
                if ((k & 15) == 12) { asm volatile("" : "+v"(r0), "+v"(r1)); asm volatile("" ::: "memory"); } }
            const float eg = gg[t], delta = bb[t] * (vv[t] - eg * (r0 + r1));
            float o0 = 0.f, o1 = 0.f;
#pragma unroll
            for (int k = 0; k < 128; k += 4) { const f32x4 kk = *(const LAS f32x4*)(kv + k), qq = *(const LAS f32x4*)(qv + k);
                s[k] = eg * s[k] + kk[0] * delta; s[k + 1] = eg * s[k + 1] + kk[1] * delta; s[k + 2] = eg * s[k + 2] + kk[2] * delta; s[k + 3] = eg * s[k + 3] + kk[3] * delta;
                o0 += s[k] * qq[0]; o1 += s[k + 1] * qq[1]; o0 += s[k + 2] * qq[2]; o1 += s[k + 3] * qq[3];
                if ((k & 15) == 12) { asm volatile("" : "+v"(o0), "+v"(o1)); asm volatile("" ::: "memory"); } }
            o[t] = o0 + o1;
        }
#pragma unroll
        for (int k = 0; k < 128; ++k) sout[(size_t)k * DV] = s[k];
#pragma unroll
        for (int t = 0; t < 4; ++t) { const float ss = wave_sum(o[t] * o[t]); if (lane == 0) red[((tid >> 6) & 1) * 4 + t] = ss; }
        __syncthreads();
#pragma unroll
        for (int t = 0; t < 4; ++t) { const float rstd = rsqrtf((red[t] + red[4 + t]) * (1.0f / 128.0f) + EPS);
            YG[(size_t)(row0 + t) * D + h * 128 + dv] = (bf16_t)(cvt_pk_bf16(o[t] * rstd * siluf_(gate[t]), 0.f) & 0xffffu); }
    }
}
struct SsPre { f32x4 hs[4]; u32x2 bw[4][4], cw[4][4]; float dt[4], xv[4]; float ah, dh, ex, ez; };
__device__ __forceinline__ void sample_ssd_load(const Args& a, int l, SsPre& P, int unit, int tid) {
    const int p = tid >> 3, nq = tid & 7; const int sq = unit >> 5, hd = unit & 31, g = hd >> 3; const int row0 = ROW_S0 + sq * 4;
    const bf16_t* XBCA = (const bf16_t*)(a.ws + WS_XBCA); const float* SM2 = (const float*)(a.ws + WS_SM2); const bf16_t* PROJ = (const bf16_t*)(a.ws + WS_PROJ);
    const float* sin = a.in[I_SSSM] + ((size_t)(l * DB + sq) * NH + hd) * HP * NST + (size_t)p * NST + nq * 4;
#pragma unroll
    for (int i = 0; i < 4; ++i) P.hs[i] = *(const f32x4*)(sin + 32 * i);
#pragma unroll
    for (int t = 0; t < 4; ++t) { const size_t ro = (size_t)(row0 + t) * 3072; P.dt[t] = SM2[(size_t)(row0 + t) * 80 + hd]; P.xv[t] = bf1(XBCA[ro + hd * 64 + p]);
#pragma unroll
        for (int i = 0; i < 4; ++i) { P.bw[t][i] = *(const u32x2*)(XBCA + ro + DI + g * 128 + nq * 4 + 32 * i); P.cw[t][i] = *(const u32x2*)(XBCA + ro + DI + 512 + g * 128 + nq * 4 + 32 * i); } }
    P.ah = a.in[I_SALOG][l * NH + hd]; P.dh = a.in[I_SD][l * NH + hd];
    { const int t = (tid >> 6) & 3, pp = tid & 63; P.ex = bf1(XBCA[(size_t)(row0 + t) * 3072 + hd * 64 + pp]); P.ez = bf1(PROJ[(size_t)(row0 + t) * NPROJ + PC_Z + hd * 64 + pp]); }
}
__device__ __forceinline__ void phase_sample_ssd(const Args& a, int l, LAS unsigned char* lds, int vb, int nvb) {
    const int tid = tidx(), p = tid >> 3, nq = tid & 7, lane = tid & 63;
    LAS float* ybuf = (LAS float*)lds + 8192;
    bf16_t* YS = (bf16_t*)(a.ws + WS_YS); float* SSQ = (float*)(a.ws + WS_SSQ);
    const int G = nvb; int unit = vb;
    SsPre P; if (unit < DB * NH) sample_ssd_load(a, l, P, unit, tid);
    for (; unit < DB * NH; unit += G) {
        const int sq = unit >> 5, hd = unit & 31; const int row0 = ROW_S0 + sq * 4;
        float* sout = a.out + O_SSSM + ((size_t)(l * DB + sq) * NH + hd) * HP * NST + (size_t)p * NST + nq * 4;
        SsPre C = P;
        if (unit + G < DB * NH) sample_ssd_load(a, l, P, unit + G, tid);
        const float Ah = -__expf(C.ah);
        __syncthreads();
#pragma unroll
        for (int t = 0; t < 4; ++t) { const float dA = __expf(C.dt[t] * Ah), dtx = C.dt[t] * C.xv[t]; float yp = 0.f;
#pragma unroll
            for (int i = 0; i < 4; ++i) { const u32x2 bw = C.bw[t][i], cw = C.cw[t][i];
                C.hs[i][0] = C.hs[i][0] * dA + dtx * bf_lo(bw.x); C.hs[i][1] = C.hs[i][1] * dA + dtx * bf_hi(bw.x); C.hs[i][2] = C.hs[i][2] * dA + dtx * bf_lo(bw.y); C.hs[i][3] = C.hs[i][3] * dA + dtx * bf_hi(bw.y);
                yp += (C.hs[i][0] * bf_lo(cw.x) + C.hs[i][1] * bf_hi(cw.x)) + (C.hs[i][2] * bf_lo(cw.y) + C.hs[i][3] * bf_hi(cw.y)); }
            yp += __shfl_xor(yp, 1); yp += __shfl_xor(yp, 2); yp += __shfl_xor(yp, 4);
            if (nq == 0) ybuf[t * 64 + p] = yp; }
#pragma unroll
        for (int i = 0; i < 4; ++i) *(f32x4*)(sout + 32 * i) = C.hs[i];
        __syncthreads();
        if (tid < 256) { const int t = tid >> 6, pp = tid & 63, row = row0 + t;
            const float y = (ybuf[t * 64 + pp] + C.dh * C.ex) * siluf_(C.ez);
            YS[(size_t)row * DI + hd * 64 + pp] = (bf16_t)(cvt_pk_bf16(y, 0.f) & 0xffffu);
            const float ss = wave_sum(y * y); if (lane == 0) SSQ[(size_t)row * 32 + hd] = ss; }
    }
}


struct SsdPre { u32x4 pC[2], pB[2], pBT[2], pXT, pX, pZ; float pS; };
__device__ __forceinline__ void ssd_load(const Args& a, SsdPre& P, int b, int hd, int c, int tid) {
    const int g = hd >> 3; const int cid = c == 0 ? CID_M : b * 32 + c - 1; const int row0 = c == 0 ? ROW_M0 : b * SEQ + 64 * (c - 1);
    const bf16_t* XBCA = (const bf16_t*)(a.ws + WS_XBCA); const bf16_t* BTG = (const bf16_t*)(a.ws + WS_BTG); const bf16_t* XTG = (const bf16_t*)(a.ws + WS_XTG);
    const bf16_t* PROJ = (const bf16_t*)(a.ws + WS_PROJ); const float* SM2 = (const float*)(a.ws + WS_SM2);
#pragma unroll
    for (int k = 0; k < 2; ++k) { const int idx = tid + 512 * k, row = idx >> 4, c16 = idx & 15;
        P.pC[k] = *(const u32x4*)(XBCA + (size_t)(row0 + row) * 3072 + DI + 512 + g * 128 + c16 * 8);
        P.pB[k] = *(const u32x4*)(XBCA + (size_t)(row0 + row) * 3072 + DI + g * 128 + c16 * 8);
        const int n = idx & 127, j8 = idx >> 7; P.pBT[k] = *(const u32x4*)(BTG + ((size_t)(cid * 8 + j8) * 512 + g * 128 + n) * 8); }
    P.pXT = *(const u32x4*)(XTG + ((size_t)(cid * 8 + (tid >> 6)) * 2048 + hd * 64 + (tid & 63)) * 8);
    { const int p = tid >> 3, j8 = tid & 7;
      P.pX = *(const u32x4*)(XBCA + (size_t)(row0 + p) * 3072 + hd * 64 + j8 * 8);
      P.pZ = *(const u32x4*)(PROJ + (size_t)(row0 + p) * NPROJ + PC_Z + hd * 64 + j8 * 8); }
    P.pS = tid < 128 ? SM2[(size_t)(row0 + (tid & 63)) * 80 + (tid >> 6) * 32 + hd] : 0.f;
}
__device__ __forceinline__ void ssd_chain(const Args& a, int l, LAS unsigned char* lds, int unit) {
    const int tid = tidx(), lane = tid & 63, wave = __builtin_amdgcn_readfirstlane(tid >> 6), r = lane & 15, q = lane >> 4;
    const int b = unit >> 5, hd = unit & 31;
    LAS bf16_t* Cn = (LAS bf16_t*)lds;
    LAS bf16_t* Bn = Cn + 64 * 136;
    LAS bf16_t* BT = Bn + 64 * 136;
    LAS bf16_t* XT = BT + 128 * 72;
    LAS bf16_t* Wl = XT + 64 * 72;
    LAS bf16_t* Hb = Wl + 64 * 72;
    LAS float* YL = (LAS float*)(Hb + 2 * 64 * 136);
    LAS float* tdt = YL + 64 * 68; LAS float* tac = tdt + 64; LAS float* teac = tac + 64; LAS float* twj = teac + 64;
    bf16_t* YS = (bf16_t*)(a.ws + WS_YS); float* SSQ = (float*)(a.ws + WS_SSQ);
    const float Dh = a.in[I_SD][l * NH + hd];
    __syncthreads();
    for (int i = tid; i < 64 * 136 / 2; i += 512) ((LAS unsigned*)Hb)[i] = 0u;
    f32x4 hT[4];
#pragma unroll
    for (int pt = 0; pt < 4; ++pt) hT[pt] = (f32x4){0.f, 0.f, 0.f, 0.f};
    SsdPre P; ssd_load(a, P, b, hd, 0, tid);
    int cur = 0;
    for (int c = 0; c < 33; ++c) {
        const int nvalid = c == 0 ? 16 : 64; const int row0 = c == 0 ? ROW_M0 : b * SEQ + 64 * (c - 1);
        for (int r5 = 0; r5 < REPN(20); ++r5)
#pragma unroll
        for (int k = 0; k < 2; ++k) { const int idx = tid + 512 * k, row = idx >> 4, c16 = idx & 15; *(LAS u32x4*)(Cn + row * 136 + c16 * 8) = P.pC[k]; *(LAS u32x4*)(Bn + row * 136 + c16 * 8) = P.pB[k];
            const int n = idx & 127, j8 = idx >> 7; *(LAS u32x4*)(BT + n * 72 + j8 * 8) = P.pBT[k]; }
        *(LAS u32x4*)(XT + (tid & 63) * 72 + (tid >> 6) * 8) = P.pXT;
        if (tid < 128) tdt[tid] = P.pS;
        const u32x4 xcur = P.pX, zcur = P.pZ;
        __syncthreads();
        if (c < 32) ssd_load(a, P, b, hd, c + 1, tid);
        const float last = tac[nvalid - 1];
        for (int r3 = 0; r3 < REPN(18); ++r3)
        { const int it = wave & 3, pt0 = 2 * (wave >> 2); const int i = 16 * it + r; bf16x8 cf[4];
#pragma unroll
          for (int ks = 0; ks < 4; ++ks) cf[ks] = *(const LAS bf16x8*)(Cn + (16 * it + r) * 136 + 32 * ks + 8 * q);
          const float aci = tac[i], eaci = __expf(aci); u32x2 wreg[4];
          bf16x8 bfr[4][4];
#pragma unroll
          for (int jt = 0; jt < 4; ++jt)
#pragma unroll
              for (int ks = 0; ks < 4; ++ks) bfr[jt][ks] = (jt <= it) ? *(const LAS bf16x8*)(Bn + (16 * jt + r) * 136 + 32 * ks + 8 * q) : cf[ks];
          __builtin_amdgcn_sched_barrier(0);
#pragma unroll
          for (int jt = 0; jt < 4; ++jt) { wreg[jt] = (u32x2){0u, 0u};
              if (jt <= it) { f32x4 acc = (f32x4){0.f, 0.f, 0.f, 0.f};
#pragma unroll
                  for (int ks = 0; ks < 4; ++ks) acc = MFMA16(bfr[jt][ks], cf[ks], acc);
                  const f32x4 acj = *(const LAS f32x4*)(tac + 16 * jt + 4 * q), dtj = *(const LAS f32x4*)(tdt + 16 * jt + 4 * q);
#pragma unroll
                  for (int e = 0; e < 4; ++e) { const int j = 16 * jt + 4 * q + e; acc[e] = (j <= i) ? acc[e] * __expf(fminf(aci - acj[e], 0.f)) * dtj[e] : 0.f; }
                  wreg[jt] = pack4(acc); } }
          const LAS bf16_t* Hc = Hb + cur * 64 * 136;
          bf16x8 hfr[2][4]; u32x2 xfr[2][2][2];
#pragma unroll
          for (int t2 = 0; t2 < 2; ++t2) {
#pragma unroll
              for (int ks = 0; ks < 4; ++ks) hfr[t2][ks] = *(const LAS bf16x8*)(Hc + (16 * (pt0 + t2) + r) * 136 + 32 * ks + 8 * q);
#pragma unroll
              for (int s2 = 0; s2 < 2; ++s2) { xfr[t2][s2][0] = *(const LAS u32x2*)(XT + (16 * (pt0 + t2) + r) * 72 + 32 * s2 + 4 * q); xfr[t2][s2][1] = *(const LAS u32x2*)(XT + (16 * (pt0 + t2) + r) * 72 + 32 * s2 + 16 + 4 * q); } }
          __builtin_amdgcn_sched_barrier(0);
#pragma unroll
          for (int t2 = 0; t2 < 2; ++t2) { const int pt = pt0 + t2; f32x4 acc = (f32x4){0.f, 0.f, 0.f, 0.f};
#pragma unroll
              for (int ks = 0; ks < 4; ++ks) acc = MFMA16(hfr[t2][ks], cf[ks], acc);
              acc = acc * eaci;
#pragma unroll
              for (int s2 = 0; s2 < 2; ++s2) { if (2 * s2 <= it) {
                  const u32x4 xw4 = (u32x4){xfr[t2][s2][0].x, xfr[t2][s2][0].y, xfr[t2][s2][1].x, xfr[t2][s2][1].y}, ww4 = (u32x4){wreg[2 * s2].x, wreg[2 * s2].y, wreg[2 * s2 + 1].x, wreg[2 * s2 + 1].y};
                  acc = MFMA16(__builtin_bit_cast(bf16x8, xw4), __builtin_bit_cast(bf16x8, ww4), acc); } }
              *(LAS f32x4*)(YL + (16 * it + r) * 68 + 16 * pt + 4 * q) = acc; } }
        { const float elast = __expf(last); bf16x8 bs[2];
#pragma unroll
          for (int ks = 0; ks < 2; ++ks) { float f[8]; unpack8(*(const LAS u32x4*)(BT + (16 * wave + r) * 72 + 32 * ks + 8 * q), f);
              const f32x4 a0 = *(const LAS f32x4*)(tac + 32 * ks + 8 * q), a1 = *(const LAS f32x4*)(tac + 32 * ks + 8 * q + 4), d0 = *(const LAS f32x4*)(tdt + 32 * ks + 8 * q), d1 = *(const LAS f32x4*)(tdt + 32 * ks + 8 * q + 4);
              float wv[8];
#pragma unroll
              for (int e = 0; e < 4; ++e) { wv[e] = __expf(last - a0[e]) * d0[e]; wv[4 + e] = __expf(last - a1[e]) * d1[e]; }
              u32x4 o; o.x = cvt_pk_bf16(f[0] * wv[0], f[1] * wv[1]); o.y = cvt_pk_bf16(f[2] * wv[2], f[3] * wv[3]); o.z = cvt_pk_bf16(f[4] * wv[4], f[5] * wv[5]); o.w = cvt_pk_bf16(f[6] * wv[6], f[7] * wv[7]); bs[ks] = __builtin_bit_cast(bf16x8, o); }
          LAS bf16_t* Hn = Hb + (cur ^ 1) * 64 * 136; bf16x8 xq[4][2];
#pragma unroll
          for (int pt = 0; pt < 4; ++pt)
#pragma unroll
              for (int ks = 0; ks < 2; ++ks) xq[pt][ks] = *(const LAS bf16x8*)(XT + (16 * pt + r) * 72 + 32 * ks + 8 * q);
          __builtin_amdgcn_sched_barrier(0);
#pragma unroll
          for (int pt = 0; pt < 4; ++pt) { hT[pt] = hT[pt] * elast;
#pragma unroll
              for (int ks = 0; ks < 2; ++ks) hT[pt] = MFMA16(bs[ks], xq[pt][ks], hT[pt]);
              *(LAS u32x2*)(Hn + (16 * pt + r) * 136 + 16 * wave + 4 * q) = pack4(hT[pt]); } }
        __syncthreads();
        for (int r4 = 0; r4 < REPN(19); ++r4)
        { const int i = tid >> 3, p8 = tid & 7; const f32x4 y0 = *(const LAS f32x4*)(YL + i * 68 + p8 * 8), y1 = *(const LAS f32x4*)(YL + i * 68 + p8 * 8 + 4);
          float xv[8], zv[8], o[8]; unpack8(xcur, xv); unpack8(zcur, zv); float ss = 0.f;
#pragma unroll
          for (int e = 0; e < 8; ++e) { const float y = e < 4 ? y0[e] : y1[e - 4]; o[e] = (y + Dh * xv[e]) * siluf_(zv[e]); ss += o[e] * o[e]; }
          ss += __shfl_xor(ss, 1); ss += __shfl_xor(ss, 2); ss += __shfl_xor(ss, 4);
          if (i < nvalid && (c > 0 || b == 0)) { u32x4 w; w.x = cvt_pk_bf16(o[0], o[1]); w.y = cvt_pk_bf16(o[2], o[3]); w.z = cvt_pk_bf16(o[4], o[5]); w.w = cvt_pk_bf16(o[6], o[7]);
              *(u32x4*)(YS + (size_t)(row0 + i) * DI + hd * 64 + p8 * 8) = w; if (p8 == 0) SSQ[(size_t)(row0 + i) * 32 + hd] = ss; } }
        cur ^= 1;
    }
    float* so = a.out + O_PSSM + ((size_t)(l * NB + b) * NH + hd) * HP * NST;
#pragma unroll
    for (int pt = 0; pt < 4; ++pt) *(f32x4*)(so + (size_t)(16 * pt + r) * NST + 16 * wave + 4 * q) = hT[pt];
}

struct GdnPre { u32x4 pW[2], pQ[2], pA, pK[2], pG[2]; u32x2 pU[4]; float pS; };
__device__ __forceinline__ void gdn_load(const Args& a, GdnPre& P, int b, int h, int c, int tid, int wave, int r, int q) {
    const int cid = c == 0 ? CID_M : b * 32 + c - 1, pc = c == 0 ? 256 : b * 32 + c - 1; const int row0 = c == 0 ? ROW_M0 : b * SEQ + 64 * (c - 1);
    const bf16_t* WM = (const bf16_t*)(a.ws + WS_WM); const bf16_t* QKVA = (const bf16_t*)(a.ws + WS_QKVA); const bf16_t* ATTN = (const bf16_t*)(a.ws + WS_ATTN);
    const bf16_t* KGT = (const bf16_t*)(a.ws + WS_KGT); const bf16_t* UT = (const bf16_t*)(a.ws + WS_UT); const bf16_t* PROJ = (const bf16_t*)(a.ws + WS_PROJ); const float* SM2 = (const float*)(a.ws + WS_SM2);
#pragma unroll
    for (int k = 0; k < 2; ++k) { const int idx = tid + 512 * k, i = idx >> 4, c16 = idx & 15;
        P.pW[k] = *(const u32x4*)(WM + ((size_t)(pc * 8 + h) * 64 + i) * 128 + c16 * 8);
        P.pQ[k] = *(const u32x4*)(QKVA + (size_t)(row0 + i) * 3072 + h * 128 + c16 * 8);
        const int dk = idx & 127, j8 = idx >> 7; P.pK[k] = *(const u32x4*)(KGT + ((size_t)(cid * 8 + j8) * 1024 + h * 128 + dk) * 8);
        P.pG[k] = *(const u32x4*)(PROJ + (size_t)(row0 + (tid >> 3)) * NPROJ + PC_GATE + h * 128 + (tid & 7) * 16 + 8 * k); }
    P.pA = *(const u32x4*)(ATTN + ((size_t)(pc * 8 + h) * 64 + (tid >> 3)) * 64 + (tid & 7) * 8);
    const int wi = wave & 3, wh = wave >> 2;
#pragma unroll
    for (int t = 0; t < 4; ++t) P.pU[t] = *(const u32x2*)(UT + ((size_t)(pc * 8 + h) * 128 + 16 * (4 * wh + t) + r) * 64 + 16 * wi + 4 * q);
    P.pS = tid < 64 ? SM2[(size_t)(row0 + tid) * 80 + 64 + h] : 0.f;
}
__device__ __forceinline__ void gdn_chain(const Args& a, int l, LAS unsigned char* lds, int unit) {
    const int tid = tidx(), lane = tid & 63, wave = __builtin_amdgcn_readfirstlane(tid >> 6), r = lane & 15, q = lane >> 4;
    const int b = unit >> 3, h = unit & 7, wi = wave & 3, wh = wave >> 2;
    LAS bf16_t* STb = (LAS bf16_t*)lds;
    LAS bf16_t* Wm = STb + 128 * 136;
    LAS bf16_t* Qn = Wm + 64 * 136;
    LAS bf16_t* VNT = Qn + 64 * 136;
    LAS bf16_t* ATn = VNT + 128 * 72;
    LAS bf16_t* KG = ATn + 64 * 72;
    LAS float* OL = (LAS float*)(KG + 128 * 72);
    LAS float* tgc = OL + 64 * 132;
    bf16_t* YG = (bf16_t*)(a.ws + WS_YG);
    __syncthreads();
    for (int i = tid; i < 128 * 136 / 2; i += 512) ((LAS unsigned*)STb)[i] = 0u;
    f32x4 S[8];
#pragma unroll
    for (int t = 0; t < 8; ++t) S[t] = (f32x4){0.f, 0.f, 0.f, 0.f};
    GdnPre P; gdn_load(a, P, b, h, 0, tid, wave, r, q);
    for (int c = 0; c < 33; ++c) {
        const int nvalid = c == 0 ? 16 : 64; const int row0 = c == 0 ? ROW_M0 : b * SEQ + 64 * (c - 1);
#pragma unroll
        for (int k = 0; k < 2; ++k) { const int idx = tid + 512 * k, i = idx >> 4, c16 = idx & 15; *(LAS u32x4*)(Wm + i * 136 + c16 * 8) = P.pW[k]; *(LAS u32x4*)(Qn + i * 136 + c16 * 8) = P.pQ[k];
            const int dk = idx & 127, j8 = idx >> 7; *(LAS u32x4*)(KG + dk * 72 + j8 * 8) = P.pK[k]; }
        *(LAS u32x4*)(ATn + (tid >> 3) * 72 + (tid & 7) * 8) = P.pA;
        if (tid < 64) tgc[tid] = P.pS;
        u32x2 ucur[4]; u32x4 gcur[2];
#pragma unroll
        for (int t = 0; t < 4; ++t) ucur[t] = P.pU[t];
        gcur[0] = P.pG[0]; gcur[1] = P.pG[1];
        __syncthreads();
        if (c < 32) gdn_load(a, P, b, h, c + 1, tid, wave, r, q);
        const float last = tgc[nvalid - 1];
        f32x4 o1[4];
        { bf16x8 wf[4], qf[4];
#pragma unroll
          for (int ks = 0; ks < 4; ++ks) { wf[ks] = *(const LAS bf16x8*)(Wm + (16 * wi + r) * 136 + 32 * ks + 8 * q); qf[ks] = *(const LAS bf16x8*)(Qn + (16 * wi + r) * 136 + 32 * ks + 8 * q); }
          const f32x4 gi = *(const LAS f32x4*)(tgc + 16 * wi + 4 * q);
#pragma unroll
          for (int t = 0; t < 4; ++t) { const int dvt = 4 * wh + t; f32x4 p1 = (f32x4){0.f, 0.f, 0.f, 0.f}; o1[t] = (f32x4){0.f, 0.f, 0.f, 0.f};
              bf16x8 sfr[4];
#pragma unroll
              for (int ks = 0; ks < 4; ++ks) sfr[ks] = *(const LAS bf16x8*)(STb + (16 * dvt + r) * 136 + 32 * ks + 8 * q);
              __builtin_amdgcn_sched_barrier(0);
#pragma unroll
              for (int ks = 0; ks < 4; ++ks) { const bf16x8 sf = sfr[ks]; p1 = MFMA16(wf[ks], sf, p1); o1[t] = MFMA16(qf[ks], sf, o1[t]); }
              f32x4 vn; vn[0] = bf_lo(ucur[t].x) - p1[0]; vn[1] = bf_hi(ucur[t].x) - p1[1]; vn[2] = bf_lo(ucur[t].y) - p1[2]; vn[3] = bf_hi(ucur[t].y) - p1[3];
              *(LAS u32x2*)(VNT + (16 * dvt + r) * 72 + 16 * wi + 4 * q) = pack4(vn);
#pragma unroll
              for (int e = 0; e < 4; ++e) o1[t][e] *= __expf(gi[e]); } }
        __syncthreads();
        bf16x8 vfr[4][2];
#pragma unroll
        for (int t = 0; t < 4; ++t)
#pragma unroll
            for (int ks = 0; ks < 2; ++ks) vfr[t][ks] = *(const LAS bf16x8*)(VNT + (16 * (4 * wh + t) + r) * 72 + 32 * ks + 8 * q);
        { bf16x8 af[2];
#pragma unroll
          for (int ks = 0; ks < 2; ++ks) af[ks] = *(const LAS bf16x8*)(ATn + (16 * wi + r) * 72 + 32 * ks + 8 * q);
          __builtin_amdgcn_sched_barrier(0);
#pragma unroll
          for (int t = 0; t < 4; ++t) { const int dvt = 4 * wh + t;
#pragma unroll
              for (int ks = 0; ks < 2; ++ks) o1[t] = MFMA16(af[ks], vfr[t][ks], o1[t]);
#pragma unroll
              for (int e = 0; e < 4; ++e) OL[(16 * wi + 4 * q + e) * 132 + 16 * dvt + r] = o1[t][e]; } }
        { const float elast = __expf(last); bf16x8 kf[2];
#pragma unroll
          for (int ks = 0; ks < 2; ++ks) kf[ks] = *(const LAS bf16x8*)(KG + (16 * wave + r) * 72 + 32 * ks + 8 * q);
          bf16x8 vf2[4][2];
#pragma unroll
          for (int t = 0; t < 4; ++t)
#pragma unroll
              for (int ks = 0; ks < 2; ++ks) vf2[t][ks] = *(const LAS bf16x8*)(VNT + (16 * (4 * (wh ^ 1) + t) + r) * 72 + 32 * ks + 8 * q);
          __builtin_amdgcn_sched_barrier(0);
#pragma unroll
          for (int dvt = 0; dvt < 8; ++dvt) { S[dvt] = S[dvt] * elast;
#pragma unroll
              for (int ks = 0; ks < 2; ++ks) { const bf16x8 vv = ((dvt >> 2) == wh) ? vfr[dvt & 3][ks] : vf2[dvt & 3][ks]; S[dvt] = MFMA16(kf[ks], vv, S[dvt]); }
              *(LAS u32x2*)(STb + (16 * dvt + r) * 136 + 16 * wave + 4 * q) = pack4(S[dvt]); } }
        __syncthreads();
        { const int i = tid >> 3, d16 = tid & 7; float o[16], gt[16]; float ss = 0.f;
#pragma unroll
          for (int k = 0; k < 4; ++k) { const f32x4 v = *(const LAS f32x4*)(OL + i * 132 + d16 * 16 + 4 * k); o[4 * k] = v[0]; o[4 * k + 1] = v[1]; o[4 * k + 2] = v[2]; o[4 * k + 3] = v[3]; ss += (v[0] * v[0] + v[1] * v[1]) + (v[2] * v[2] + v[3] * v[3]); }
          ss += __shfl_xor(ss, 1); ss += __shfl_xor(ss, 2); ss += __shfl_xor(ss, 4);
          const float rstd = rsqrtf(ss * (1.0f / 128.0f) + EPS);
          { float f[8]; unpack8(gcur[0], f);
#pragma unroll
            for (int e = 0; e < 8; ++e) gt[e] = f[e]; unpack8(gcur[1], f);
#pragma unroll
            for (int e = 0; e < 8; ++e) gt[8 + e] = f[e]; }
#pragma unroll
          for (int e = 0; e < 16; ++e) o[e] = o[e] * rstd * siluf_(gt[e]);
          if (i < nvalid && (c > 0 || b == 0)) { u32x4 w0, w1; w0.x = cvt_pk_bf16(o[0], o[1]); w0.y = cvt_pk_bf16(o[2], o[3]); w0.z = cvt_pk_bf16(o[4], o[5]); w0.w = cvt_pk_bf16(o[6], o[7]);
              w1.x = cvt_pk_bf16(o[8], o[9]); w1.y = cvt_pk_bf16(o[10], o[11]); w1.z = cvt_pk_bf16(o[12], o[13]); w1.w = cvt_pk_bf16(o[14], o[15]);
              bf16_t* dst = YG + (size_t)(row0 + i) * D + h * 128 + d16 * 16; *(u32x4*)dst = w0; *(u32x4*)(dst + 8) = w1; } }
    }
    float* so = a.out + O_PGDN + ((size_t)(l * NB + b) * 8 + h) * DK * DV;
#pragma unroll
    for (int dvt = 0; dvt < 8; ++dvt)
#pragma unroll
        for (int e = 0; e < 4; ++e) so[(size_t)(16 * wave + 4 * q + e) * DV + 16 * dvt + r] = S[dvt][e];
}

__device__ __forceinline__ void phase_ssm_norm(const Args& a) {
    bf16_t* YS = (bf16_t*)(a.ws + WS_YS); const float* SSQ = (const float*)(a.ws + WS_SSQ);
#pragma unroll 4
    for (int idx = bidx() * 512 + tidx(); idx < (ROW_M0 + NMETA) * 256; idx += gdim() * 512) { const int row = idx >> 8, c8 = idx & 255, g = c8 >> 6;
        const f32x4 s0 = *(const f32x4*)(SSQ + (size_t)row * 32 + g * 8), s1 = *(const f32x4*)(SSQ + (size_t)row * 32 + g * 8 + 4);
        const float rstd = rsqrtf((((s0[0] + s0[1]) + (s0[2] + s0[3])) + ((s1[0] + s1[1]) + (s1[2] + s1[3]))) * (1.0f / 512.0f) + EPS);
        u32x4* p = (u32x4*)(YS + (size_t)row * DI + c8 * 8); float f[8]; unpack8(*p, f);
        u32x4 o; o.x = cvt_pk_bf16(f[0] * rstd, f[1] * rstd); o.y = cvt_pk_bf16(f[2] * rstd, f[3] * rstd); o.z = cvt_pk_bf16(f[4] * rstd, f[5] * rstd); o.w = cvt_pk_bf16(f[6] * rstd, f[7] * rstd); *p = o; }
}
__device__ __forceinline__ void phase_ffn_act(const Args& a, int l) {
    const int tid = tidx(), lane = tid & 63, wave = tid >> 6; const int gw = bidx() * 8 + wave, NGW = gdim() * 8;
    const bf16_t* UP = (const bf16_t*)(a.ws + WS_UP); bf16_t* ACT = (bf16_t*)(a.ws + WS_ACT);
    constexpr int NR = (ROW_M0 + NMETA) / 16;
    for (int wu = gw; wu < NR * 11; wu += NGW) {
        const int rg = wu / 11, sl = wu - rg * 11; const int row0 = rg * 16, ch = sl * 256 + lane * 4;
        const int kind = row0 < ROW_S0 ? 0 : row0 < ROW_M0 ? 1 : 2;
        u32x2 gtv[16], upv[16];
#pragma unroll
        for (int i = 0; i < 16; ++i) { const size_t ro = (size_t)(row0 + i) * NUP; gtv[i] = *(const u32x2*)(UP + ro + ch); upv[i] = *(const u32x2*)(UP + ro + DFF + ch); }
        const f32x4 w0 = *(const f32x4*)(a.in[I_FCW] + ((size_t)l * 3 + 0) * DFF + ch), w1 = *(const f32x4*)(a.in[I_FCW] + ((size_t)l * 3 + 1) * DFF + ch), w2 = *(const f32x4*)(a.in[I_FCW] + ((size_t)l * 3 + 2) * DFF + ch);
        const f32x4 bs = *(const f32x4*)(a.in[I_FCB] + (size_t)l * DFF + ch);
        f32x4 x0 = (f32x4){0.f, 0.f, 0.f, 0.f}, x1 = x0; f32x4 st[4][2];
#pragma unroll
        for (int sI = 0; sI < 4; ++sI) { st[sI][0] = x0; st[sI][1] = x0; }
        if (kind == 0) { const int r2 = (row0 & (SEQ - 1)) ? row0 - 2 : ROW_M0 + 14; const u32x2 p0 = *(const u32x2*)(UP + (size_t)r2 * NUP + ch), p1 = *(const u32x2*)(UP + (size_t)(r2 + 1) * NUP + ch);
            x0 = (f32x4){bf_lo(p0.x), bf_hi(p0.x), bf_lo(p0.y), bf_hi(p0.y)}; x1 = (f32x4){bf_lo(p1.x), bf_hi(p1.x), bf_lo(p1.y), bf_hi(p1.y)}; }
        else if (kind == 1) { const int sq0 = (row0 - ROW_S0) >> 2;
#pragma unroll
            for (int sI = 0; sI < 4; ++sI)
#pragma unroll
                for (int jj = 0; jj < 2; ++jj) st[sI][jj] = *(const f32x4*)(a.in[I_SFC] + ((size_t)(l * DB + sq0 + sI) * 2 + jj) * DFF + ch); }
#pragma unroll
        for (int i = 0; i < 16; ++i) {
            if (kind == 1 && (i & 3) == 0) { x0 = st[i >> 2][0]; x1 = st[i >> 2][1]; }
            const f32x4 g = (f32x4){bf_lo(gtv[i].x), bf_hi(gtv[i].x), bf_lo(gtv[i].y), bf_hi(gtv[i].y)}, u = (f32x4){bf_lo(upv[i].x), bf_hi(upv[i].x), bf_lo(upv[i].y), bf_hi(upv[i].y)};
            const f32x4 y = w0 * x0 + w1 * x1 + w2 * g + bs; f32x4 o;
#pragma unroll
            for (int e = 0; e < 4; ++e) o[e] = siluf_(y[e]) * u[e];
            *(u32x2*)(ACT + (size_t)(row0 + i) * DFF + ch) = pack4(o);
            if (kind == 0 && (row0 & (SEQ - 1)) == SEQ - 16 && i >= 14) *(f32x4*)(a.out + O_PFC + ((size_t)(l * NB + (row0 >> 11)) * 2 + (i - 14)) * DFF + ch) = g;
            if (kind == 1 && (i & 3) >= 2) *(f32x4*)(a.out + O_SFC + ((size_t)(l * DB + ((row0 - ROW_S0) >> 2) + (i >> 2)) * 2 + ((i & 3) - 2)) * DFF + ch) = g;
            x0 = x1; x1 = g;
        }
    }
}
__device__ __forceinline__ void phase_final(const Args& a) {
    const int lane = tidx() & 63, wave = tidx() >> 6; const int gw = bidx() * 8 + wave, NGW = gdim() * 8;
    const float* X = (const float*)(a.ws + WS_X); const float* RSS = (const float*)(a.ws + WS_RSS);
    for (int row = gw; row < ROW_M0; row += NGW) { const float rs = pg8::row_rstd(RSS, row);
        float* dst = row < ROW_S0 ? a.out + O_YP + (size_t)row * D : a.out + O_YS + (size_t)(row - ROW_S0) * D;
#pragma unroll
        for (int j = 0; j < 4; ++j) { const f32x4 v = *(const f32x4*)(X + (size_t)row * D + 256 * j + 4 * lane), wv = *(const f32x4*)(a.in[I_NF] + 256 * j + 4 * lane); *(f32x4*)(dst + 256 * j + 4 * lane) = v * rs * wv; } }
}

constexpr int PH_PER_LAYER = 11, PH_FINAL = 2 + DEPTH * PH_PER_LAYER, PH_END = PH_FINAL + 1;
__global__ void __launch_bounds__(512, 2) mk(Args a) {
    extern __shared__ __attribute__((aligned(16))) unsigned char lds_raw[];
    LAS unsigned char* lds = (LAS unsigned char*)lds_raw;
    volatile LAS unsigned* MISC = (volatile LAS unsigned*)(lds + LDS_CTL);
    if (threadIdx.x < 16) MISC[threadIdx.x] = 0u;
    __syncthreads();
#if MK_SINGLE
    XcdBarrier bar = xcd_barrier_post((unsigned*)(a.ws + WS_CTL), MISC);
#ifdef MK_TIME
#define SEAM(k) do { if (IN(k) && IN((k) + 1)) xcd_barrier(bar); if (blockIdx.x == 0 && threadIdx.x == 0) { const unsigned long long tn = wall_clock64(); tim[tk] += (float)(tn - tprev) * 0.01f; tprev = tn; } } while (0)
#else
#define SEAM(k) do { if (IN(k) && IN((k) + 1)) xcd_barrier(bar); } while (0)
#endif
#else
#define SEAM(k) do { } while (0)
#endif
#define IN(k) (a.ph_lo <= (k) && (k) < a.ph_hi)
    const int G = gdim();
#ifdef MK_TIME
    float* tim = (float*)(a.ws + WS_CTL + 65536); unsigned long long tprev = wall_clock64(); int tk = 0;
#define TK(k) tk = (k)
#else
#define TK(k)
#endif
    if (PHON(0) && IN(0)) for (int rp = 0; rp < REPN(0); ++rp) phase_weights(a, lds);
    TK(0);
    if (PHON(1) && IN(1)) phase_inputs(a);
    TK(1); SEAM(1);
    for (int l = 0; l < DEPTH; ++l) {
        const int pb = 2 + l * PH_PER_LAYER;
        if (PHON(2) && IN(pb + 0)) { pg8::Gemm g{(const bf16_t*)(a.ws + WS_XB), (const bf16_t*)(a.ws + WS_WIN + l * SZ_WIN), MP, NPROJ_T, D}; pg8::StaticOrder S; S.init(MP, NPROJ_T, G, bidx());
            pg8::EpiScaleBf16 E{(bf16_t*)(a.ws + WS_PROJ), NPROJ, (const float*)(a.ws + WS_RSS), (float*)(a.ws + WS_SMALL), NPROJ / 256};
            for (int rp = 0; rp < REPN(2); ++rp) pg8::gemm_phase<pg8::EpiScaleBf16, pg8::StaticOrder, true, true>(lds, g, S, E); }
        TK(2); SEAM(pb + 0);
        if (PHON(3) && IN(pb + 1)) for (int rp = 0; rp < REPN(3); ++rp) phase_prep(a, l, lds);
        TK(3); SEAM(pb + 1);
        if (IN(pb + 2)) for (int rp = 0; rp < REPN(4); ++rp) { if (PHON(4)) phase_gdnprep(a, lds); __syncthreads(); }
        TK(4); SEAM(pb + 2);
        if (IN(pb + 3)) for (int rp = 0; rp < REPN(5); ++rp) { if (PHON(7)) for (int r2 = 0; r2 < REPN(16); ++r2) for (int c = bidx(); c < NB * NH; c += G) { const int x = c & 7, k = c >> 3, gp = (k >> 3) * 8 + x; ssd_chain(a, l, lds, (gp >> 2) * 32 + (gp & 3) * 8 + (k & 7)); }     if (PHON(8)) for (int r2 = 0; r2 < REPN(17); ++r2) for (int u = bidx(); u < NB * 8; u += G) gdn_chain(a, l, lds, u);
            { const int nfree = G > NB * 8 ? G - NB * 8 : G, vb = G > NB * 8 ? bidx() - NB * 8 : bidx();
              if (vb >= 0) { __syncthreads(); if (PHON(5)) phase_sample_gdn(a, l, lds, vb, nfree); __syncthreads(); if (PHON(6)) phase_sample_ssd(a, l, lds, vb, nfree); __syncthreads(); } } }
        TK(5); SEAM(pb + 3);
        if (PHON(9) && IN(pb + 4)) phase_ssm_norm(a);
        TK(6); SEAM(pb + 4);
        if (PHON(10) && IN(pb + 5)) { pg8::Gemm g{(const bf16_t*)(a.ws + WS_YS), (const bf16_t*)(a.ws + WS_WSO + l * SZ_WSO), MP, D, DI}; pg8::StaticOrder S; S.init(MP, D, G, bidx());
            pg8::EpiGateF32 E{(float*)(a.ws + WS_T1), (const bf16_t*)(a.ws + WS_PROJ), PC_MGS};
            pg8::gemm_phase<pg8::EpiGateF32, pg8::StaticOrder, true, true>(lds, g, S, E); }
        TK(7);
        if (PHON(11) && IN(pb + 6)) { pg8::Gemm g{(const bf16_t*)(a.ws + WS_YG), (const bf16_t*)(a.ws + WS_WGO + l * SZ_WGO), MP, D, D}; pg8::StaticOrder S; S.init(MP, D, G, bidx());
            pg8::EpiMerge E{(bf16_t*)(a.ws + WS_MRG), (const float*)(a.ws + WS_T1), (const bf16_t*)(a.ws + WS_PROJ), PC_MGG};
            pg8::gemm_phase<pg8::EpiMerge, pg8::StaticOrder, true, true>(lds, g, S, E); }
        TK(8); SEAM(pb + 6);
        if (PHON(12) && IN(pb + 7)) { pg8::Gemm g{(const bf16_t*)(a.ws + WS_MRG), (const bf16_t*)(a.ws + WS_WO + l * SZ_WO), MP, D, D}; pg8::StaticOrder S; S.init(MP, D, G, bidx());
            pg8::EpiResid E{(float*)(a.ws + WS_X), (bf16_t*)(a.ws + WS_XB), (float*)(a.ws + WS_RSS)};
            pg8::gemm_phase<pg8::EpiResid, pg8::StaticOrder, true, true>(lds, g, S, E); }
        TK(9); SEAM(pb + 7);
        if (PHON(13) && IN(pb + 8)) { pg8::Gemm g{(const bf16_t*)(a.ws + WS_XB), (const bf16_t*)(a.ws + WS_WUP + l * SZ_WUP), MP, NUP, D}; pg8::StaticOrder S; S.init(MP, NUP, G, bidx());
            pg8::EpiScaleBf16 E{(bf16_t*)(a.ws + WS_UP), NUP, (const float*)(a.ws + WS_RSS), nullptr, NUP / 256};
            pg8::gemm_phase<pg8::EpiScaleBf16, pg8::StaticOrder, true, true>(lds, g, S, E); }
        TK(10); SEAM(pb + 8);
        if (PHON(14) && IN(pb + 9)) for (int rp = 0; rp < REPN(11); ++rp) phase_ffn_act(a, l);
        TK(11); SEAM(pb + 9);
        if (PHON(15) && IN(pb + 10)) { pg8::Gemm g{(const bf16_t*)(a.ws + WS_ACT), (const bf16_t*)(a.ws + WS_WDN + l * SZ_WDN), MP, D, DFF}; pg8::StaticOrder S; S.init(MP, D, G, bidx());
            pg8::EpiResid E{(float*)(a.ws + WS_X), (bf16_t*)(a.ws + WS_XB), (float*)(a.ws + WS_RSS)};
            pg8::gemm_phase<pg8::EpiResid, pg8::StaticOrder, true, true>(lds, g, S, E); }
        TK(12); SEAM(pb + 10);
    }
    if (PHON(16) && IN(PH_FINAL)) phase_final(a);
#ifdef MK_TIME
    TK(13); xcd_barrier(bar); if (blockIdx.x == 0 && threadIdx.x == 0) { const unsigned long long tn = wall_clock64(); tim[tk] += (float)(tn - tprev) * 0.01f; }
    __syncthreads();
    { float A = 0.f, B = 0.f; for (int k = 0; k < 14; ++k) { const float v = __hip_atomic_load(tim + k, __ATOMIC_RELAXED, __HIP_MEMORY_SCOPE_AGENT); if ((MK_TIME_A >> k) & 1) A += v; if ((MK_TIME_B >> k) & 1) { A += v; B += v; } }
      if (blockIdx.x == 0) { __syncthreads(); if (threadIdx.x == 0) a.out[O_YS] = A; for (size_t i = threadIdx.x; i < (size_t)DEPTH * NB * 2 * DFF; i += 512) a.out[O_PFC + i] = B; } }
#endif
#undef IN
#undef SEAM
}


extern "C" void kernel_launch(void* const* d_in, const int* in_sizes, int n_in, void* d_out, int out_size, void* d_ws, size_t ws_size, hipStream_t stream) {
    static int grid = 0;
    if (grid == 0) {
        if (n_in != 29 || (size_t)out_size != O_END || ws_size < WS_END) { fprintf(stderr, "kernel_launch: unexpected shapes (n_in %d, out %d vs %zu, ws %zu vs %zu)\n", n_in, out_size, (size_t)O_END, ws_size, (size_t)WS_END); grid = -1; return; }
        int dev = 0, cus = 0, per_cu = 0;
        if (hipGetDevice(&dev) != hipSuccess || hipDeviceGetAttribute(&cus, hipDeviceAttributeMultiprocessorCount, dev) != hipSuccess) { grid = -1; return; }
        if (hipFuncSetAttribute((const void*)mk, hipFuncAttributeMaxDynamicSharedMemorySize, LDS_BYTES) != hipSuccess) { fprintf(stderr, "kernel_launch: hipFuncSetAttribute failed\n"); grid = -1; return; }
        if (hipOccupancyMaxActiveBlocksPerMultiprocessor(&per_cu, (const void*)mk, 512, LDS_BYTES) != hipSuccess || per_cu < 1) fprintf(stderr, "kernel_launch: occupancy query says %d\n", per_cu);
        (void)hipGetLastError();
        grid = cus;
    }
    if (grid < 0) return;
    (void)hipMemsetAsync((char*)d_ws + WS_CTL, 0, CTL_BYTES, stream);
    Args a{};
    for (int i = 0; i < 29; ++i) a.in[i] = (const float*)d_in[i];
    a.out = (float*)d_out; a.ws = (unsigned char*)d_ws;
#if MK_SINGLE
    a.ph_lo = 0; a.ph_hi = PH_END;
    hipLaunchKernelGGL(mk, dim3(grid), dim3(512), LDS_BYTES, stream, a);
#else
    for (int ph = 0; ph < PH_END; ++ph) { a.ph_lo = ph; a.ph_hi = ph + 1; hipLaunchKernelGGL(mk, dim3(grid), dim3(512), LDS_BYTES, stream, a); }
#endif
}
```

```cpp
#include <hip/hip_runtime.h>
#include <cstdio>
#include <cstdint>

#ifndef PH_ENABLE
#define PH_ENABLE 0xFFFFFFFFu
#endif
#define PHON(k) (((PH_ENABLE) >> (k)) & 1u)
#ifndef MK_TIME_A
#define MK_TIME_A 0
#define MK_TIME_B 0
#endif
#ifndef MK_REP
#define MK_REP 0u
#endif
#define REPN(k) ((((MK_REP) >> (k)) & 1u) ? 2 : 1)
#ifndef MK_SINGLE
#define MK_SINGLE 1
#endif

#define LAS __attribute__((address_space(3)))
typedef unsigned short bf16_t;
typedef short bf16x8 __attribute__((ext_vector_type(8)));
typedef float f32x4 __attribute__((ext_vector_type(4)));
typedef float f32x2 __attribute__((ext_vector_type(2)));
typedef unsigned u32x4 __attribute__((ext_vector_type(4)));
typedef unsigned u32x2 __attribute__((ext_vector_type(2)));

constexpr int D = 1024, DEPTH = 4, NB = 8, SEQ = 2048, DB = 128, DS = 4, NMETA = 16;
constexpr int MP = 17152, ROW_S0 = 16384, ROW_M0 = 16896;
constexpr int DI = 2048, XBC = 3072, QKV = 3072, NPROJ = 11264, NPROJ_T = 11520, DFF = 2816, NUP = 5632, IN_DIM = 11312;
constexpr int NH = 32, HP = 64, NST = 128, NG = 4, GH = 8, DK = 128, DV = 128;
constexpr int NCHUNK = 265;
constexpr int CID_S0 = 256, CID_M = 264;
constexpr float EPS = 1e-6f;
constexpr int PC_Z = 0, PC_XBC = 2048, PC_QKV = 5120, PC_GATE = 8192, PC_MGS = 9216, PC_MGG = 10240;

constexpr size_t al(size_t x) { return (x + 4095) & ~(size_t)4095; }
constexpr size_t WS_CTL = 0, CTL_BYTES = 1u << 20;
constexpr size_t WS_WIN = WS_CTL + CTL_BYTES;                         constexpr size_t SZ_WIN = (size_t)NPROJ_T * D * 2;
constexpr size_t WS_WSO = WS_WIN + DEPTH * SZ_WIN;                    constexpr size_t SZ_WSO = (size_t)D * DI * 2;
constexpr size_t WS_WGO = WS_WSO + DEPTH * SZ_WSO;                    constexpr size_t SZ_WGO = (size_t)D * D * 2;
constexpr size_t WS_WO  = WS_WGO + DEPTH * SZ_WGO;                    constexpr size_t SZ_WO  = (size_t)D * D * 2;
constexpr size_t WS_WUP = WS_WO + DEPTH * SZ_WO;                      constexpr size_t SZ_WUP = (size_t)NUP * D * 2;
constexpr size_t WS_WDN = WS_WUP + DEPTH * SZ_WUP;                    constexpr size_t SZ_WDN = (size_t)D * DFF * 2;
constexpr size_t WS_X   = WS_WDN + DEPTH * SZ_WDN;
constexpr size_t WS_XB  = WS_X + (size_t)MP * D * 4;
constexpr size_t WS_RSS = WS_XB + (size_t)MP * D * 2;
constexpr size_t WS_PROJ = al(WS_RSS + (size_t)MP * 16 * 4);
constexpr size_t WS_SMALL = WS_PROJ + (size_t)MP * NPROJ * 2;
constexpr size_t WS_SM2 = WS_SMALL + (size_t)MP * 64 * 4;
constexpr size_t WS_XBCA = al(WS_SM2 + (size_t)MP * 80 * 4);
constexpr size_t WS_QKVA = WS_XBCA + (size_t)MP * XBC * 2;
constexpr size_t WS_XTG = WS_QKVA + (size_t)MP * QKV * 2;
constexpr size_t WS_BTG = WS_XTG + (size_t)NCHUNK * 2048 * 64 * 2;
constexpr size_t WS_KBT = WS_BTG + (size_t)NCHUNK * 512 * 64 * 2;
constexpr size_t WS_KGT = WS_KBT + (size_t)NCHUNK * 1024 * 64 * 2;
constexpr size_t WS_VBT = WS_KGT + (size_t)NCHUNK * 1024 * 64 * 2;
constexpr size_t WS_ATTN = WS_VBT + (size_t)NCHUNK * 1024 * 64 * 2;
constexpr size_t WS_UT = WS_ATTN + (size_t)257 * 8 * 64 * 64 * 2;
constexpr size_t WS_WM = WS_UT + (size_t)257 * 8 * 128 * 64 * 2;
constexpr size_t WS_YS = WS_WM + (size_t)257 * 8 * 128 * 64 * 2;
constexpr size_t WS_SSQ = WS_YS + (size_t)MP * DI * 2;
constexpr size_t WS_YG = WS_SSQ + (size_t)MP * 32 * 4;
constexpr size_t WS_T1 = WS_YG + (size_t)MP * D * 2;
constexpr size_t WS_MRG = WS_T1 + (size_t)MP * D * 4;
constexpr size_t WS_UP = WS_MRG + (size_t)MP * D * 2;
constexpr size_t WS_ACT = WS_UP + (size_t)MP * NUP * 2;
constexpr size_t WS_SLAB = WS_ACT + (size_t)MP * DFF * 2;
constexpr size_t WS_END = WS_SLAB + (size_t)268 * 65536 * 4;

constexpr size_t O_YP = 0;
constexpr size_t O_YS = O_YP + (size_t)NB * SEQ * D;
constexpr size_t O_PSSM = O_YS + (size_t)DB * DS * D;
constexpr size_t O_PSC = O_PSSM + (size_t)DEPTH * NB * NH * HP * NST;
constexpr size_t O_PGDN = O_PSC + (size_t)DEPTH * NB * 3 * XBC;
constexpr size_t O_PGC = O_PGDN + (size_t)DEPTH * NB * 8 * DK * DV;
constexpr size_t O_PFC = O_PGC + (size_t)DEPTH * NB * 3 * QKV;
constexpr size_t O_SSSM = O_PFC + (size_t)DEPTH * NB * 2 * DFF;
constexpr size_t O_SSC = O_SSSM + (size_t)DEPTH * DB * NH * HP * NST;
constexpr size_t O_SGDN = O_SSC + (size_t)DEPTH * DB * 3 * XBC;
constexpr size_t O_SGC = O_SGDN + (size_t)DEPTH * DB * 8 * DK * DV;
constexpr size_t O_SFC = O_SGC + (size_t)DEPTH * DB * 3 * QKV;
constexpr size_t O_END = O_SFC + (size_t)DEPTH * DB * 2 * DFF;

typedef __bf16 bf16x2_t __attribute__((ext_vector_type(2)));
__device__ __forceinline__ unsigned cvt_pk_bf16(float lo, float hi) { bf16x2_t v; v[0] = (__bf16)lo; v[1] = (__bf16)hi; return __builtin_bit_cast(unsigned, v); }
__device__ __forceinline__ float bf_lo(unsigned w) { return __uint_as_float(w << 16); }
__device__ __forceinline__ float bf_hi(unsigned w) { return __uint_as_float(w & 0xffff0000u); }
__device__ __forceinline__ float bf1(bf16_t b) { return __uint_as_float(((unsigned)b) << 16); }
__device__ __forceinline__ float sigmoidf_(float x) { return __builtin_amdgcn_rcpf(1.0f + __expf(-x)); }
__device__ __forceinline__ float siluf_(float x) { return x * __builtin_amdgcn_rcpf(1.0f + __expf(-x)); }
__device__ __forceinline__ float softplusf_(float x) { return fmaxf(x, 0.f) + log1pf(__expf(-fabsf(x))); }
__device__ __forceinline__ int tidx() { int t = threadIdx.x; asm volatile("" : "+v"(t)); return t; }
__device__ __forceinline__ int bidx() { int t = blockIdx.x; asm volatile("" : "+s"(t)); return t; }
__device__ __forceinline__ int gdim() { int t = gridDim.x; asm volatile("" : "+s"(t)); return t; }
__device__ __forceinline__ u32x2 pack4(const f32x4 v) { u32x2 o; o.x = cvt_pk_bf16(v[0], v[1]); o.y = cvt_pk_bf16(v[2], v[3]); return o; }
__device__ __forceinline__ void unpack8(const u32x4 w, float (&f)[8]) { f[0] = bf_lo(w.x); f[1] = bf_hi(w.x); f[2] = bf_lo(w.y); f[3] = bf_hi(w.y); f[4] = bf_lo(w.z); f[5] = bf_hi(w.z); f[6] = bf_lo(w.w); f[7] = bf_hi(w.w); }
#define LDS_WAIT() asm volatile("s_waitcnt lgkmcnt(0)" ::: "memory")
#define VM_WAIT() asm volatile("s_waitcnt vmcnt(0)" ::: "memory")

namespace pg8 {
#define PG8_LAS __attribute__((address_space(3)))
constexpr int BM = 256, BK = 64, HALF = 128, HTB = HALF * BK * 2, STAGE_BYTES = 8 * HTB, NXCD = 8, WGM = 4;
__host__ __device__ __forceinline__ int lds_byte(int r, int c) { const int st = (r >> 4) * 2 + (c >> 5), rr = r & 15, cc = c & 31, ob = rr * 64 + cc * 2; return st * 1024 + (ob ^ (((ob >> 9) & 1) << 5)); }
__host__ __device__ __forceinline__ void stage_rc(int b, int& R, int& C) { const int st = b / 1024, sb = b % 1024, swz = sb ^ (((sb >> 9) & 1) << 5); R = (st >> 1) * 16 + swz / 64; C = (st & 1) * 32 + (swz % 64) / 2; }
__host__ __device__ __forceinline__ int perm32(int rho) { const int n = rho >> 4, i = rho & 15; return 8 * (i >> 2) + 4 * n + (i & 3); }
struct Unit { int pm, pn, kt0, nkt, role, uid; };
struct Gemm { const bf16_t* A; const bf16_t* Bt; int M, N, K; };
struct StaticOrder {
    int nM, nN, nwg, G, c;
    __host__ __device__ void init(int M, int N, int G_, int c_) { nM = M / BM; nN = N / BM; nwg = nM * nN; G = G_; c = c_; }
    __host__ __device__ bool next(int i, Unit& u) const {
        const long L = (long)i * G + c; if (L >= nwg) return false;
        int wgid = (int)L; { const int q = nwg / NXCD, r = nwg % NXCD, xcd = wgid % NXCD, off = wgid / NXCD; wgid = (xcd < r ? xcd * (q + 1) : r * (q + 1) + (xcd - r) * q) + off; }
        const int nig = WGM * nN, gid = wgid / nig, fm = gid * WGM, gsz = (nM - fm) < WGM ? (nM - fm) : WGM;
        u.pm = fm + ((wgid % nig) % gsz); u.pn = (wgid % nig) / gsz; u.kt0 = 0; u.nkt = 0; u.role = 0; u.uid = 0; return true;
    }
    __device__ __forceinline__ void a_ready(const Unit&) const {}
    __device__ __forceinline__ void done(const Unit&) const {}
    template <class Epi> __device__ __forceinline__ void epilogue(f32x4 (&acc)[2][2][4][2], const Unit& u, const Epi& E, int wr, int wc, int fr, int fq) const { E(acc, u, wr, wc, fr, fq); }
};
struct StreamK {
    int nN, P, lo, hi; float* slab; unsigned* flags;
    __device__ __forceinline__ void init(int M, int N, int K, int G_, int c_, float* slab_, unsigned* flags_) { nN = N / BM; P = K / (2 * BK); const int c = (G_ % NXCD == 0) ? (c_ % NXCD) * (G_ / NXCD) + c_ / NXCD : c_;
        const int TP = (M / BM) * nN * P; lo = c * TP / G_; hi = (c + 1) * TP / G_; slab = slab_; flags = flags_; }
    __device__ __forceinline__ bool next(int i, Unit& u) const {
        const int st = i == 0 ? lo : (lo / P + i) * P; if (st >= hi) return false;
        const int ui = st / P, ub = ui * P, en = (ub + P) < hi ? (ub + P) : hi, p0 = st - ub, p1 = en - ub;
        u.pm = ui / nN; u.pn = ui - u.pm * nN; u.kt0 = 2 * p0; u.nkt = 2 * (p1 - p0); u.uid = ui; u.role = p0 > 0 ? 2 : (p1 < P ? 1 : 0); return true;
    }
    __device__ __forceinline__ void a_ready(const Unit&) const {}
    __device__ __forceinline__ void done(const Unit&) const {}
    template <class Epi> __device__ __forceinline__ void epilogue(f32x4 (&acc)[2][2][4][2], const Unit& u, const Epi& E, int wr, int wc, int fr, int fq) const {
        const int tid = threadIdx.x, lane = tid & 63; const int uid = __builtin_amdgcn_readfirstlane(u.uid);
        if (u.role == 2) {
            const __amdgpu_buffer_rsrc_t rs = __builtin_amdgcn_make_buffer_rsrc(slab + (size_t)uid * 65536, 0, 262144, 0x00020000);
#pragma unroll
            for (int k = 0; k < 32; ++k) __builtin_amdgcn_raw_buffer_store_b128(__builtin_bit_cast(u32x4, acc[k >> 4][(k >> 3) & 1][(k >> 1) & 3][k & 1]), rs, tid * 16, k * 8192, 16);
            asm volatile("s_waitcnt vmcnt(0)" ::: "memory");
            if (lane == 0) __hip_atomic_fetch_add(flags + uid, 1u, __ATOMIC_RELAXED, __HIP_MEMORY_SCOPE_AGENT);
            return;
        }
        if (u.role == 1) {
            unsigned sp = 0;
            while ((unsigned)__builtin_amdgcn_readfirstlane(__hip_atomic_load(flags + uid, __ATOMIC_RELAXED, __HIP_MEMORY_SCOPE_AGENT)) < 8u) { __builtin_amdgcn_s_sleep(2); if (++sp > (1u << 22)) break; }
            __builtin_amdgcn_fence(__ATOMIC_ACQUIRE, "agent"); asm volatile("s_waitcnt vmcnt(0)" ::: "memory");
            const __amdgpu_buffer_rsrc_t rl = __builtin_amdgcn_make_buffer_rsrc(slab + (size_t)uid * 65536, 0, 262144, 0x00020000);
#pragma unroll
            for (int k = 0; k < 32; ++k) acc[k >> 4][(k >> 3) & 1][(k >> 1) & 3][k & 1] += __builtin_bit_cast(f32x4, __builtin_amdgcn_raw_buffer_load_b128(rl, tid * 16, k * 8192, 16));
        }
        E(acc, u, wr, wc, fr, fq);
    }
};

template <class Epi, class Sched, bool ALIGN_EPI = false, bool SP2 = false>
__device__ __forceinline__ void gemm_phase(PG8_LAS unsigned char* lds, const Gemm g, const Sched& S, const Epi& E) {
    const int tid = tidx(), wid = __builtin_amdgcn_readfirstlane(tid >> 6), lane = tid & 63, wr = wid >> 2, wc = wid & 3, fr = lane & 15, fq = lane >> 4;
    const int K = g.K, nt = K / BK;
    unsigned voffA[2], voffB[2];
#pragma unroll
    for (int i = 0; i < 2; ++i) { int R, C; stage_rc(tid * 16 + i * 8192, R, C); const int Rb = Epi::PERM ? ((R & ~31) + perm32(R & 31)) : R;
        voffA[i] = (unsigned)(R * K + C) * 2u; voffB[i] = (unsigned)(Rb * K + C) * 2u; }
    const size_t kstep = (size_t)(BK * 2);
    const size_t hstep = (size_t)HALF * K * 2;
    const size_t tstep = 2 * hstep;
    const unsigned ldsw = (unsigned)wid * 1024u;
    const int aoff = lds_byte(wr * 64 + fr, fq * 8), boff = lds_byte(wc * 32 + fr, fq * 8);
#define PG8_SA(b, h) (((b) * 2 + (h)) * HTB)
#define PG8_SB(b, h) ((4 + (b) * 2 + (h)) * HTB)
#define PG8_STAGE(bufoff, gbase, voff) do { _Pragma("unroll") for (int _i = 0; _i < 2; ++_i) \
        __builtin_amdgcn_global_load_lds((const unsigned*)((const char*)(gbase) + (voff)[_i]), (PG8_LAS unsigned*)(lds + (bufoff) + ldsw + _i * 8192), 16, 0, 0); } while (0)
#define PG8_LDA(dst, b, h) do { _Pragma("unroll") for (int m = 0; m < 4; ++m) _Pragma("unroll") for (int k = 0; k < 2; ++k) dst[m][k] = *(const PG8_LAS bf16x8*)(lds + PG8_SA(b, h) + aoff + m * 2048 + k * 1024); } while (0)
#define PG8_LDB(dst, b, h) do { _Pragma("unroll") for (int n = 0; n < 2; ++n) _Pragma("unroll") for (int k = 0; k < 2; ++k) dst[n][k] = *(const PG8_LAS bf16x8*)(lds + PG8_SB(b, h) + boff + n * 2048 + k * 1024); } while (0)
#define PG8_MMA(ai, bj, At, Bt) do { __builtin_amdgcn_s_setprio(1); _Pragma("unroll") for (int m = 0; m < 4; ++m) _Pragma("unroll") for (int n = 0; n < 2; ++n) _Pragma("unroll") for (int k = 0; k < 2; ++k) \
        acc[ai][bj][m][n] = __builtin_amdgcn_mfma_f32_16x16x32_bf16(Bt[n][k], At[m][k], acc[ai][bj][m][n], 0, 0, 0); __builtin_amdgcn_s_setprio(0); } while (0)
#define PG8_WAIT_V(n) asm volatile("s_waitcnt vmcnt(" #n ")" ::: "memory")
#define PG8_WAIT_L(n) asm volatile("s_waitcnt lgkmcnt(" #n ")" ::: "memory")
#define PG8_BAR __builtin_amdgcn_s_barrier()
#define PG8_SCHED __builtin_amdgcn_sched_barrier(0)
    Unit cur, nxt; int ui = 0;
    if (!S.next(0, cur)) return;
    f32x4 acc[2][2][4][2];
#pragma unroll
    for (int a = 0; a < 2; ++a)
#pragma unroll
        for (int b = 0; b < 2; ++b)
#pragma unroll
            for (int m = 0; m < 4; ++m)
#pragma unroll
                for (int n = 0; n < 2; ++n) acc[a][b][m][n] = (f32x4){0.f, 0.f, 0.f, 0.f};
    bf16x8 At[4][2], B0[2][2], B1[2][2];
    const char* cA = (const char*)g.A + (size_t)cur.pm * tstep + (size_t)cur.kt0 * kstep; const char* cB = (const char*)g.Bt + (size_t)cur.pn * tstep + (size_t)cur.kt0 * kstep;
    S.a_ready(cur);
    if constexpr (SP2) {
        PG8_STAGE(PG8_SB(0, 0), cB, voffB); PG8_STAGE(PG8_SB(0, 1), cB + hstep, voffB); PG8_STAGE(PG8_SA(0, 0), cA, voffA); PG8_STAGE(PG8_SA(0, 1), cA + hstep, voffA);
        if (wr == 1) PG8_BAR;
        PG8_WAIT_V(2); PG8_BAR;
        PG8_STAGE(PG8_SB(1, 0), cB + kstep, voffB); PG8_STAGE(PG8_SA(1, 0), cA + kstep, voffA); PG8_STAGE(PG8_SB(1, 1), cB + hstep + kstep, voffB);
        PG8_WAIT_V(6); PG8_BAR;
    } else {
        PG8_STAGE(PG8_SB(0, 0), cB, voffB); PG8_STAGE(PG8_SA(0, 0), cA, voffA); PG8_STAGE(PG8_SB(0, 1), cB + hstep, voffB); PG8_STAGE(PG8_SA(0, 1), cA + hstep, voffA);
        if (wr == 1) PG8_BAR;
        PG8_WAIT_V(4); PG8_BAR;
        PG8_STAGE(PG8_SB(1, 0), cB + kstep, voffB); PG8_STAGE(PG8_SA(1, 0), cA + kstep, voffA); PG8_STAGE(PG8_SB(1, 1), cB + hstep + kstep, voffB);
        PG8_WAIT_V(6); PG8_BAR;
    }
    for (;;) {
        const bool has_next = S.next(ui + 1, nxt);
        const char* nA = has_next ? (const char*)g.A + (size_t)nxt.pm * tstep + (size_t)nxt.kt0 * kstep : cA; const char* nB = has_next ? (const char*)g.Bt + (size_t)nxt.pn * tstep + (size_t)nxt.kt0 * kstep : cB;
        const int ntc = cur.nkt ? cur.nkt : nt;
        for (int t = 0; t < ntc; t += 2) {
            const bool last = (t == ntc - 2);
            const char* a1 = cA + (size_t)(t + 1) * kstep;
            const char* a2 = last ? nA : cA + (size_t)(t + 2) * kstep; const char* b2 = last ? nB : cB + (size_t)(t + 2) * kstep;
            const char* a3 = a2 + kstep; const char* b3 = b2 + kstep;
            if (last && has_next) S.a_ready(nxt);
            if constexpr (SP2) {
            PG8_LDB(B0, 0, 0); PG8_LDB(B1, 0, 1); PG8_SCHED; PG8_LDA(At, 0, 0); PG8_STAGE(PG8_SA(1, 1), a1 + hstep, voffA);
            PG8_WAIT_V(8); PG8_WAIT_L(0); PG8_BAR; PG8_MMA(0, 0, At, B0); PG8_MMA(0, 1, At, B1); PG8_BAR; PG8_SCHED;
            PG8_LDA(At, 0, 1); PG8_STAGE(PG8_SB(0, 0), b2, voffB); PG8_STAGE(PG8_SB(0, 1), b2 + hstep, voffB); PG8_STAGE(PG8_SA(0, 0), a2, voffA);
            PG8_WAIT_V(8); PG8_WAIT_L(0); PG8_BAR; PG8_MMA(1, 0, At, B0); PG8_MMA(1, 1, At, B1); PG8_BAR; PG8_SCHED;
            PG8_LDB(B0, 1, 0); PG8_LDB(B1, 1, 1); PG8_SCHED; PG8_LDA(At, 1, 0); PG8_STAGE(PG8_SA(0, 1), a2 + hstep, voffA);
            PG8_WAIT_V(8); PG8_WAIT_L(0); PG8_BAR; PG8_MMA(0, 0, At, B0); PG8_MMA(0, 1, At, B1); PG8_BAR; PG8_SCHED;
            PG8_LDA(At, 1, 1); PG8_STAGE(PG8_SB(1, 0), b3, voffB); PG8_STAGE(PG8_SB(1, 1), b3 + hstep, voffB); PG8_STAGE(PG8_SA(1, 0), a3, voffA);
            PG8_WAIT_V(8); PG8_WAIT_L(0); PG8_BAR; PG8_MMA(1, 0, At, B0); PG8_MMA(1, 1, At, B1); PG8_BAR; PG8_SCHED;
            } else {
            PG8_LDB(B0, 0, 0); PG8_SCHED; PG8_LDA(At, 0, 0); PG8_STAGE(PG8_SA(1, 1), a1 + hstep, voffA);
            PG8_WAIT_L(8); PG8_BAR; PG8_WAIT_L(0); PG8_MMA(0, 0, At, B0); PG8_BAR; PG8_SCHED;
            PG8_LDB(B1, 0, 1); PG8_STAGE(PG8_SB(0, 0), b2, voffB);
            PG8_BAR; PG8_WAIT_L(0); PG8_MMA(0, 1, At, B1); PG8_BAR;
            PG8_LDA(At, 0, 1); PG8_STAGE(PG8_SA(0, 0), a2, voffA);
            PG8_BAR; PG8_WAIT_L(0); PG8_MMA(1, 0, At, B0); PG8_BAR; PG8_SCHED;
            PG8_STAGE(PG8_SB(0, 1), b2 + hstep, voffB);
            PG8_WAIT_V(6); PG8_BAR; PG8_MMA(1, 1, At, B1); PG8_BAR;
            PG8_LDB(B0, 1, 0); PG8_SCHED; PG8_LDA(At, 1, 0); PG8_STAGE(PG8_SA(0, 1), a2 + hstep, voffA);
            PG8_WAIT_L(8); PG8_BAR; PG8_WAIT_L(0); PG8_MMA(0, 0, At, B0); PG8_BAR; PG8_SCHED;
            PG8_LDB(B1, 1, 1); PG8_STAGE(PG8_SB(1, 0), b3, voffB);
            PG8_BAR; PG8_WAIT_L(0); PG8_MMA(0, 1, At, B1); PG8_BAR;
            PG8_LDA(At, 1, 1); PG8_STAGE(PG8_SA(1, 0), a3, voffA);
            PG8_BAR; PG8_WAIT_L(0); PG8_MMA(1, 0, At, B0); PG8_BAR; PG8_SCHED;
            PG8_STAGE(PG8_SB(1, 1), b3 + hstep, voffB);
            PG8_WAIT_V(6); PG8_BAR; PG8_MMA(1, 1, At, B1); PG8_BAR;
            }
        }
        if constexpr (ALIGN_EPI) { if (wr == 0) PG8_BAR; }
        S.epilogue(acc, cur, E, wr, wc, fr, fq); S.done(cur);
        if (!has_next) break;
#pragma unroll
        for (int a = 0; a < 2; ++a)
#pragma unroll
            for (int b = 0; b < 2; ++b)
#pragma unroll
                for (int m = 0; m < 4; ++m)
#pragma unroll
                    for (int n = 0; n < 2; ++n) acc[a][b][m][n] = (f32x4){0.f, 0.f, 0.f, 0.f};
        cur = nxt; cA = nA; cB = nB; ++ui;
        if constexpr (ALIGN_EPI) { if (wr == 1) PG8_BAR; }
    }
    PG8_WAIT_V(0);
    if constexpr (!ALIGN_EPI) { if (wr == 0) PG8_BAR; }
    PG8_BAR;
#undef PG8_SA
#undef PG8_SB
#undef PG8_STAGE
#undef PG8_LDA
#undef PG8_LDB
#undef PG8_MMA
#undef PG8_WAIT_V
#undef PG8_WAIT_L
#undef PG8_BAR
#undef PG8_SCHED
}

__device__ __forceinline__ float row_rstd(const float* rss, int row) {
    const f32x4* p = (const f32x4*)(rss + (size_t)row * 16); const f32x4 a = p[0], b = p[1], c = p[2], d = p[3];
    const float s = ((a[0] + a[1]) + (a[2] + a[3])) + ((b[0] + b[1]) + (b[2] + b[3])) + ((c[0] + c[1]) + (c[2] + c[3])) + ((d[0] + d[1]) + (d[2] + d[3]));
    return rsqrtf(s * (1.0f / 1024.0f) + EPS);
}
struct EpiScaleBf16 {
    static constexpr bool PERM = true;
    bf16_t* O; int ldc; const float* rss; float* SM; int ntile_main;
    __device__ __forceinline__ void operator()(const f32x4 (&acc)[2][2][4][2], const Unit& u, int wr, int wc, int fr, int fq) const {
        const int row0 = u.pm * BM + wr * 64 + fr, cin = wc * 32 + 8 * fq;
#pragma unroll
        for (int ai = 0; ai < 2; ++ai)
#pragma unroll
            for (int m = 0; m < 4; ++m) { const int row = row0 + ai * HALF + m * 16; const float rs = row_rstd(rss, row);
#pragma unroll
                for (int bj = 0; bj < 2; ++bj) { const f32x4 v0 = acc[ai][bj][m][0] * rs, v1 = acc[ai][bj][m][1] * rs;
                    if (u.pn < ntile_main) { u32x4 w; w.x = cvt_pk_bf16(v0[0], v0[1]); w.y = cvt_pk_bf16(v0[2], v0[3]); w.z = cvt_pk_bf16(v1[0], v1[1]); w.w = cvt_pk_bf16(v1[2], v1[3]);
                        *(u32x4*)(O + (size_t)row * ldc + u.pn * BM + cin + bj * HALF) = w; }
                    else { const int c = cin + bj * HALF; if (c < 64) { float* p = SM + (size_t)row * 64 + c; *(f32x4*)p = v0; *(f32x4*)(p + 4) = v1; } } } }
    }
};
struct EpiGateF32 {
    static constexpr bool PERM = true;
    float* T1; const bf16_t* P; int gcol0;
    __device__ __forceinline__ void operator()(const f32x4 (&acc)[2][2][4][2], const Unit& u, int wr, int wc, int fr, int fq) const {
        const int row0 = u.pm * BM + wr * 64 + fr, col0 = u.pn * BM + wc * 32 + 8 * fq;
#pragma unroll
        for (int ai = 0; ai < 2; ++ai)
#pragma unroll
            for (int m = 0; m < 4; ++m) { const int row = row0 + ai * HALF + m * 16;
#pragma unroll
                for (int bj = 0; bj < 2; ++bj) { const int c = col0 + bj * HALF; const u32x4 g = *(const u32x4*)(P + (size_t)row * NPROJ + gcol0 + c);
                    const f32x4 a0 = acc[ai][bj][m][0], a1 = acc[ai][bj][m][1]; f32x4 o0, o1;
                    o0[0] = sigmoidf_(bf_lo(g.x)) * a0[0]; o0[1] = sigmoidf_(bf_hi(g.x)) * a0[1]; o0[2] = sigmoidf_(bf_lo(g.y)) * a0[2]; o0[3] = sigmoidf_(bf_hi(g.y)) * a0[3];
                    o1[0] = sigmoidf_(bf_lo(g.z)) * a1[0]; o1[1] = sigmoidf_(bf_hi(g.z)) * a1[1]; o1[2] = sigmoidf_(bf_lo(g.w)) * a1[2]; o1[3] = sigmoidf_(bf_hi(g.w)) * a1[3];
                    *(f32x4*)(T1 + (size_t)row * D + c) = o0; *(f32x4*)(T1 + (size_t)row * D + c + 4) = o1; } }
    }
};
struct EpiMerge {
    static constexpr bool PERM = true;
    bf16_t* O; const float* T1; const bf16_t* P; int gcol0;
    __device__ __forceinline__ void operator()(const f32x4 (&acc)[2][2][4][2], const Unit& u, int wr, int wc, int fr, int fq) const {
        const int row0 = u.pm * BM + wr * 64 + fr, col0 = u.pn * BM + wc * 32 + 8 * fq;
#pragma unroll
        for (int ai = 0; ai < 2; ++ai)
#pragma unroll
            for (int m = 0; m < 4; ++m) { const int row = row0 + ai * HALF + m * 16;
#pragma unroll
                for (int bj = 0; bj < 2; ++bj) { const int c = col0 + bj * HALF; const u32x4 g = *(const u32x4*)(P + (size_t)row * NPROJ + gcol0 + c);
                    const f32x4 t0 = *(const f32x4*)(T1 + (size_t)row * D + c), t1 = *(const f32x4*)(T1 + (size_t)row * D + c + 4);
                    const f32x4 a0 = acc[ai][bj][m][0], a1 = acc[ai][bj][m][1];
                    u32x4 w; w.x = cvt_pk_bf16(t0[0] + sigmoidf_(bf_lo(g.x)) * a0[0], t0[1] + sigmoidf_(bf_hi(g.x)) * a0[1]); w.y = cvt_pk_bf16(t0[2] + sigmoidf_(bf_lo(g.y)) * a0[2], t0[3] + sigmoidf_(bf_hi(g.y)) * a0[3]);
                    w.z = cvt_pk_bf16(t1[0] + sigmoidf_(bf_lo(g.z)) * a1[0], t1[1] + sigmoidf_(bf_hi(g.z)) * a1[1]); w.w = cvt_pk_bf16(t1[2] + sigmoidf_(bf_lo(g.w)) * a1[2], t1[3] + sigmoidf_(bf_hi(g.w)) * a1[3]);
                    *(u32x4*)(O + (size_t)row * D + c) = w; } }
    }
};
struct EpiResid {
    static constexpr bool PERM = false;
    float* X; bf16_t* XB; float* rss;
    __device__ __forceinline__ void operator()(const f32x4 (&acc)[2][2][4][2], const Unit& u, int wr, int wc, int fr, int fq) const {
        const int row0 = u.pm * BM + wr * 64 + fr, col0 = u.pn * BM + wc * 32 + 4 * fq;
#pragma unroll
        for (int ai = 0; ai < 2; ++ai)
#pragma unroll
            for (int m = 0; m < 4; ++m) { const int row = row0 + ai * HALF + m * 16; float s = 0.f;
#pragma unroll
                for (int bj = 0; bj < 2; ++bj)
#pragma unroll
                    for (int n = 0; n < 2; ++n) { const int c = col0 + bj * HALF + n * 16; float* xp = X + (size_t)row * D + c; const f32x4 xn = *(const f32x4*)xp + acc[ai][bj][m][n];
                        *(f32x4*)xp = xn; u32x2 w; w.x = cvt_pk_bf16(xn[0], xn[1]); w.y = cvt_pk_bf16(xn[2], xn[3]); *(u32x2*)(XB + (size_t)row * D + c) = w;
                        s += (xn[0] * xn[0] + xn[1] * xn[1]) + (xn[2] * xn[2] + xn[3] * xn[3]); }
                s += __shfl_xor(s, 16); s += __shfl_xor(s, 32);
                if (fq == 0) rss[(size_t)row * 16 + u.pn * 4 + wc] = s; }
    }
};
}

#define XB_TMO      128
#define XB_XCNT(j)  (256  + 64 * (j))
#define XB_XSUB(j)  (1280 + 64 * (j))
#define XB_XGEN(j)  (2304 + 64 * (j))
#define XB_TOP      3328
#define XB_TOPGEN   3392
#define XCD_BAR_WORDS 3456
#define XB_SPIN_CAP (1u << 18)
__device__ __forceinline__ unsigned xb_ld(unsigned* p)              { return __hip_atomic_load(p, __ATOMIC_RELAXED, __HIP_MEMORY_SCOPE_AGENT); }
__device__ __forceinline__ unsigned xb_add(unsigned* p, unsigned v) { return __hip_atomic_fetch_add(p, v, __ATOMIC_RELAXED, __HIP_MEMORY_SCOPE_AGENT); }
__device__ __forceinline__ unsigned xb_xcc_id() { return (unsigned)__builtin_amdgcn_s_getreg((3 << 11) | 20) & 0xFu; }
#define XB_SPIN(cond, bar) do { unsigned _sp = 0; while (cond) { __builtin_amdgcn_s_sleep(1); \
    if ((++_sp & 255u) == 0u) { if (xb_ld(&(bar)[XB_TMO])) break; if (_sp > XB_SPIN_CAP) { atomicAdd(&(bar)[XB_TMO], 1u); break; } } } } while (0)
struct XcdBarrier { unsigned* bar; unsigned x; volatile LAS unsigned* st; };
__device__ __forceinline__ XcdBarrier xcd_barrier_post(unsigned* bar, volatile LAS unsigned* st) {
    XcdBarrier b; b.bar = bar; b.x = xb_xcc_id(); b.st = st;
    if (threadIdx.x == 0) (void)xb_add(&bar[XB_XCNT(b.x)], 1u);
    return b;
}
__device__ __forceinline__ void xcd_barrier_complete(unsigned* bar, unsigned x, unsigned& nloc, unsigned& nx) {
    const unsigned G = gridDim.x * gridDim.y * gridDim.z;
    unsigned sum, cnt, mine, sp = 0u;
    for (;;) {
        sum = 0u; cnt = 0u; mine = 0u;
#pragma unroll
        for (unsigned j = 0; j < 16; ++j) { const unsigned c = xb_ld(&bar[XB_XCNT(j)]); sum += c; cnt += (c > 0u) ? 1u : 0u; mine = (j == x) ? c : mine; }
        if (sum == G) break;
        __builtin_amdgcn_s_sleep(1);
        if ((++sp & 255u) == 0u) { if (xb_ld(&bar[XB_TMO])) break; if (sp > XB_SPIN_CAP) { atomicAdd(&bar[XB_TMO], 1u); break; } }
    }
    nloc = mine > 0u ? mine : 1u; nx = cnt > 0u ? cnt : 1u;
}
__device__ __forceinline__ void xcd_barrier(const XcdBarrier& b) {
    asm volatile("s_waitcnt vmcnt(0)" ::: "memory");
    __syncthreads();
    if (threadIdx.x == 0) {
        unsigned* bar = b.bar;
        __builtin_amdgcn_s_waitcnt(0);
        unsigned nloc = b.st[0], nx = b.st[1];
        if (nloc == 0u) { xcd_barrier_complete(bar, b.x, nloc, nx); b.st[0] = nloc; b.st[1] = nx; }
        const unsigned old = xb_add(&bar[XB_XSUB(b.x)], 1u);
        const unsigned gen = old / nloc;
        if (old + 1u == (gen + 1u) * nloc) {
            __builtin_amdgcn_fence(__ATOMIC_RELEASE, "agent");
            asm volatile("s_waitcnt vmcnt(0)" ::: "memory");
            const unsigned og = xb_add(&bar[XB_TOP], 1u);
            const unsigned tg = og / nx;
            if (og + 1u == (tg + 1u) * nx) xb_add(&bar[XB_TOPGEN], 1u);
            else XB_SPIN(xb_ld(&bar[XB_TOPGEN]) == tg, bar);
            __builtin_amdgcn_fence(__ATOMIC_ACQUIRE, "agent");
            xb_add(&bar[XB_XGEN(b.x)], 1u);
            asm volatile("s_waitcnt vmcnt(0)" ::: "memory");
        } else {
            XB_SPIN(xb_ld(&bar[XB_XGEN(b.x)]) == gen, bar);
            __builtin_amdgcn_fence(__ATOMIC_ACQUIRE, "agent");
            asm volatile("s_waitcnt vmcnt(0)" ::: "memory");
        }
    }
    __syncthreads();
}

struct Args {
    const float* in[29]; float* out; unsigned char* ws; int ph_lo, ph_hi;
};
enum { I_XP = 0, I_XS, I_SSSM, I_SSC, I_SGDN, I_SGC, I_SFC, I_META, I_NMIX, I_WIN, I_SCW, I_SCB, I_SDTB, I_SALOG, I_SD, I_SNW, I_GCW, I_GDTB, I_GALOG, I_GNW,
       I_WSO, I_WGO, I_WO, I_NFFN, I_WUP, I_FCW, I_FCB, I_WDN, I_NF };
constexpr int LDS_BYTES = 160 * 1024 - 512;
constexpr int LDS_CTL = LDS_BYTES - 64;

__device__ __forceinline__ float wave_sum(float v) {
#pragma unroll
    for (int o = 1; o < 64; o <<= 1) v += __shfl_xor(v, o);
    return v;
}

__device__ __forceinline__ int win_src_col(int n) {
    if (n < 5120) return n;
    if (n < 8192) return 5152 + (n - 5120);
    if (n < 9216) return 8240 + (n - 8192);
    if (n < 10240) return 9264 + (n - 9216);
    if (n < 11264) return 10288 + (n - 10240);
    if (n < 11296) return 5120 + (n - 11264);
    if (n < 11304) return 8224 + (n - 11296);
    if (n < 11312) return 8232 + (n - 11304);
    return -1;
}
template <int MODE>
__device__ __forceinline__ void transpose_item(const float* W, int K, int Nsrc, bf16_t* WT, const float* scale, int scale_mask, LAS float* scr, int item, int nblk, int lane) {
    const int kb = item / nblk, nb = item - kb * nblk, k0 = 64 * kb, n0 = 64 * nb;
    const int nq = lane & 15, kr = lane >> 4; const int n = n0 + 4 * nq; const int sc = MODE == 1 ? win_src_col(n) : n;
    f32x4 v[16];
#pragma unroll
    for (int i = 0; i < 16; ++i) { const int k = k0 + 4 * i + kr; v[i] = sc >= 0 ? *(const f32x4*)(W + (size_t)k * Nsrc + sc) : (f32x4){0.f, 0.f, 0.f, 0.f}; }
#pragma unroll
    for (int i = 0; i < 16; ++i) { const int kk = 4 * i + kr; const float sv = scale ? scale[(k0 + kk) & scale_mask] : 1.0f; LAS float* d = scr + kk * 65 + 4 * nq;
        d[0] = v[i][0] * sv; d[1] = v[i][1] * sv; d[2] = v[i][2] * sv; d[3] = v[i][3] * sv; }
    LDS_WAIT(); asm volatile("" ::: "memory");
    const int c = lane & 7;
#pragma unroll
    for (int j = 0; j < 8; ++j) { const int nn = (lane >> 3) + 8 * j; const LAS float* sp = scr + (8 * c) * 65 + nn;
        u32x4 o; o.x = cvt_pk_bf16(sp[0 * 65], sp[1 * 65]); o.y = cvt_pk_bf16(sp[2 * 65], sp[3 * 65]); o.z = cvt_pk_bf16(sp[4 * 65], sp[5 * 65]); o.w = cvt_pk_bf16(sp[6 * 65], sp[7 * 65]);
        *(u32x4*)(WT + (size_t)(n0 + nn) * K + k0 + 8 * c) = o; }
    LDS_WAIT(); asm volatile("" ::: "memory");
}
__device__ __forceinline__ void phase_weights(const Args& a, LAS unsigned char* lds) {
    const int lane = tidx() & 63, wave = tidx() >> 6;
    LAS float* scr = (LAS float*)(lds + wave * 17408);
    const int gw = bidx() * 8 + wave, NGW = gdim() * 8;
    constexpr int I_A = 16 * (NPROJ_T / 64), I_B = 32 * 16, I_C = 16 * 16, I_D = 16 * 16, I_E = 16 * (NUP / 64), I_F = 44 * 16, I_L = I_A + I_B + I_C + I_D + I_E + I_F;
    for (int it = gw; it < DEPTH * I_L; it += NGW) {
        const int l = it / I_L; int r = it % I_L;
        if (r < I_A) { transpose_item<1>(a.in[I_WIN] + (size_t)l * D * IN_DIM, D, IN_DIM, (bf16_t*)(a.ws + WS_WIN + l * SZ_WIN), a.in[I_NMIX] + l * D, 0xffff, scr, r, NPROJ_T / 64, lane); continue; } r -= I_A;
        if (r < I_B) { transpose_item<0>(a.in[I_WSO] + (size_t)l * DI * D, DI, D, (bf16_t*)(a.ws + WS_WSO + l * SZ_WSO), a.in[I_SNW] + l * DI, 0xffff, scr, r, 16, lane); continue; } r -= I_B;
        if (r < I_C) { transpose_item<0>(a.in[I_WGO] + (size_t)l * D * D, D, D, (bf16_t*)(a.ws + WS_WGO + l * SZ_WGO), a.in[I_GNW] + l * DV, 127, scr, r, 16, lane); continue; } r -= I_C;
        if (r < I_D) { transpose_item<0>(a.in[I_WO] + (size_t)l * D * D, D, D, (bf16_t*)(a.ws + WS_WO + l * SZ_WO), nullptr, 0, scr, r, 16, lane); continue; } r -= I_D;
        if (r < I_E) { transpose_item<0>(a.in[I_WUP] + (size_t)l * D * NUP, D, NUP, (bf16_t*)(a.ws + WS_WUP + l * SZ_WUP), a.in[I_NFFN] + l * D, 0xffff, scr, r, NUP / 64, lane); continue; } r -= I_E;
        transpose_item<0>(a.in[I_WDN] + (size_t)l * DFF * D, DFF, D, (bf16_t*)(a.ws + WS_WDN + l * SZ_WDN), nullptr, 0, scr, r, 16, lane);
    }
}

__device__ __forceinline__ const float* src_row(const Args& a, int row) {
    if (row < ROW_S0) return a.in[I_XP] + (size_t)row * D;
    if (row < ROW_M0) return a.in[I_XS] + (size_t)(row - ROW_S0) * D;
    if (row < ROW_M0 + NMETA) return a.in[I_META] + (size_t)(row - ROW_M0) * D;
    return nullptr;
}
__device__ __forceinline__ void phase_inputs(const Args& a) {
    const int lane = tidx() & 63, wave = tidx() >> 6;
    const int gw = bidx() * 8 + wave, NGW = gdim() * 8;
    float* X = (float*)(a.ws + WS_X); bf16_t* XB = (bf16_t*)(a.ws + WS_XB); float* RSS = (float*)(a.ws + WS_RSS);
    for (int row = gw; row < MP; row += NGW) {
        const float* s = src_row(a, row); float ss = 0.f;
#pragma unroll
        for (int j = 0; j < 4; ++j) { f32x4 v = s ? *(const f32x4*)(s + 256 * j + 4 * lane) : (f32x4){0.f, 0.f, 0.f, 0.f};
            *(f32x4*)(X + (size_t)row * D + 256 * j + 4 * lane) = v; u32x2 w; w.x = cvt_pk_bf16(v[0], v[1]); w.y = cvt_pk_bf16(v[2], v[3]);
            *(u32x2*)(XB + (size_t)row * D + 256 * j + 4 * lane) = w; ss += (v[0] * v[0] + v[1] * v[1]) + (v[2] * v[2] + v[3] * v[3]); }
        ss = wave_sum(ss);
        if (lane < 16) RSS[(size_t)row * 16 + lane] = lane == 0 ? ss : 0.f;
    }
}

struct Chunk { int row0, seg, nvalid, kind, b, c; };
__device__ __forceinline__ Chunk chunk_of(int cid) {
    Chunk k;
    if (cid < CID_S0) { k.kind = 0; k.b = cid >> 5; k.c = cid & 31; k.row0 = k.b * SEQ + 64 * k.c; k.seg = 64; k.nvalid = 64; }
    else if (cid < CID_M) { k.kind = 1; k.b = cid - CID_S0; k.c = 0; k.row0 = ROW_S0 + 64 * k.b; k.seg = 4; k.nvalid = 64; }
    else { k.kind = 2; k.b = 0; k.c = 0; k.row0 = ROW_M0; k.seg = 16; k.nvalid = 16; }
    return k;
}

__device__ __forceinline__ void phase_prep(const Args& a, int l, LAS unsigned char* lds) {
    const int tid = tidx();
    LAS float* tDT = (LAS float*)lds;
    LAS float* tAC = tDT + 64 * 32;
    LAS float* tG = tAC + 64 * 32;
    LAS float* tB = tG + 64 * 8;
    const bf16_t* PROJ = (const bf16_t*)(a.ws + WS_PROJ); const float* SMALL = (const float*)(a.ws + WS_SMALL); float* SM2 = (float*)(a.ws + WS_SM2);
    bf16_t* XBCA = (bf16_t*)(a.ws + WS_XBCA); bf16_t* QKVA = (bf16_t*)(a.ws + WS_QKVA);
    bf16_t* XTG = (bf16_t*)(a.ws + WS_XTG); bf16_t* BTG = (bf16_t*)(a.ws + WS_BTG); bf16_t* KBT = (bf16_t*)(a.ws + WS_KBT); bf16_t* KGT = (bf16_t*)(a.ws + WS_KGT); bf16_t* VBT = (bf16_t*)(a.ws + WS_VBT);
    for (int unit = bidx(); unit < 256 * 3 + 9 * 6; unit += gdim()) {
        const int ex = unit - 256 * 3; const int cid = ex < 0 ? unit / 3 : 256 + ex / 6, third = ex < 0 ? unit % 3 : (ex % 6) >> 1, halfsel = ex < 0 ? -1 : (ex & 1); const Chunk ck = chunk_of(cid);
        __syncthreads();
        for (int idx = tid; idx < 64 * 48; idx += 512) { const int tok = idx / 48, col = idx % 48; const float raw = SMALL[(size_t)(ck.row0 + tok) * 64 + col]; const bool valid = tok < ck.nvalid;
            if (col < 32) { const float dt = valid ? softplusf_(raw + a.in[I_SDTB][l * NH + col]) : 0.f; tDT[tok * 32 + col] = dt; tAC[tok * 32 + col] = -__expf(a.in[I_SALOG][l * NH + col]) * dt; }
            else if (col < 40) { const int h = col - 32; tG[tok * 8 + h] = valid ? -__expf(a.in[I_GALOG][l * 8 + h]) * softplusf_(raw + a.in[I_GDTB][l * 8 + h]) : 0.f; }
            else { const int h = col - 40; tB[tok * 8 + h] = valid ? sigmoidf_(raw) : 0.f; } }
        __syncthreads();
        { const int lane = tid & 63, wv = tid >> 6;
#pragma unroll
          for (int cc = 0; cc < 5; ++cc) { const int col = wv * 5 + cc; LAS float* t = col < 32 ? tAC + col : tG + (col - 32); const int st = col < 32 ? 32 : 8;
              float v = t[lane * st];
#pragma unroll
              for (int o = 1; o < 64; o <<= 1) { const float up = __shfl_up(v, o); if (o < ck.seg && (lane & (ck.seg - 1)) >= o) v += up; }
              t[lane * st] = v; } }
        __syncthreads();
        if (third == 0 && halfsel <= 0) for (int idx = tid; idx < 64 * 80; idx += 512) { const int tok = idx / 80, col = idx % 80;
            const float v = col < 32 ? tDT[tok * 32 + col] : col < 64 ? tAC[tok * 32 + col - 32] : col < 72 ? tG[tok * 8 + col - 64] : tB[tok * 8 + col - 72];
            SM2[(size_t)(ck.row0 + tok) * 80 + col] = v; }
        const int gc = third * 2048 + tid * 4; const bool isx = gc < XBC; const int ch = isx ? gc : gc - XBC;
        const int pcol = isx ? PC_XBC + ch : PC_QKV + ch;
        const float* cw = isx ? a.in[I_SCW] + (size_t)l * 4 * XBC : a.in[I_GCW] + (size_t)l * 4 * QKV;
        float w[4][4], bias[4];
#pragma unroll
        for (int j = 0; j < 4; ++j) { const f32x4 t = *(const f32x4*)(cw + j * 3072 + ch); w[j][0] = t[0]; w[j][1] = t[1]; w[j][2] = t[2]; w[j][3] = t[3]; }
        { const f32x4 t = isx ? *(const f32x4*)(a.in[I_SCB] + l * XBC + ch) : (f32x4){0.f, 0.f, 0.f, 0.f}; bias[0] = t[0]; bias[1] = t[1]; bias[2] = t[2]; bias[3] = t[3]; }
        const float* st_in = (isx ? a.in[I_SSC] : a.in[I_SGC]) + (size_t)l * DB * 3 * 3072;
        float* cs_out_p = a.out + (isx ? O_PSC : O_PGC) + (size_t)l * NB * 3 * 3072;
        float* cs_out_s = a.out + (isx ? O_SSC : O_SGC) + (size_t)l * DB * 3 * 3072;
        const int kind = isx ? (ch < DI ? 0 : ch < DI + 512 ? 1 : 2) : (ch < 1024 ? 3 : ch < 2048 ? 4 : 5);
        const int hh = kind >= 3 ? ((ch & 1023) >> 7) : 0;
        float xw[3][4];
#pragma unroll
        for (int j = 0; j < 3; ++j)
#pragma unroll
            for (int e = 0; e < 4; ++e) xw[j][e] = 0.f;
        if (halfsel >= 0 && (tid >> 8) != halfsel) continue;
        const bool is_sample = ck.kind == 1, last_prompt = ck.kind == 0 && ck.c == 31;
        if (ck.kind == 0) { const int r3 = ck.c > 0 ? ck.row0 - 3 : ROW_M0 + 13;
#pragma unroll
            for (int j = 0; j < 3; ++j) { const u32x2 t = *(const u32x2*)(PROJ + (size_t)(r3 + j) * NPROJ + pcol); xw[j][0] = bf_lo(t.x); xw[j][1] = bf_hi(t.x); xw[j][2] = bf_lo(t.y); xw[j][3] = bf_hi(t.y); } }
        u32x2 nxt[8];
#pragma unroll
        for (int ii = 0; ii < 8; ++ii) nxt[ii] = *(const u32x2*)(PROJ + (size_t)(ck.row0 + ii) * NPROJ + pcol);
        for (int i8 = 0; i8 < 8; ++i8) {
            float cur[8][4];
#pragma unroll
            for (int ii = 0; ii < 8; ++ii) { const u32x2 t = nxt[ii]; cur[ii][0] = bf_lo(t.x); cur[ii][1] = bf_hi(t.x); cur[ii][2] = bf_lo(t.y); cur[ii][3] = bf_hi(t.y); }
            if (i8 < 7) {
#pragma unroll
                for (int ii = 0; ii < 8; ++ii) nxt[ii] = *(const u32x2*)(PROJ + (size_t)(ck.row0 + i8 * 8 + 8 + ii) * NPROJ + pcol); }
            float av[8][4];
#pragma unroll
            for (int ii = 0; ii < 8; ++ii) { const int i = i8 * 8 + ii;
                if (is_sample && (ii & 3) == 0) {
                    const int sq = ck.b * 16 + (i >> 2);
#pragma unroll
                    for (int j = 0; j < 3; ++j) { const f32x4 t = *(const f32x4*)(st_in + ((size_t)sq * 3 + j) * 3072 + ch); xw[j][0] = t[0]; xw[j][1] = t[1]; xw[j][2] = t[2]; xw[j][3] = t[3]; }
                }
#pragma unroll
                for (int e = 0; e < 4; ++e) { const float y = w[0][e] * xw[0][e] + w[1][e] * xw[1][e] + w[2][e] * xw[2][e] + w[3][e] * cur[ii][e] + bias[e]; av[ii][e] = siluf_(y);
                    xw[0][e] = xw[1][e]; xw[1][e] = xw[2][e]; xw[2][e] = cur[ii][e]; }
                if (ii >= 5 && last_prompt && i8 == 7) *(f32x4*)(cs_out_p + ((size_t)ck.b * 3 + (ii - 5)) * 3072 + ch) = (f32x4){cur[ii][0], cur[ii][1], cur[ii][2], cur[ii][3]};
                if ((ii & 3) >= 1 && is_sample) *(f32x4*)(cs_out_s + ((size_t)(ck.b * 16 + (i >> 2)) * 3 + ((ii & 3) - 1)) * 3072 + ch) = (f32x4){cur[ii][0], cur[ii][1], cur[ii][2], cur[ii][3]};
            }
            if (kind == 3 || kind == 4) {
                float ss[8];
#pragma unroll
                for (int ii = 0; ii < 8; ++ii) ss[ii] = (av[ii][0] * av[ii][0] + av[ii][1] * av[ii][1]) + (av[ii][2] * av[ii][2] + av[ii][3] * av[ii][3]);
#pragma unroll
                for (int o = 1; o < 32; o <<= 1)
#pragma unroll
                    for (int ii = 0; ii < 8; ++ii) ss[ii] += __shfl_xor(ss[ii], o);
#pragma unroll
                for (int ii = 0; ii < 8; ++ii) { const float r = rsqrtf(ss[ii] + EPS) * (kind == 3 ? 0.08838834764831845f : 1.0f);
#pragma unroll
                    for (int e = 0; e < 4; ++e) av[ii][e] *= r; }
            }
#pragma unroll
            for (int ii = 0; ii < 8; ++ii) { const int row = ck.row0 + i8 * 8 + ii; u32x2 o; o.x = cvt_pk_bf16(av[ii][0], av[ii][1]); o.y = cvt_pk_bf16(av[ii][2], av[ii][3]);
                *(u32x2*)((isx ? XBCA : QKVA) + (size_t)row * 3072 + ch) = o; }
            if (kind == 0 || kind == 1) { bf16_t* dst = kind == 0 ? XTG + ((size_t)(cid * 8 + i8) * 2048 + ch) * 8 : BTG + ((size_t)(cid * 8 + i8) * 512 + (ch - DI)) * 8;
#pragma unroll
                for (int e = 0; e < 4; ++e) { u32x4 o; o.x = cvt_pk_bf16(av[0][e], av[1][e]); o.y = cvt_pk_bf16(av[2][e], av[3][e]); o.z = cvt_pk_bf16(av[4][e], av[5][e]); o.w = cvt_pk_bf16(av[6][e], av[7][e]); *(u32x4*)(dst + e * 8) = o; } }
            if (kind == 4) { float s1[8], s2[8];
#pragma unroll
                for (int ii = 0; ii < 8; ++ii) { const int i = i8 * 8 + ii; const float gcv = tG[i * 8 + hh], last = tG[((i | (ck.seg - 1))) * 8 + hh]; s1[ii] = tB[i * 8 + hh] * __expf(gcv); s2[ii] = __expf(last - gcv); }
                bf16_t* d1 = KBT + ((size_t)(cid * 8 + i8) * 1024 + (ch - 1024)) * 8; bf16_t* d2 = KGT + ((size_t)(cid * 8 + i8) * 1024 + (ch - 1024)) * 8;
#pragma unroll
                for (int e = 0; e < 4; ++e) { u32x4 o; o.x = cvt_pk_bf16(av[0][e] * s1[0], av[1][e] * s1[1]); o.y = cvt_pk_bf16(av[2][e] * s1[2], av[3][e] * s1[3]); o.z = cvt_pk_bf16(av[4][e] * s1[4], av[5][e] * s1[5]); o.w = cvt_pk_bf16(av[6][e] * s1[6], av[7][e] * s1[7]); *(u32x4*)(d1 + e * 8) = o;
                    u32x4 p; p.x = cvt_pk_bf16(av[0][e] * s2[0], av[1][e] * s2[1]); p.y = cvt_pk_bf16(av[2][e] * s2[2], av[3][e] * s2[3]); p.z = cvt_pk_bf16(av[4][e] * s2[4], av[5][e] * s2[5]); p.w = cvt_pk_bf16(av[6][e] * s2[6], av[7][e] * s2[7]); *(u32x4*)(d2 + e * 8) = p; } }
            if (kind == 5) { float s1[8];
#pragma unroll
                for (int ii = 0; ii < 8; ++ii) s1[ii] = tB[(i8 * 8 + ii) * 8 + hh];
                bf16_t* d1 = VBT + ((size_t)(cid * 8 + i8) * 1024 + (ch - 2048)) * 8;
#pragma unroll
                for (int e = 0; e < 4; ++e) { u32x4 o; o.x = cvt_pk_bf16(av[0][e] * s1[0], av[1][e] * s1[1]); o.y = cvt_pk_bf16(av[2][e] * s1[2], av[3][e] * s1[3]); o.z = cvt_pk_bf16(av[4][e] * s1[4], av[5][e] * s1[5]); o.w = cvt_pk_bf16(av[6][e] * s1[6], av[7][e] * s1[7]); *(u32x4*)(d1 + e * 8) = o; } }
        }
    }
}

#define MFMA16(a, b, c) __builtin_amdgcn_mfma_f32_16x16x32_bf16((a), (b), (c), 0, 0, 0)

constexpr int GP_WAVE_LDS = 17920;
__device__ __forceinline__ void phase_gdnprep(const Args& a, LAS unsigned char* lds) {
    const int lane = tidx() & 63, wave = tidx() >> 6, r = lane & 15, q = lane >> 4;
    LAS float* AT = (LAS float*)(lds + wave * GP_WAVE_LDS);
    LAS bf16_t* Tb = (LAS bf16_t*)(lds + wave * GP_WAVE_LDS);
    LAS float* gcs = AT + 64 * 68; LAS float* bts = gcs + 64;
    const bf16_t* QKVA = (const bf16_t*)(a.ws + WS_QKVA); const float* SM2 = (const float*)(a.ws + WS_SM2);
    const bf16_t* KBT = (const bf16_t*)(a.ws + WS_KBT); const bf16_t* VBT = (const bf16_t*)(a.ws + WS_VBT);
    bf16_t* ATTN = (bf16_t*)(a.ws + WS_ATTN); bf16_t* UT = (bf16_t*)(a.ws + WS_UT); bf16_t* WM = (bf16_t*)(a.ws + WS_WM);
    const int gw = bidx() * 8 + wave, NGW = gdim() * 8;
    for (int unit = gw; unit < 257 * 8; unit += NGW) {
        const int pc = unit >> 3, h = unit & 7; const int cid = pc < 256 ? pc : CID_M; const Chunk ck = chunk_of(cid);
        gcs[lane] = SM2[(size_t)(ck.row0 + lane) * 80 + 64 + h]; bts[lane] = SM2[(size_t)(ck.row0 + lane) * 80 + 72 + h];
        bf16x8 kf[4][4];
#pragma unroll
        for (int t = 0; t < 4; ++t)
#pragma unroll
            for (int ks = 0; ks < 4; ++ks) kf[t][ks] = *(const bf16x8*)(QKVA + (size_t)(ck.row0 + 16 * t + r) * 3072 + 1024 + h * 128 + 32 * ks + 8 * q);
        bf16x8 qfa[4][4];
#pragma unroll
        for (int t = 0; t < 4; ++t)
#pragma unroll
            for (int ks = 0; ks < 4; ++ks) qfa[t][ks] = *(const bf16x8*)(QKVA + (size_t)(ck.row0 + 16 * t + r) * 3072 + h * 128 + 32 * ks + 8 * q);
        LDS_WAIT(); asm volatile("" ::: "memory");
        bf16_t* attn_u = ATTN + (size_t)(pc * 8 + h) * 64 * 64;
#pragma unroll
        for (int it = 0; it < 4; ++it) {
            const int i = 16 * it + r; const float gci = gcs[i];
#pragma unroll
            for (int jt = 0; jt < 4; ++jt) {
                f32x4 acc = (f32x4){0.f, 0.f, 0.f, 0.f};
                if (jt <= it) {
#pragma unroll
                    for (int ks = 0; ks < 4; ++ks) acc = MFMA16(kf[jt][ks], qfa[it][ks], acc);
#pragma unroll
                    for (int e = 0; e < 4; ++e) { const int j = 16 * jt + 4 * q + e; acc[e] = (j <= i) ? acc[e] * __expf(fminf(gci - gcs[j], 0.f)) : 0.f; }
                }
                u32x2 o; o.x = cvt_pk_bf16(acc[0], acc[1]); o.y = cvt_pk_bf16(acc[2], acc[3]);
                *(LAS u32x2*)(Tb + i * 68 + 16 * jt + 4 * q) = o;
            }
        }
        LDS_WAIT(); asm volatile("" ::: "memory");
#pragma unroll 4
        for (int k = 0; k < 8; ++k) { const int idx = k * 64 + lane, row = idx >> 3, c8 = idx & 7; const u32x2 a0 = *(const LAS u32x2*)(Tb + row * 68 + c8 * 8), a1 = *(const LAS u32x2*)(Tb + row * 68 + c8 * 8 + 4);
            *(u32x4*)(attn_u + (size_t)row * 64 + c8 * 8) = (u32x4){a0.x, a0.y, a1.x, a1.y}; }
        LDS_WAIT(); asm volatile("" ::: "memory");
#pragma unroll
        for (int rt = 0; rt < 4; ++rt)
#pragma unroll
            for (int ct = 0; ct <= rt; ++ct) {
                f32x4 acc = (f32x4){0.f, 0.f, 0.f, 0.f};
#pragma unroll
                for (int ks = 0; ks < 4; ++ks) acc = MFMA16(kf[rt][ks], kf[ct][ks], acc);
                const int c = 16 * ct + r; const float gcc = gcs[c]; f32x4 o;
#pragma unroll
                for (int e = 0; e < 4; ++e) { const int j = 16 * rt + 4 * q + e; o[e] = (c < j) ? bts[j] * acc[e] * __expf(fminf(gcs[j] - gcc, 0.f)) : 0.f;     }
                *(LAS f32x4*)(AT + c * 68 + 16 * rt + 4 * q) = o;
            }
        LDS_WAIT(); asm volatile("" ::: "memory");
        bf16x8 vba[8][2];
#pragma unroll
        for (int dvt = 0; dvt < 8; ++dvt)
#pragma unroll
            for (int ks = 0; ks < 2; ++ks) vba[dvt][ks] = *(const bf16x8*)(VBT + ((size_t)(cid * 8 + 4 * ks + q) * 1024 + h * 128 + 16 * dvt + r) * 8);
        float t[64];
#pragma unroll
        for (int c = 63; c >= 0; --c) {
            asm volatile("" ::: "memory");
            int ln = lane; asm volatile("" : "+v"(ln)); float acc0 = (ln == c) ? 1.f : 0.f, acc1 = 0.f;
#pragma unroll
            for (int g = (c + 1) >> 2; g < 16; ++g) {
                if (g >= 4 && pc == 256) continue;
                const f32x4 av = *(const LAS f32x4*)(AT + c * 68 + 4 * g);
#pragma unroll
                for (int e = 0; e < 4; ++e) { const int j = 4 * g + e; if (j > c) { if (g & 1) acc1 -= t[j] * av[e]; else acc0 -= t[j] * av[e]; } }
            }
            t[c] = acc0 + acc1; asm volatile("" : "+v"(t[c]));
        }
        LDS_WAIT(); asm volatile("" ::: "memory");
#pragma unroll
        for (int g = 0; g < 8; ++g) { u32x4 o; o.x = cvt_pk_bf16(t[8 * g], t[8 * g + 1]); o.y = cvt_pk_bf16(t[8 * g + 2], t[8 * g + 3]); o.z = cvt_pk_bf16(t[8 * g + 4], t[8 * g + 5]); o.w = cvt_pk_bf16(t[8 * g + 6], t[8 * g + 7]);
            *(LAS u32x4*)(Tb + lane * 72 + 8 * g) = o; }
        LDS_WAIT(); asm volatile("" ::: "memory");
        bf16x8 tf[4][2];
#pragma unroll
        for (int it = 0; it < 4; ++it)
#pragma unroll
            for (int ks = 0; ks < 2; ++ks) tf[it][ks] = *(const LAS bf16x8*)(Tb + (16 * it + r) * 72 + 32 * ks + 8 * q);
        bf16_t* ut_u = UT + (size_t)(pc * 8 + h) * 128 * 64; bf16_t* wm_u = WM + (size_t)(pc * 8 + h) * 64 * 128;
        bf16x8 kba[8][2];
#pragma unroll
        for (int dkt = 0; dkt < 8; ++dkt)
#pragma unroll
            for (int ks = 0; ks < 2; ++ks) kba[dkt][ks] = *(const bf16x8*)(KBT + ((size_t)(cid * 8 + 4 * ks + q) * 1024 + h * 128 + 16 * dkt + r) * 8);
#pragma unroll
        for (int dvt = 0; dvt < 8; ++dvt) {
#pragma unroll
            for (int it = 0; it < 4; ++it) { f32x4 acc = (f32x4){0.f, 0.f, 0.f, 0.f};
#pragma unroll
                for (int ks = 0; ks < 2; ++ks) acc = MFMA16(tf[it][ks], vba[dvt][ks], acc);
                u32x2 o; o.x = cvt_pk_bf16(acc[0], acc[1]); o.y = cvt_pk_bf16(acc[2], acc[3]);
                *(LAS u32x2*)(Tb + (16 * dvt + r) * 68 + 16 * it + 4 * q) = o; }
        }
        LDS_WAIT(); asm volatile("" ::: "memory");
#pragma unroll 4
        for (int k = 0; k < 16; ++k) { const int idx = k * 64 + lane, row = idx >> 3, c8 = idx & 7; const u32x2 a0 = *(const LAS u32x2*)(Tb + row * 68 + c8 * 8), a1 = *(const LAS u32x2*)(Tb + row * 68 + c8 * 8 + 4);
            *(u32x4*)(ut_u + (size_t)row * 64 + c8 * 8) = (u32x4){a0.x, a0.y, a1.x, a1.y}; }
        LDS_WAIT(); asm volatile("" ::: "memory");
#pragma unroll
        for (int dkt = 0; dkt < 8; ++dkt) {
#pragma unroll
            for (int it = 0; it < 4; ++it) { f32x4 acc = (f32x4){0.f, 0.f, 0.f, 0.f};
#pragma unroll
                for (int ks = 0; ks < 2; ++ks) acc = MFMA16(kba[dkt][ks], tf[it][ks], acc);
                u32x2 o; o.x = cvt_pk_bf16(acc[0], acc[1]); o.y = cvt_pk_bf16(acc[2], acc[3]);
                *(LAS u32x2*)(Tb + (16 * it + r) * 132 + 16 * dkt + 4 * q) = o; }
        }
        LDS_WAIT(); asm volatile("" ::: "memory");
#pragma unroll 4
        for (int k = 0; k < 16; ++k) { const int idx = k * 64 + lane, row = idx >> 4, c8 = idx & 15; const u32x2 a0 = *(const LAS u32x2*)(Tb + row * 132 + c8 * 8), a1 = *(const LAS u32x2*)(Tb + row * 132 + c8 * 8 + 4);
            *(u32x4*)(wm_u + (size_t)row * 128 + c8 * 8) = (u32x4){a0.x, a0.y, a1.x, a1.y}; }
        LDS_WAIT(); asm volatile("" ::: "memory");
    }
}

__device__ __forceinline__ void phase_sample_gdn(const Args& a, int l, LAS unsigned char* lds, int vb, int nvb) {
    const int tid = tidx(), sub = tid >> 7, dv = tid & 127, lane = tid & 63;
    LAS float* qk = (LAS float*)lds + sub * 1024;
    LAS float* red = (LAS float*)lds + 4096 + sub * 8;
    const bf16_t* QKVA = (const bf16_t*)(a.ws + WS_QKVA); const float* SM2 = (const float*)(a.ws + WS_SM2); const bf16_t* PROJ = (const bf16_t*)(a.ws + WS_PROJ);
    bf16_t* YG = (bf16_t*)(a.ws + WS_YG);
    for (int base = vb * 4; base < DB * 8; base += nvb * 4) {
        const int unit = base + sub, sq = unit >> 3, h = unit & 7; const int row0 = ROW_S0 + sq * 4;
        const float* sin = a.in[I_SGDN] + ((size_t)(l * DB + sq) * 8 + h) * DK * DV + dv;
        float* sout = a.out + O_SGDN + ((size_t)(l * DB + sq) * 8 + h) * DK * DV + dv;
        float s[128];
#pragma unroll
        for (int k = 0; k < 128; ++k) s[k] = sin[(size_t)k * DV];
        __syncthreads();
#pragma unroll
        for (int j = 0; j < 8; ++j) { const int idx = dv + 128 * j; const int tok = idx >> 8, which = (idx >> 7) & 1, d = idx & 127;
            qk[idx] = bf1(QKVA[(size_t)(row0 + tok) * 3072 + which * 1024 + h * 128 + d]); }
        float vv[4], gg[4], bb[4], gate[4];
#pragma unroll
        for (int t = 0; t < 4; ++t) { vv[t] = bf1(QKVA[(size_t)(row0 + t) * 3072 + 2048 + h * 128 + dv]); const float gc = SM2[(size_t)(row0 + t) * 80 + 64 + h], gp = t ? SM2[(size_t)(row0 + t - 1) * 80 + 64 + h] : 0.f;
            gg[t] = __expf(gc - gp); bb[t] = SM2[(size_t)(row0 + t) * 80 + 72 + h]; gate[t] = bf1(PROJ[(size_t)(row0 + t) * NPROJ + PC_GATE + h * 128 + dv]); }
        __syncthreads();
        float o[4];
#pragma unroll
        for (int t = 0; t < 4; ++t) {
            asm volatile("" ::: "memory");
            const LAS float* qv = qk + t * 256; const LAS float* kv = qv + 128;
            float r0 = 0.f, r1 = 0.f;
#pragma unroll
            for (int k = 0; k < 128; k += 4) { const f32x4 kk = *(const LAS f32x4*)(kv + k); r0 += s[k] * kk[0]; r1 += s[k + 1] * kk[1]; r0 += s[k + 2] * kk[2]; r1 += s[k + 3] * kk[3];
                if ((k & 15) == 12) { asm volatile("" : "+v"(r0), "+v"(r1)); asm volatile("" ::: "memory"); } }
            const float eg = gg[t], delta = bb[t] * (vv[t] - eg * (r0 + r1));
            float o0 = 0.f, o1 = 0.f;
#pragma unroll
            for (int k = 0; k < 128; k += 4) { const f32x4 kk = *(const LAS f32x4*)(kv + k), qq = *(const LAS f32x4*)(qv + k);
                s[k] = eg * s[k] + kk[0] * delta; s[k + 1] = eg * s[k + 1] + kk[1] * delta; s[k + 2] = eg * s[k + 2] + kk[2] * delta; s[k + 3] = eg * s[k + 3] + kk[3] * delta;
                o0 += s[k] * qq[0]; o1 += s[k + 1] * qq[1]; o0 += s[k + 2] * qq[2]; o1 += s[k + 3] * qq[3];
                if ((k & 15) == 12) { asm volatile("" : "+v"(o0), "+v"(o1)); asm volatile("" ::: "memory"); } }
            o[t] = o0 + o1;
        }
#pragma unroll
        for (int k = 0; k < 128; ++k) sout[(size_t)k * DV] = s[k];
#pragma unroll
        for (int t = 0; t < 4; ++t) { const float ss = wave_sum(o[t] * o[t]); if (lane == 0) red[((tid >> 6) & 1) * 4 + t] = ss; }
        __syncthreads();
#pragma unroll
        for (int t = 0; t < 4; ++t) { const float rstd = rsqrtf((red[t] + red[4 + t]) * (1.0f / 128.0f) + EPS);
            YG[(size_t)(row0 + t) * D + h * 128 + dv] = (bf16_t)(cvt_pk_bf16(o[t] * rstd * siluf_(gate[t]), 0.f) & 0xffffu); }
    }
}
struct SsPre { f32x4 hs[4]; u32x2 bw[4][4], cw[4][4]; float dt[4], xv[4]; float ah, dh, ex, ez; };
__device__ __forceinline__ void sample_ssd_load(const Args& a, int l, SsPre& P, int unit, int tid) {
    const int p = tid >> 3, nq = tid & 7; const int sq = unit >> 5, hd = unit & 31, g = hd >> 3; const int row0 = ROW_S0 + sq * 4;
    const bf16_t* XBCA = (const bf16_t*)(a.ws + WS_XBCA); const float* SM2 = (const float*)(a.ws + WS_SM2); const bf16_t* PROJ = (const bf16_t*)(a.ws + WS_PROJ);
    const float* sin = a.in[I_SSSM] + ((size_t)(l * DB + sq) * NH + hd) * HP * NST + (size_t)p * NST + nq * 4;
#pragma unroll
    for (int i = 0; i < 4; ++i) P.hs[i] = *(const f32x4*)(sin + 32 * i);
#pragma unroll
    for (int t = 0; t < 4; ++t) { const size_t ro = (size_t)(row0 + t) * 3072; P.dt[t] = SM2[(size_t)(row0 + t) * 80 + hd]; P.xv[t] = bf1(XBCA[ro + hd * 64 + p]);
#pragma unroll
        for (int i = 0; i < 4; ++i) { P.bw[t][i] = *(const u32x2*)(XBCA + ro + DI + g * 128 + nq * 4 + 32 * i); P.cw[t][i] = *(const u32x2*)(XBCA + ro + DI + 512 + g * 128 + nq * 4 + 32 * i); } }
    P.ah = a.in[I_SALOG][l * NH + hd]; P.dh = a.in[I_SD][l * NH + hd];
    { const int t = (tid >> 6) & 3, pp = tid & 63; P.ex = bf1(XBCA[(size_t)(row0 + t) * 3072 + hd * 64 + pp]); P.ez = bf1(PROJ[(size_t)(row0 + t) * NPROJ + PC_Z + hd * 64 + pp]); }
}
__device__ __forceinline__ void phase_sample_ssd(const Args& a, int l, LAS unsigned char* lds, int vb, int nvb) {
    const int tid = tidx(), p = tid >> 3, nq = tid & 7, lane = tid & 63;
    LAS float* ybuf = (LAS float*)lds + 8192;
    bf16_t* YS = (bf16_t*)(a.ws + WS_YS); float* SSQ = (float*)(a.ws + WS_SSQ);
    const int G = nvb; int unit = vb;
    SsPre P; if (unit < DB * NH) sample_ssd_load(a, l, P, unit, tid);
    for (; unit < DB * NH; unit += G) {
        const int sq = unit >> 5, hd = unit & 31; const int row0 = ROW_S0 + sq * 4;
        float* sout = a.out + O_SSSM + ((size_t)(l * DB + sq) * NH + hd) * HP * NST + (size_t)p * NST + nq * 4;
        SsPre C = P;
        if (unit + G < DB * NH) sample_ssd_load(a, l, P, unit + G, tid);
        const float Ah = -__expf(C.ah);
        __syncthreads();
#pragma unroll
        for (int t = 0; t < 4; ++t) { const float dA = __expf(C.dt[t] * Ah), dtx = C.dt[t] * C.xv[t]; float yp = 0.f;
#pragma unroll
            for (int i = 0; i < 4; ++i) { const u32x2 bw = C.bw[t][i], cw = C.cw[t][i];
                C.hs[i][0] = C.hs[i][0] * dA + dtx * bf_lo(bw.x); C.hs[i][1] = C.hs[i][1] * dA + dtx * bf_hi(bw.x); C.hs[i][2] = C.hs[i][2] * dA + dtx * bf_lo(bw.y); C.hs[i][3] = C.hs[i][3] * dA + dtx * bf_hi(bw.y);
                yp += (C.hs[i][0] * bf_lo(cw.x) + C.hs[i][1] * bf_hi(cw.x)) + (C.hs[i][2] * bf_lo(cw.y) + C.hs[i][3] * bf_hi(cw.y)); }
            yp += __shfl_xor(yp, 1); yp += __shfl_xor(yp, 2); yp += __shfl_xor(yp, 4);
            if (nq == 0) ybuf[t * 64 + p] = yp; }
#pragma unroll
        for (int i = 0; i < 4; ++i) *(f32x4*)(sout + 32 * i) = C.hs[i];
        __syncthreads();
        if (tid < 256) { const int t = tid >> 6, pp = tid & 63, row = row0 + t;
            const float y = (ybuf[t * 64 + pp] + C.dh * C.ex) * siluf_(C.ez);
            YS[(size_t)row * DI + hd * 64 + pp] = (bf16_t)(cvt_pk_bf16(y, 0.f) & 0xffffu);
            const float ss = wave_sum(y * y); if (lane == 0) SSQ[(size_t)row * 32 + hd] = ss; }
    }
}


struct SsdPre { u32x4 pC[2], pB[2], pBT[2], pXT, pX, pZ; float pS; };
__device__ __forceinline__ void ssd_load(const Args& a, SsdPre& P, int b, int hd, int c, int tid) {
    const int g = hd >> 3; const int cid = c == 0 ? CID_M : b * 32 + c - 1; const int row0 = c == 0 ? ROW_M0 : b * SEQ + 64 * (c - 1);
    const bf16_t* XBCA = (const bf16_t*)(a.ws + WS_XBCA); const bf16_t* BTG = (const bf16_t*)(a.ws + WS_BTG); const bf16_t* XTG = (const bf16_t*)(a.ws + WS_XTG);
    const bf16_t* PROJ = (const bf16_t*)(a.ws + WS_PROJ); const float* SM2 = (const float*)(a.ws + WS_SM2);
#pragma unroll
    for (int k = 0; k < 2; ++k) { const int idx = tid + 512 * k, row = idx >> 4, c16 = idx & 15;
        P.pC[k] = *(const u32x4*)(XBCA + (size_t)(row0 + row) * 3072 + DI + 512 + g * 128 + c16 * 8);
        P.pB[k] = *(const u32x4*)(XBCA + (size_t)(row0 + row) * 3072 + DI + g * 128 + c16 * 8);
        const int n = idx & 127, j8 = idx >> 7; P.pBT[k] = *(const u32x4*)(BTG + ((size_t)(cid * 8 + j8) * 512 + g * 128 + n) * 8); }
    P.pXT = *(const u32x4*)(XTG + ((size_t)(cid * 8 + (tid >> 6)) * 2048 + hd * 64 + (tid & 63)) * 8);
    { const int p = tid >> 3, j8 = tid & 7;
      P.pX = *(const u32x4*)(XBCA + (size_t)(row0 + p) * 3072 + hd * 64 + j8 * 8);
      P.pZ = *(const u32x4*)(PROJ + (size_t)(row0 + p) * NPROJ + PC_Z + hd * 64 + j8 * 8); }
    P.pS = tid < 128 ? SM2[(size_t)(row0 + (tid & 63)) * 80 + (tid >> 6) * 32 + hd] : 0.f;
}
__device__ __forceinline__ void ssd_chain(const Args& a, int l, LAS unsigned char* lds, int unit) {
    const int tid = tidx(), lane = tid & 63, wave = __builtin_amdgcn_readfirstlane(tid >> 6), r = lane & 15, q = lane >> 4;
    const int b = unit >> 5, hd = unit & 31;
    LAS bf16_t* Cn = (LAS bf16_t*)lds;
    LAS bf16_t* Bn = Cn + 64 * 136;
    LAS bf16_t* BT = Bn + 64 * 136;
    LAS bf16_t* XT = BT + 128 * 72;
    LAS bf16_t* Wl = XT + 64 * 72;
    LAS bf16_t* Hb = Wl + 64 * 72;
    LAS float* YL = (LAS float*)(Hb + 2 * 64 * 136);
    LAS float* tdt = YL + 64 * 68; LAS float* tac = tdt + 64; LAS float* teac = tac + 64; LAS float* twj = teac + 64;
    bf16_t* YS = (bf16_t*)(a.ws + WS_YS); float* SSQ = (float*)(a.ws + WS_SSQ);
    const float Dh = a.in[I_SD][l * NH + hd];
    __syncthreads();
    for (int i = tid; i < 64 * 136 / 2; i += 512) ((LAS unsigned*)Hb)[i] = 0u;
    f32x4 hT[4];
#pragma unroll
    for (int pt = 0; pt < 4; ++pt) hT[pt] = (f32x4){0.f, 0.f, 0.f, 0.f};
    SsdPre P; ssd_load(a, P, b, hd, 0, tid);
    int cur = 0;
    for (int c = 0; c < 33; ++c) {
        const int nvalid = c == 0 ? 16 : 64; const int row0 = c == 0 ? ROW_M0 : b * SEQ + 64 * (c - 1);
        for (int r5 = 0; r5 < REPN(20); ++r5)
#pragma unroll
        for (int k = 0; k < 2; ++k) { const int idx = tid + 512 * k, row = idx >> 4, c16 = idx & 15; *(LAS u32x4*)(Cn + row * 136 + c16 * 8) = P.pC[k]; *(LAS u32x4*)(Bn + row * 136 + c16 * 8) = P.pB[k];
            const int n = idx & 127, j8 = idx >> 7; *(LAS u32x4*)(BT + n * 72 + j8 * 8) = P.pBT[k]; }
        *(LAS u32x4*)(XT + (tid & 63) * 72 + (tid >> 6) * 8) = P.pXT;
        if (tid < 128) tdt[tid] = P.pS;
        const u32x4 xcur = P.pX, zcur = P.pZ;
        __syncthreads();
        if (c < 32) ssd_load(a, P, b, hd, c + 1, tid);
        const float last = tac[nvalid - 1];
        for (int r3 = 0; r3 < REPN(18); ++r3)
        { const int it = wave & 3, pt0 = 2 * (wave >> 2); const int i = 16 * it + r; bf16x8 cf[4];
#pragma unroll
          for (int ks = 0; ks < 4; ++ks) cf[ks] = *(const LAS bf16x8*)(Cn + (16 * it + r) * 136 + 32 * ks + 8 * q);
          const float aci = tac[i], eaci = __expf(aci); u32x2 wreg[4];
          bf16x8 bfr[4][4];
#pragma unroll
          for (int jt = 0; jt < 4; ++jt)
#pragma unroll
              for (int ks = 0; ks < 4; ++ks) bfr[jt][ks] = (jt <= it) ? *(const LAS bf16x8*)(Bn + (16 * jt + r) * 136 + 32 * ks + 8 * q) : cf[ks];
          __builtin_amdgcn_sched_barrier(0);
#pragma unroll
          for (int jt = 0; jt < 4; ++jt) { wreg[jt] = (u32x2){0u, 0u};
              if (jt <= it) { f32x4 acc = (f32x4){0.f, 0.f, 0.f, 0.f};
#pragma unroll
                  for (int ks = 0; ks < 4; ++ks) acc = MFMA16(bfr[jt][ks], cf[ks], acc);
                  const f32x4 acj = *(const LAS f32x4*)(tac + 16 * jt + 4 * q), dtj = *(const LAS f32x4*)(tdt + 16 * jt + 4 * q);
#pragma unroll
                  for (int e = 0; e < 4; ++e) { const int j = 16 * jt + 4 * q + e; acc[e] = (j <= i) ? acc[e] * __expf(fminf(aci - acj[e], 0.f)) * dtj[e] : 0.f; }
                  wreg[jt] = pack4(acc); } }
          const LAS bf16_t* Hc = Hb + cur * 64 * 136;
          bf16x8 hfr[2][4]; u32x2 xfr[2][2][2];
#pragma unroll
          for (int t2 = 0; t2 < 2; ++t2) {
#pragma unroll
              for (int ks = 0; ks < 4; ++ks) hfr[t2][ks] = *(const LAS bf16x8*)(Hc + (16 * (pt0 + t2) + r) * 136 + 32 * ks + 8 * q);
#pragma unroll
              for (int s2 = 0; s2 < 2; ++s2) { xfr[t2][s2][0] = *(const LAS u32x2*)(XT + (16 * (pt0 + t2) + r) * 72 + 32 * s2 + 4 * q); xfr[t2][s2][1] = *(const LAS u32x2*)(XT + (16 * (pt0 + t2) + r) * 72 + 32 * s2 + 16 + 4 * q); } }
          __builtin_amdgcn_sched_barrier(0);
#pragma unroll
          for (int t2 = 0; t2 < 2; ++t2) { const int pt = pt0 + t2; f32x4 acc = (f32x4){0.f, 0.f, 0.f, 0.f};
#pragma unroll
              for (int ks = 0; ks < 4; ++ks) acc = MFMA16(hfr[t2][ks], cf[ks], acc);
              acc = acc * eaci;
#pragma unroll
              for (int s2 = 0; s2 < 2; ++s2) { if (2 * s2 <= it) {
                  const u32x4 xw4 = (u32x4){xfr[t2][s2][0].x, xfr[t2][s2][0].y, xfr[t2][s2][1].x, xfr[t2][s2][1].y}, ww4 = (u32x4){wreg[2 * s2].x, wreg[2 * s2].y, wreg[2 * s2 + 1].x, wreg[2 * s2 + 1].y};
                  acc = MFMA16(__builtin_bit_cast(bf16x8, xw4), __builtin_bit_cast(bf16x8, ww4), acc); } }
              *(LAS f32x4*)(YL + (16 * it + r) * 68 + 16 * pt + 4 * q) = acc; } }
        { const float elast = __expf(last); bf16x8 bs[2];
#pragma unroll
          for (int ks = 0; ks < 2; ++ks) { float f[8]; unpack8(*(const LAS u32x4*)(BT + (16 * wave + r) * 72 + 32 * ks + 8 * q), f);
              const f32x4 a0 = *(const LAS f32x4*)(tac + 32 * ks + 8 * q), a1 = *(const LAS f32x4*)(tac + 32 * ks + 8 * q + 4), d0 = *(const LAS f32x4*)(tdt + 32 * ks + 8 * q), d1 = *(const LAS f32x4*)(tdt + 32 * ks + 8 * q + 4);
              float wv[8];
#pragma unroll
              for (int e = 0; e < 4; ++e) { wv[e] = __expf(last - a0[e]) * d0[e]; wv[4 + e] = __expf(last - a1[e]) * d1[e]; }
              u32x4 o; o.x = cvt_pk_bf16(f[0] * wv[0], f[1] * wv[1]); o.y = cvt_pk_bf16(f[2] * wv[2], f[3] * wv[3]); o.z = cvt_pk_bf16(f[4] * wv[4], f[5] * wv[5]); o.w = cvt_pk_bf16(f[6] * wv[6], f[7] * wv[7]); bs[ks] = __builtin_bit_cast(bf16x8, o); }
          LAS bf16_t* Hn = Hb + (cur ^ 1) * 64 * 136; bf16x8 xq[4][2];
#pragma unroll
          for (int pt = 0; pt < 4; ++pt)
#pragma unroll
              for (int ks = 0; ks < 2; ++ks) xq[pt][ks] = *(const LAS bf16x8*)(XT + (16 * pt + r) * 72 + 32 * ks + 8 * q);
          __builtin_amdgcn_sched_barrier(0);
#pragma unroll
          for (int pt = 0; pt < 4; ++pt) { hT[pt] = hT[pt] * elast;
#pragma unroll
              for (int ks = 0; ks < 2; ++ks) hT[pt] = MFMA16(bs[ks], xq[pt][ks], hT[pt]);
              *(LAS u32x2*)(Hn + (16 * pt + r) * 136 + 16 * wave + 4 * q) = pack4(hT[pt]); } }
        __syncthreads();
        for (int r4 = 0; r4 < REPN(19); ++r4)
        { const int i = tid >> 3, p8 = tid & 7; const f32x4 y0 = *(const LAS f32x4*)(YL + i * 68 + p8 * 8), y1 = *(const LAS f32x4*)(YL + i * 68 + p8 * 8 + 4);
          float xv[8], zv[8], o[8]; unpack8(xcur, xv); unpack8(zcur, zv); float ss = 0.f;
#pragma unroll
          for (int e = 0; e < 8; ++e) { const float y = e < 4 ? y0[e] : y1[e - 4]; o[e] = (y + Dh * xv[e]) * siluf_(zv[e]); ss += o[e] * o[e]; }
          ss += __shfl_xor(ss, 1); ss += __shfl_xor(ss, 2); ss += __shfl_xor(ss, 4);
          if (i < nvalid && (c > 0 || b == 0)) { u32x4 w; w.x = cvt_pk_bf16(o[0], o[1]); w.y = cvt_pk_bf16(o[2], o[3]); w.z = cvt_pk_bf16(o[4], o[5]); w.w = cvt_pk_bf16(o[6], o[7]);
              *(u32x4*)(YS + (size_t)(row0 + i) * DI + hd * 64 + p8 * 8) = w; if (p8 == 0) SSQ[(size_t)(row0 + i) * 32 + hd] = ss; } }
        cur ^= 1;
    }
    float* so = a.out + O_PSSM + ((size_t)(l * NB + b) * NH + hd) * HP * NST;
#pragma unroll
    for (int pt = 0; pt < 4; ++pt) *(f32x4*)(so + (size_t)(16 * pt + r) * NST + 16 * wave + 4 * q) = hT[pt];
}

struct GdnPre { u32x4 pW[2], pQ[2], pA, pK[2], pG[2]; u32x2 pU[4]; float pS; };
__device__ __forceinline__ void gdn_load(const Args& a, GdnPre& P, int b, int h, int c, int tid, int wave, int r, int q) {
    const int cid = c == 0 ? CID_M : b * 32 + c - 1, pc = c == 0 ? 256 : b * 32 + c - 1; const int row0 = c == 0 ? ROW_M0 : b * SEQ + 64 * (c - 1);
    const bf16_t* WM = (const bf16_t*)(a.ws + WS_WM); const bf16_t* QKVA = (const bf16_t*)(a.ws + WS_QKVA); const bf16_t* ATTN = (const bf16_t*)(a.ws + WS_ATTN);
    const bf16_t* KGT = (const bf16_t*)(a.ws + WS_KGT); const bf16_t* UT = (const bf16_t*)(a.ws + WS_UT); const bf16_t* PROJ = (const bf16_t*)(a.ws + WS_PROJ); const float* SM2 = (const float*)(a.ws + WS_SM2);
#pragma unroll
    for (int k = 0; k < 2; ++k) { const int idx = tid + 512 * k, i = idx >> 4, c16 = idx & 15;
        P.pW[k] = *(const u32x4*)(WM + ((size_t)(pc * 8 + h) * 64 + i) * 128 + c16 * 8);
        P.pQ[k] = *(const u32x4*)(QKVA + (size_t)(row0 + i) * 3072 + h * 128 + c16 * 8);
        const int dk = idx & 127, j8 = idx >> 7; P.pK[k] = *(const u32x4*)(KGT + ((size_t)(cid * 8 + j8) * 1024 + h * 128 + dk) * 8);
        P.pG[k] = *(const u32x4*)(PROJ + (size_t)(row0 + (tid >> 3)) * NPROJ + PC_GATE + h * 128 + (tid & 7) * 16 + 8 * k); }
    P.pA = *(const u32x4*)(ATTN + ((size_t)(pc * 8 + h) * 64 + (tid >> 3)) * 64 + (tid & 7) * 8);
    const int wi = wave & 3, wh = wave >> 2;
#pragma unroll
    for (int t = 0; t < 4; ++t) P.pU[t] = *(const u32x2*)(UT + ((size_t)(pc * 8 + h) * 128 + 16 * (4 * wh + t) + r) * 64 + 16 * wi + 4 * q);
    P.pS = tid < 64 ? SM2[(size_t)(row0 + tid) * 80 + 64 + h] : 0.f;
}
__device__ __forceinline__ void gdn_chain(const Args& a, int l, LAS unsigned char* lds, int unit) {
    const int tid = tidx(), lane = tid & 63, wave = __builtin_amdgcn_readfirstlane(tid >> 6), r = lane & 15, q = lane >> 4;
    const int b = unit >> 3, h = unit & 7, wi = wave & 3, wh = wave >> 2;
    LAS bf16_t* STb = (LAS bf16_t*)lds;
    LAS bf16_t* Wm = STb + 128 * 136;
    LAS bf16_t* Qn = Wm + 64 * 136;
    LAS bf16_t* VNT = Qn + 64 * 136;
    LAS bf16_t* ATn = VNT + 128 * 72;
    LAS bf16_t* KG = ATn + 64 * 72;
    LAS float* OL = (LAS float*)(KG + 128 * 72);
    LAS float* tgc = OL + 64 * 132;
    bf16_t* YG = (bf16_t*)(a.ws + WS_YG);
    __syncthreads();
    for (int i = tid; i < 128 * 136 / 2; i += 512) ((LAS unsigned*)STb)[i] = 0u;
    f32x4 S[8];
#pragma unroll
    for (int t = 0; t < 8; ++t) S[t] = (f32x4){0.f, 0.f, 0.f, 0.f};
    GdnPre P; gdn_load(a, P, b, h, 0, tid, wave, r, q);
    for (int c = 0; c < 33; ++c) {
        const int nvalid = c == 0 ? 16 : 64; const int row0 = c == 0 ? ROW_M0 : b * SEQ + 64 * (c - 1);
#pragma unroll
        for (int k = 0; k < 2; ++k) { const int idx = tid + 512 * k, i = idx >> 4, c16 = idx & 15; *(LAS u32x4*)(Wm + i * 136 + c16 * 8) = P.pW[k]; *(LAS u32x4*)(Qn + i * 136 + c16 * 8) = P.pQ[k];
            const int dk = idx & 127, j8 = idx >> 7; *(LAS u32x4*)(KG + dk * 72 + j8 * 8) = P.pK[k]; }
        *(LAS u32x4*)(ATn + (tid >> 3) * 72 + (tid & 7) * 8) = P.pA;
        if (tid < 64) tgc[tid] = P.pS;
        u32x2 ucur[4]; u32x4 gcur[2];
#pragma unroll
        for (int t = 0; t < 4; ++t) ucur[t] = P.pU[t];
        gcur[0] = P.pG[0]; gcur[1] = P.pG[1];
        __syncthreads();
        if (c < 32) gdn_load(a, P, b, h, c + 1, tid, wave, r, q);
        const float last = tgc[nvalid - 1];
        f32x4 o1[4];
        { bf16x8 wf[4], qf[4];
#pragma unroll
          for (int ks = 0; ks < 4; ++ks) { wf[ks] = *(const LAS bf16x8*)(Wm + (16 * wi + r) * 136 + 32 * ks + 8 * q); qf[ks] = *(const LAS bf16x8*)(Qn + (16 * wi + r) * 136 + 32 * ks + 8 * q); }
          const f32x4 gi = *(const LAS f32x4*)(tgc + 16 * wi + 4 * q);
#pragma unroll
          for (int t = 0; t < 4; ++t) { const int dvt = 4 * wh + t; f32x4 p1 = (f32x4){0.f, 0.f, 0.f, 0.f}; o1[t] = (f32x4){0.f, 0.f, 0.f, 0.f};
              bf16x8 sfr[4];
#pragma unroll
              for (int ks = 0; ks < 4; ++ks) sfr[ks] = *(const LAS bf16x8*)(STb + (16 * dvt + r) * 136 + 32 * ks + 8 * q);
              __builtin_amdgcn_sched_barrier(0);
#pragma unroll
              for (int ks = 0; ks < 4; ++ks) { const bf16x8 sf = sfr[ks]; p1 = MFMA16(wf[ks], sf, p1); o1[t] = MFMA16(qf[ks], sf, o1[t]); }
              f32x4 vn; vn[0] = bf_lo(ucur[t].x) - p1[0]; vn[1] = bf_hi(ucur[t].x) - p1[1]; vn[2] = bf_lo(ucur[t].y) - p1[2]; vn[3] = bf_hi(ucur[t].y) - p1[3];
              *(LAS u32x2*)(VNT + (16 * dvt + r) * 72 + 16 * wi + 4 * q) = pack4(vn);
#pragma unroll
              for (int e = 0; e < 4; ++e) o1[t][e] *= __expf(gi[e]); } }
        __syncthreads();
        bf16x8 vfr[4][2];
#pragma unroll
        for (int t = 0; t < 4; ++t)
#pragma unroll
            for (int ks = 0; ks < 2; ++ks) vfr[t][ks] = *(const LAS bf16x8*)(VNT + (16 * (4 * wh + t) + r) * 72 + 32 * ks + 8 * q);
        { bf16x8 af[2];
#pragma unroll
          for (int ks = 0; ks < 2; ++ks) af[ks] = *(const LAS bf16x8*)(ATn + (16 * wi + r) * 72 + 32 * ks + 8 * q);
          __builtin_amdgcn_sched_barrier(0);
#pragma unroll
          for (int t = 0; t < 4; ++t) { const int dvt = 4 * wh + t;
#pragma unroll
              for (int ks = 0; ks < 2; ++ks) o1[t] = MFMA16(af[ks], vfr[t][ks], o1[t]);
#pragma unroll
              for (int e = 0; e < 4; ++e) OL[(16 * wi + 4 * q + e) * 132 + 16 * dvt + r] = o1[t][e]; } }
        { const float elast = __expf(last); bf16x8 kf[2];
#pragma unroll
          for (int ks = 0; ks < 2; ++ks) kf[ks] = *(const LAS bf16x8*)(KG + (16 * wave + r) * 72 + 32 * ks + 8 * q);
          bf16x8 vf2[4][2];
#pragma unroll
          for (int t = 0; t < 4; ++t)
#pragma unroll
              for (int ks = 0; ks < 2; ++ks) vf2[t][ks] = *(const LAS bf16x8*)(VNT + (16 * (4 * (wh ^ 1) + t) + r) * 72 + 32 * ks + 8 * q);
          __builtin_amdgcn_sched_barrier(0);
#pragma unroll
          for (int dvt = 0; dvt < 8; ++dvt) { S[dvt] = S[dvt] * elast;
#pragma unroll
              for (int ks = 0; ks < 2; ++ks) { const bf16x8 vv = ((dvt >> 2) == wh) ? vfr[dvt & 3][ks] : vf2[dvt & 3][ks]; S[dvt] = MFMA16(kf[ks], vv, S[dvt]); }
              *(LAS u32x2*)(STb + (16 * dvt + r) * 136 + 16 * wave + 4 * q) = pack4(S[dvt]); } }
        __syncthreads();
        { const int i = tid >> 3, d16 = tid & 7; float o[16], gt[16]; float ss = 0.f;
#pragma unroll
          for (int k = 0; k < 4; ++k) { const f32x4 v = *(const LAS f32x4*)(OL + i * 132 + d16 * 16 + 4 * k); o[4 * k] = v[0]; o[4 * k + 1] = v[1]; o[4 * k + 2] = v[2]; o[4 * k + 3] = v[3]; ss += (v[0] * v[0] + v[1] * v[1]) + (v[2] * v[2] + v[3] * v[3]); }
          ss += __shfl_xor(ss, 1); ss += __shfl_xor(ss, 2); ss += __shfl_xor(ss, 4);
          const float rstd = rsqrtf(ss * (1.0f / 128.0f) + EPS);
          { float f[8]; unpack8(gcur[0], f);
#pragma unroll
            for (int e = 0; e < 8; ++e) gt[e] = f[e]; unpack8(gcur[1], f);
#pragma unroll
            for (int e = 0; e < 8; ++e) gt[8 + e] = f[e]; }
#pragma unroll
          for (int e = 0; e < 16; ++e) o[e] = o[e] * rstd * siluf_(gt[e]);
          if (i < nvalid && (c > 0 || b == 0)) { u32x4 w0, w1; w0.x = cvt_pk_bf16(o[0], o[1]); w0.y = cvt_pk_bf16(o[2], o[3]); w0.z = cvt_pk_bf16(o[4], o[5]); w0.w = cvt_pk_bf16(o[6], o[7]);
              w1.x = cvt_pk_bf16(o[8], o[9]); w1.y = cvt_pk_bf16(o[10], o[11]); w1.z = cvt_pk_bf16(o[12], o[13]); w1.w = cvt_pk_bf16(o[14], o[15]);
              bf16_t* dst = YG + (size_t)(row0 + i) * D + h * 128 + d16 * 16; *(u32x4*)dst = w0; *(u32x4*)(dst + 8) = w1; } }
    }
    float* so = a.out + O_PGDN + ((size_t)(l * NB + b) * 8 + h) * DK * DV;
#pragma unroll
    for (int dvt = 0; dvt < 8; ++dvt)
#pragma unroll
        for (int e = 0; e < 4; ++e) so[(size_t)(16 * wave + 4 * q + e) * DV + 16 * dvt + r] = S[dvt][e];
}

__device__ __forceinline__ void phase_ssm_norm(const Args& a) {
    bf16_t* YS = (bf16_t*)(a.ws + WS_YS); const float* SSQ = (const float*)(a.ws + WS_SSQ);
#pragma unroll 4
    for (int idx = bidx() * 512 + tidx(); idx < (ROW_M0 + NMETA) * 256; idx += gdim() * 512) { const int row = idx >> 8, c8 = idx & 255, g = c8 >> 6;
        const f32x4 s0 = *(const f32x4*)(SSQ + (size_t)row * 32 + g * 8), s1 = *(const f32x4*)(SSQ + (size_t)row * 32 + g * 8 + 4);
        const float rstd = rsqrtf((((s0[0] + s0[1]) + (s0[2] + s0[3])) + ((s1[0] + s1[1]) + (s1[2] + s1[3]))) * (1.0f / 512.0f) + EPS);
        u32x4* p = (u32x4*)(YS + (size_t)row * DI + c8 * 8); float f[8]; unpack8(*p, f);
        u32x4 o; o.x = cvt_pk_bf16(f[0] * rstd, f[1] * rstd); o.y = cvt_pk_bf16(f[2] * rstd, f[3] * rstd); o.z = cvt_pk_bf16(f[4] * rstd, f[5] * rstd); o.w = cvt_pk_bf16(f[6] * rstd, f[7] * rstd); *p = o; }
}
__device__ __forceinline__ void phase_ffn_act(const Args& a, int l) {
    const int tid = tidx(), lane = tid & 63, wave = tid >> 6; const int gw = bidx() * 8 + wave, NGW = gdim() * 8;
    const bf16_t* UP = (const bf16_t*)(a.ws + WS_UP); bf16_t* ACT = (bf16_t*)(a.ws + WS_ACT);
    constexpr int NR = (ROW_M0 + NMETA) / 16;
    for (int wu = gw; wu < NR * 11; wu += NGW) {
        const int rg = wu / 11, sl = wu - rg * 11; const int row0 = rg * 16, ch = sl * 256 + lane * 4;
        const int kind = row0 < ROW_S0 ? 0 : row0 < ROW_M0 ? 1 : 2;
        u32x2 gtv[16], upv[16];
#pragma unroll
        for (int i = 0; i < 16; ++i) { const size_t ro = (size_t)(row0 + i) * NUP; gtv[i] = *(const u32x2*)(UP + ro + ch); upv[i] = *(const u32x2*)(UP + ro + DFF + ch); }
        const f32x4 w0 = *(const f32x4*)(a.in[I_FCW] + ((size_t)l * 3 + 0) * DFF + ch), w1 = *(const f32x4*)(a.in[I_FCW] + ((size_t)l * 3 + 1) * DFF + ch), w2 = *(const f32x4*)(a.in[I_FCW] + ((size_t)l * 3 + 2) * DFF + ch);
        const f32x4 bs = *(const f32x4*)(a.in[I_FCB] + (size_t)l * DFF + ch);
        f32x4 x0 = (f32x4){0.f, 0.f, 0.f, 0.f}, x1 = x0; f32x4 st[4][2];
#pragma unroll
        for (int sI = 0; sI < 4; ++sI) { st[sI][0] = x0; st[sI][1] = x0; }
        if (kind == 0) { const int r2 = (row0 & (SEQ - 1)) ? row0 - 2 : ROW_M0 + 14; const u32x2 p0 = *(const u32x2*)(UP + (size_t)r2 * NUP + ch), p1 = *(const u32x2*)(UP + (size_t)(r2 + 1) * NUP + ch);
            x0 = (f32x4){bf_lo(p0.x), bf_hi(p0.x), bf_lo(p0.y), bf_hi(p0.y)}; x1 = (f32x4){bf_lo(p1.x), bf_hi(p1.x), bf_lo(p1.y), bf_hi(p1.y)}; }
        else if (kind == 1) { const int sq0 = (row0 - ROW_S0) >> 2;
#pragma unroll
            for (int sI = 0; sI < 4; ++sI)
#pragma unroll
                for (int jj = 0; jj < 2; ++jj) st[sI][jj] = *(const f32x4*)(a.in[I_SFC] + ((size_t)(l * DB + sq0 + sI) * 2 + jj) * DFF + ch); }
#pragma unroll
        for (int i = 0; i < 16; ++i) {
            if (kind == 1 && (i & 3) == 0) { x0 = st[i >> 2][0]; x1 = st[i >> 2][1]; }
            const f32x4 g = (f32x4){bf_lo(gtv[i].x), bf_hi(gtv[i].x), bf_lo(gtv[i].y), bf_hi(gtv[i].y)}, u = (f32x4){bf_lo(upv[i].x), bf_hi(upv[i].x), bf_lo(upv[i].y), bf_hi(upv[i].y)};
            const f32x4 y = w0 * x0 + w1 * x1 + w2 * g + bs; f32x4 o;
#pragma unroll
            for (int e = 0; e < 4; ++e) o[e] = siluf_(y[e]) * u[e];
            *(u32x2*)(ACT + (size_t)(row0 + i) * DFF + ch) = pack4(o);
            if (kind == 0 && (row0 & (SEQ - 1)) == SEQ - 16 && i >= 14) *(f32x4*)(a.out + O_PFC + ((size_t)(l * NB + (row0 >> 11)) * 2 + (i - 14)) * DFF + ch) = g;
            if (kind == 1 && (i & 3) >= 2) *(f32x4*)(a.out + O_SFC + ((size_t)(l * DB + ((row0 - ROW_S0) >> 2) + (i >> 2)) * 2 + ((i & 3) - 2)) * DFF + ch) = g;
            x0 = x1; x1 = g;
        }
    }
}
__device__ __forceinline__ void phase_final(const Args& a) {
    const int lane = tidx() & 63, wave = tidx() >> 6; const int gw = bidx() * 8 + wave, NGW = gdim() * 8;
    const float* X = (const float*)(a.ws + WS_X); const float* RSS = (const float*)(a.ws + WS_RSS);
    for (int row = gw; row < ROW_M0; row += NGW) { const float rs = pg8::row_rstd(RSS, row);
        float* dst = row < ROW_S0 ? a.out + O_YP + (size_t)row * D : a.out + O_YS + (size_t)(row - ROW_S0) * D;
#pragma unroll
        for (int j = 0; j < 4; ++j) { const f32x4 v = *(const f32x4*)(X + (size_t)row * D + 256 * j + 4 * lane), wv = *(const f32x4*)(a.in[I_NF] + 256 * j + 4 * lane); *(f32x4*)(dst + 256 * j + 4 * lane) = v * rs * wv; } }
}

constexpr int PH_PER_LAYER = 11, PH_FINAL = 2 + DEPTH * PH_PER_LAYER, PH_END = PH_FINAL + 1;
__global__ void __launch_bounds__(512, 2) mk(Args a) {
    extern __shared__ __attribute__((aligned(16))) unsigned char lds_raw[];
    LAS unsigned char* lds = (LAS unsigned char*)lds_raw;
    volatile LAS unsigned* MISC = (volatile LAS unsigned*)(lds + LDS_CTL);
    if (threadIdx.x < 16) MISC[threadIdx.x] = 0u;
    __syncthreads();
#if MK_SINGLE
    XcdBarrier bar = xcd_barrier_post((unsigned*)(a.ws + WS_CTL), MISC);
#ifdef MK_TIME
#define SEAM(k) do { if (IN(k) && IN((k) + 1)) xcd_barrier(bar); if (blockIdx.x == 0 && threadIdx.x == 0) { const unsigned long long tn = wall_clock64(); tim[tk] += (float)(tn - tprev) * 0.01f; tprev = tn; } } while (0)
#else
#define SEAM(k) do { if (IN(k) && IN((k) + 1)) xcd_barrier(bar); } while (0)
#endif
#else
#define SEAM(k) do { } while (0)
#endif
#define IN(k) (a.ph_lo <= (k) && (k) < a.ph_hi)
    const int G = gdim();
#ifdef MK_TIME
    float* tim = (float*)(a.ws + WS_CTL + 65536); unsigned long long tprev = wall_clock64(); int tk = 0;
#define TK(k) tk = (k)
#else
#define TK(k)
#endif
    if (PHON(0) && IN(0)) for (int rp = 0; rp < REPN(0); ++rp) phase_weights(a, lds);
    TK(0);
    if (PHON(1) && IN(1)) phase_inputs(a);
    TK(1); SEAM(1);
    for (int l = 0; l < DEPTH; ++l) {
        const int pb = 2 + l * PH_PER_LAYER;
        if (PHON(2) && IN(pb + 0)) { pg8::Gemm g{(const bf16_t*)(a.ws + WS_XB), (const bf16_t*)(a.ws + WS_WIN + l * SZ_WIN), MP, NPROJ_T, D}; pg8::StaticOrder S; S.init(MP, NPROJ_T, G, bidx());
            pg8::EpiScaleBf16 E{(bf16_t*)(a.ws + WS_PROJ), NPROJ, (const float*)(a.ws + WS_RSS), (float*)(a.ws + WS_SMALL), NPROJ / 256};
            for (int rp = 0; rp < REPN(2); ++rp) pg8::gemm_phase<pg8::EpiScaleBf16, pg8::StaticOrder, true, true>(lds, g, S, E); }
        TK(2); SEAM(pb + 0);
        if (PHON(3) && IN(pb + 1)) for (int rp = 0; rp < REPN(3); ++rp) phase_prep(a, l, lds);
        TK(3); SEAM(pb + 1);
        if (IN(pb + 2)) for (int rp = 0; rp < REPN(4); ++rp) { if (PHON(4)) phase_gdnprep(a, lds); __syncthreads(); }
        TK(4); SEAM(pb + 2);
        if (IN(pb + 3)) for (int rp = 0; rp < REPN(5); ++rp) { if (PHON(7)) for (int r2 = 0; r2 < REPN(16); ++r2) for (int c = bidx(); c < NB * NH; c += G) { const int x = c & 7, k = c >> 3, gp = (k >> 3) * 8 + x; ssd_chain(a, l, lds, (gp >> 2) * 32 + (gp & 3) * 8 + (k & 7)); }     if (PHON(8)) for (int r2 = 0; r2 < REPN(17); ++r2) for (int u = bidx(); u < NB * 8; u += G) gdn_chain(a, l, lds, u);
            { const int nfree = G > NB * 8 ? G - NB * 8 : G, vb = G > NB * 8 ? bidx() - NB * 8 : bidx();
              if (vb >= 0) { __syncthreads(); if (PHON(5)) phase_sample_gdn(a, l, lds, vb, nfree); __syncthreads(); if (PHON(6)) phase_sample_ssd(a, l, lds, vb, nfree); __syncthreads(); } } }
        TK(5); SEAM(pb + 3);
        if (PHON(9) && IN(pb + 4)) phase_ssm_norm(a);
        TK(6); SEAM(pb + 4);
        if (PHON(10) && IN(pb + 5)) { pg8::Gemm g{(const bf16_t*)(a.ws + WS_YS), (const bf16_t*)(a.ws + WS_WSO + l * SZ_WSO), MP, D, DI}; pg8::StaticOrder S; S.init(MP, D, G, bidx());
            pg8::EpiGateF32 E{(float*)(a.ws + WS_T1), (const bf16_t*)(a.ws + WS_PROJ), PC_MGS};
            pg8::gemm_phase<pg8::EpiGateF32, pg8::StaticOrder, true, true>(lds, g, S, E); }
        TK(7);
        if (PHON(11) && IN(pb + 6)) { pg8::Gemm g{(const bf16_t*)(a.ws + WS_YG), (const bf16_t*)(a.ws + WS_WGO + l * SZ_WGO), MP, D, D}; pg8::StaticOrder S; S.init(MP, D, G, bidx());
            pg8::EpiMerge E{(bf16_t*)(a.ws + WS_MRG), (const float*)(a.ws + WS_T1), (const bf16_t*)(a.ws + WS_PROJ), PC_MGG};
            pg8::gemm_phase<pg8::EpiMerge, pg8::StaticOrder, true, true>(lds, g, S, E); }
        TK(8); SEAM(pb + 6);
        if (PHON(12) && IN(pb + 7)) { pg8::Gemm g{(const bf16_t*)(a.ws + WS_MRG), (const bf16_t*)(a.ws + WS_WO + l * SZ_WO), MP, D, D}; pg8::StaticOrder S; S.init(MP, D, G, bidx());
            pg8::EpiResid E{(float*)(a.ws + WS_X), (bf16_t*)(a.ws + WS_XB), (float*)(a.ws + WS_RSS)};
            pg8::gemm_phase<pg8::EpiResid, pg8::StaticOrder, true, true>(lds, g, S, E); }
        TK(9); SEAM(pb + 7);
        if (PHON(13) && IN(pb + 8)) { pg8::Gemm g{(const bf16_t*)(a.ws + WS_XB), (const bf16_t*)(a.ws + WS_WUP + l * SZ_WUP), MP, NUP, D}; pg8::StaticOrder S; S.init(MP, NUP, G, bidx());
            pg8::EpiScaleBf16 E{(bf16_t*)(a.ws + WS_UP), NUP, (const float*)(a.ws + WS_RSS), nullptr, NUP / 256};
            pg8::gemm_phase<pg8::EpiScaleBf16, pg8::StaticOrder, true, true>(lds, g, S, E); }
        TK(10); SEAM(pb + 8);
        if (PHON(14) && IN(pb + 9)) for (int rp = 0; rp < REPN(11); ++rp) phase_ffn_act(a, l);
        TK(11); SEAM(pb + 9);
        if (PHON(15) && IN(pb + 10)) { pg8::Gemm g{(const bf16_t*)(a.ws + WS_ACT), (const bf16_t*)(a.ws + WS_WDN + l * SZ_WDN), MP, D, DFF}; pg8::StaticOrder S; S.init(MP, D, G, bidx());
            pg8::EpiResid E{(float*)(a.ws + WS_X), (bf16_t*)(a.ws + WS_XB), (float*)(a.ws + WS_RSS)};
            pg8::gemm_phase<pg8::EpiResid, pg8::StaticOrder, true, true>(lds, g, S, E); }
        TK(12); SEAM(pb + 10);
    }
    if (PHON(16) && IN(PH_FINAL)) phase_final(a);
#ifdef MK_TIME
    TK(13); xcd_barrier(bar); if (blockIdx.x == 0 && threadIdx.x == 0) { const unsigned long long tn = wall_clock64(); tim[tk] += (float)(tn - tprev) * 0.01f; }
    __syncthreads();
    { float A = 0.f, B = 0.f; for (int k = 0; k < 14; ++k) { const float v = __hip_atomic_load(tim + k, __ATOMIC_RELAXED, __HIP_MEMORY_SCOPE_AGENT); if ((MK_TIME_A >> k) & 1) A += v; if ((MK_TIME_B >> k) & 1) { A += v; B += v; } }
      if (blockIdx.x == 0) { __syncthreads(); if (threadIdx.x == 0) a.out[O_YS] = A; for (size_t i = threadIdx.x; i < (size_t)DEPTH * NB * 2 * DFF; i += 512) a.out[O_PFC + i] = B; } }
#endif
#undef IN
#undef SEAM
}


extern "C" void kernel_launch(void* const* d_in, const int* in_sizes, int n_in, void* d_out, int out_size, void* d_ws, size_t ws_size, hipStream_t stream) {
    static int grid = 0;
    if (grid == 0) {
        if (n_in != 29 || (size_t)out_size != O_END || ws_size < WS_END) { fprintf(stderr, "kernel_launch: unexpected shapes (n_in %d, out %d vs %zu, ws %zu vs %zu)\n", n_in, out_size, (size_t)O_END, ws_size, (size_t)WS_END); grid = -1; return; }
        int dev = 0, cus = 0, per_cu = 0;
        if (hipGetDevice(&dev) != hipSuccess || hipDeviceGetAttribute(&cus, hipDeviceAttributeMultiprocessorCount, dev) != hipSuccess) { grid = -1; return; }
        if (hipFuncSetAttribute((const void*)mk, hipFuncAttributeMaxDynamicSharedMemorySize, LDS_BYTES) != hipSuccess) { fprintf(stderr, "kernel_launch: hipFuncSetAttribute failed\n"); grid = -1; return; }
        if (hipOccupancyMaxActiveBlocksPerMultiprocessor(&per_cu, (const void*)mk, 512, LDS_BYTES) != hipSuccess || per_cu < 1) fprintf(stderr, "kernel_launch: occupancy query says %d\n", per_cu);
        (void)hipGetLastError();
        grid = cus;
    }
    if (grid < 0) return;
    (void)hipMemsetAsync((char*)d_ws + WS_CTL, 0, CTL_BYTES, stream);
    Args a{};
    for (int i = 0; i < 29; ++i) a.in[i] = (const float*)d_in[i];
    a.out = (float*)d_out; a.ws = (unsigned char*)d_ws;
#if MK_SINGLE
    a.ph_lo = 0; a.ph_hi = PH_END;
    hipLaunchKernelGGL(mk, dim3(grid), dim3(512), LDS_BYTES, stream, a);
#else
    for (int ph = 0; ph < PH_END; ++ph) { a.ph_lo = ph; a.ph_hi = ph + 1; hipLaunchKernelGGL(mk, dim3(grid), dim3(512), LDS_BYTES, stream, a); }
#endif
}
```
